# Optimizing an MI355X kernel written in HIP

```python
import math
import jax, jax.numpy as jnp
from jax import lax
import numpy as np

D_MODEL = 1024
BATCH = 4
SEQ = 8192
DEPTH = 1

SSD_HEADS = 24
SSD_HEAD_DIM = 64
SSD_INNER = SSD_HEADS * SSD_HEAD_DIM
SSD_GROUPS = 4
SSD_STATE = 128
SSD_CONV = 5
SSD_CHUNK = 128
XBC_WIDTH = SSD_INNER + 2 * SSD_GROUPS * SSD_STATE
FOURIER_GROUPS = 4
FOURIER_GROUP_DIM = 128
FOURIER_WIDTH = FOURIER_GROUPS * FOURIER_GROUP_DIM
IN_WIDTH = SSD_INNER + XBC_WIDTH + 2 * SSD_HEADS + FOURIER_WIDTH + 2 * D_MODEL
N_EXPERTS = 256
TOP_K = 8
N_EXPERT_GROUPS = 8
TOPK_GROUPS = 4
EXPERT_HIDDEN = 256
SHARED_HIDDEN = 256
ROUTED_SCALE = 2.5
EXPERT_BLOCK = 128
RMS_EPS = 1e-6

kernel_name = "bidir_ssd_fourier_moe_sandwich_block"

F32 = jnp.float32


def rmsnorm(x, g):
    xf = x.astype(F32)
    y = xf * lax.rsqrt(jnp.mean(xf * xf, axis=-1, keepdims=True) + RMS_EPS)
    return (y * g.astype(F32)).astype(x.dtype)


def centred_depthwise_conv(u, w, b):
    pad = (SSD_CONV - 1) // 2
    out = lax.conv_general_dilated(u, w[:, None, :].astype(u.dtype), window_strides=(1,),
                                   padding=((pad, pad),), dimension_numbers=('NWC', 'WIO', 'NWC'),
                                   feature_group_count=u.shape[-1])
    return out + b.astype(u.dtype)


def ssd_chunked(xh, dt, A, Bm, Cm):
    b, l, h, p = xh.shape
    g, n = Bm.shape[-2:]
    r = h // g
    L = SSD_CHUNK
    c = l // L
    X = (xh * dt[..., None]).reshape(b, c, L, g, r, p)
    a = (dt * A).reshape(b, c, L, g, r)
    acs = jnp.cumsum(jnp.moveaxis(a, 2, -1), axis=-1)
    Bc = Bm.reshape(b, c, L, g, n)
    Cc = Cm.reshape(b, c, L, g, n)
    lower = jnp.tril(jnp.ones((L, L), bool))
    decay = jnp.exp(jnp.where(lower, acs[..., :, None] - acs[..., None, :], -jnp.inf))
    cb = jnp.einsum('bclgn,bcsgn->bcgls', Cc, Bc)
    y_diag = jnp.einsum('bcgrls,bcsgrp->bclgrp', cb[:, :, :, None] * decay, X)
    state_decay = jnp.exp(acs[..., -1:] - acs)
    states = jnp.einsum('bclgn,bcgrl,bclgrp->bcgrpn', Bc, state_decay, X)
    chunk_decay = jnp.exp(acs[..., -1])

    def carry_state(s, inp):
        s_c, d_c = inp
        return s * d_c[..., None, None] + s_c, s

    _, prev = lax.scan(carry_state, jnp.zeros((b, g, r, p, n), F32),
                       (jnp.moveaxis(states, 1, 0), jnp.moveaxis(chunk_decay, 1, 0)))
    prev = jnp.moveaxis(prev, 0, 1)
    y_off = jnp.einsum('bclgn,bcgrpn,bcgrl->bclgrp', Cc, prev, jnp.exp(acs))
    return (y_diag + y_off).reshape(b, l, h, p)


def ssd_bidirectional(xh, dt_raw_f, dt_raw_b, Bm, Cm, dt_bias_f, dt_bias_b, a_log_f, a_log_b):
    dt_f = jax.nn.softplus(dt_raw_f + dt_bias_f.astype(F32))
    dt_b = jax.nn.softplus(dt_raw_b + dt_bias_b.astype(F32))
    A_f = -jnp.exp(a_log_f.astype(F32))
    A_b = -jnp.exp(a_log_b.astype(F32))
    rev = lambda t: jnp.flip(t, axis=1)
    y_f = ssd_chunked(xh, dt_f, A_f, Bm, Cm)
    y_b = rev(ssd_chunked(rev(xh), rev(dt_b), A_b, rev(Bm), rev(Cm)))
    return y_f + y_b


def gated_group_rmsnorm(y, z, w):
    v = y * jax.nn.silu(z.astype(F32))
    v = v.reshape(*v.shape[:-1], SSD_GROUPS, -1)
    v = v * lax.rsqrt(jnp.mean(v * v, axis=-1, keepdims=True) + RMS_EPS)
    return v.reshape(y.shape) * w.astype(F32)


def fourier_mix(u):
    bsz, seq, _ = u.shape
    ug = u.astype(F32).reshape(bsz, seq, FOURIER_GROUPS, FOURIER_GROUP_DIM)
    f = jnp.fft.fft2(ug, axes=(1, 3), norm='ortho').real
    return f.reshape(bsz, seq, FOURIER_WIDTH).astype(u.dtype)


def swiglu(x, w13, w2):
    a, g = jnp.split(x @ w13, 2, axis=-1)
    return (jax.nn.silu(a) * g) @ w2


def moe_ffn(xf, w_router, router_bias, w13_experts, w2_experts, w13_shared, w2_shared):
    T, D = xf.shape
    scores = jax.nn.sigmoid(xf.astype(F32) @ w_router.astype(F32))
    biased = scores + router_bias.astype(F32)
    per_group = N_EXPERTS // N_EXPERT_GROUPS
    group_score = lax.top_k(biased.reshape(T, N_EXPERT_GROUPS, per_group), 2)[0].sum(-1)
    _, top_groups = lax.top_k(group_score, TOPK_GROUPS)
    group_mask = jax.nn.one_hot(top_groups, N_EXPERT_GROUPS, dtype=F32).sum(1)
    expert_mask = jnp.repeat(group_mask, per_group, axis=1) > 0
    _, top_idx = lax.top_k(jnp.where(expert_mask, biased, -jnp.inf), TOP_K)
    top_w = jnp.take_along_axis(scores, top_idx, axis=1)
    top_w = top_w / jnp.sum(top_w, axis=-1, keepdims=True) * ROUTED_SCALE

    n_assign = T * TOP_K
    flat_e = top_idx.reshape(-1)
    order = jnp.argsort(flat_e)
    sorted_e = flat_e[order]
    sorted_tok = (order // TOP_K).astype(jnp.int32)
    sorted_w = top_w.reshape(-1)[order]
    counts = jnp.bincount(flat_e, length=N_EXPERTS)
    padded = (counts + EXPERT_BLOCK - 1) // EXPERT_BLOCK * EXPERT_BLOCK
    pad_end = jnp.cumsum(padded)
    pad_start = pad_end - padded
    start = jnp.cumsum(counts) - counts
    dest = pad_start[sorted_e] + jnp.arange(n_assign) - start[sorted_e]
    n_rows = -(-n_assign // EXPERT_BLOCK) * EXPERT_BLOCK + N_EXPERTS * EXPERT_BLOCK
    n_blocks = n_rows // EXPERT_BLOCK
    row_tok = jnp.full((n_rows,), T, jnp.int32).at[dest].set(sorted_tok)
    row_w = jnp.zeros((n_rows,), F32).at[dest].set(sorted_w)
    block_e = jnp.minimum(jnp.searchsorted(pad_end, jnp.arange(n_blocks) * EXPERT_BLOCK, side='right'),
                          N_EXPERTS - 1)
    x_pad = jnp.concatenate([xf, jnp.zeros((1, D), xf.dtype)], axis=0)

    def expert_block(acc, blk):
        tok, wgt, e = blk
        yb = swiglu(x_pad[tok], w13_experts[e], w2_experts[e])
        return acc.at[tok].add(yb.astype(F32) * wgt[:, None]), None

    acc, _ = lax.scan(expert_block, jnp.zeros((T + 1, D), F32),
                      (row_tok.reshape(n_blocks, EXPERT_BLOCK), row_w.reshape(n_blocks, EXPERT_BLOCK), block_e))
    routed = acc[:T].astype(xf.dtype)
    return routed + swiglu(xf, w13_shared, w2_shared)


def hybrid_layer(x, c, w_ada, b_ada, pre_norm_mix, post_norm_mix, pre_norm_ffn, post_norm_ffn, w_in,
                 conv_w, conv_b, dt_bias_fwd, dt_bias_bwd, a_log_fwd, a_log_bwd, d_skip, ssd_norm,
                 w_branch_ssd, w_branch_fourier, w_out, w_router, router_bias, w13_experts, w2_experts,
                 w13_shared, w2_shared):
    bsz, seq, d = x.shape
    mod = jax.nn.silu(c) @ w_ada + b_ada
    shift_m, scale_m, gate_m, shift_f, scale_f, gate_f = jnp.split(mod[:, None, :], 6, axis=-1)

    h = rmsnorm(x, pre_norm_mix) * (1 + scale_m) + shift_m
    proj = h @ w_in
    i1 = SSD_INNER
    i2 = i1 + XBC_WIDTH
    i3 = i2 + 2 * SSD_HEADS
    i4 = i3 + FOURIER_WIDTH
    z, xbc, dt_raw, u_f, gates = jnp.split(proj, [i1, i2, i3, i4], axis=-1)

    xbc = jax.nn.silu(centred_depthwise_conv(xbc, conv_w, conv_b))
    gn = SSD_GROUPS * SSD_STATE
    xs, Bm, Cm = jnp.split(xbc, [SSD_INNER, SSD_INNER + gn], axis=-1)
    xh = xs.astype(F32).reshape(bsz, seq, SSD_HEADS, SSD_HEAD_DIM)
    Bm = Bm.astype(F32).reshape(bsz, seq, SSD_GROUPS, SSD_STATE)
    Cm = Cm.astype(F32).reshape(bsz, seq, SSD_GROUPS, SSD_STATE)
    dt_f, dt_b = jnp.split(dt_raw.astype(F32), 2, axis=-1)
    y = ssd_bidirectional(xh, dt_f, dt_b, Bm, Cm, dt_bias_fwd, dt_bias_bwd, a_log_fwd, a_log_bwd)
    y = (y + d_skip.astype(F32)[:, None] * xh).reshape(bsz, seq, SSD_INNER)
    y = gated_group_rmsnorm(y, z, ssd_norm).astype(x.dtype)
    y_ssd = y @ w_branch_ssd

    y_fourier = fourier_mix(u_f) @ w_branch_fourier

    g_ssd, g_fourier = jnp.split(jax.nn.sigmoid(gates), 2, axis=-1)
    mixed = (g_ssd * y_ssd + g_fourier * y_fourier) @ w_out
    x = x + gate_m * rmsnorm(mixed, post_norm_mix)

    h = rmsnorm(x, pre_norm_ffn) * (1 + scale_f) + shift_f
    ffn = moe_ffn(h.reshape(bsz * seq, d), w_router, router_bias, w13_experts, w2_experts,
                  w13_shared, w2_shared).reshape(bsz, seq, d)
    return x + gate_f * rmsnorm(ffn, post_norm_ffn)


def setup_inputs(seed: int = 0) -> dict:
    key = jax.random.key(seed)
    ks = jax.random.split(key, 24)
    D = D_MODEL
    Ld = DEPTH

    def normal(k, shape, scale):
        return jax.random.normal(k, shape, F32) * scale

    dt0 = jnp.exp(jax.random.uniform(ks[11], (Ld, 2, SSD_HEADS), F32, math.log(1e-3), math.log(1e-1)))
    dt_bias = dt0 + jnp.log(-jnp.expm1(-dt0))
    a_log = jnp.log(jax.random.uniform(ks[12], (Ld, 2, SSD_HEADS), F32, 1.0, 16.0))
    return {
        "x": normal(ks[0], (BATCH, SEQ, D), 1.0),
        "c": normal(ks[1], (BATCH, D), 1.0),
        "w_ada": normal(ks[2], (Ld, D, 6 * D), 0.5 * D ** -0.5),
        "b_ada": normal(ks[3], (Ld, 6 * D), 0.02),
        "pre_norm_mix": 1.0 + normal(ks[4], (Ld, D), 0.05),
        "post_norm_mix": 1.0 + normal(ks[5], (Ld, D), 0.05),
        "pre_norm_ffn": 1.0 + normal(ks[6], (Ld, D), 0.05),
        "post_norm_ffn": 1.0 + normal(ks[7], (Ld, D), 0.05),
        "w_in": normal(ks[8], (Ld, D, IN_WIDTH), D ** -0.5),
        "conv_w": normal(ks[9], (Ld, SSD_CONV, XBC_WIDTH), SSD_CONV ** -0.5),
        "conv_b": normal(ks[10], (Ld, XBC_WIDTH), 0.02),
        "dt_bias_fwd": dt_bias[:, 0],
        "dt_bias_bwd": dt_bias[:, 1],
        "a_log_fwd": a_log[:, 0],
        "a_log_bwd": a_log[:, 1],
        "d_skip": 1.0 + normal(ks[13], (Ld, SSD_HEADS), 0.1),
        "ssd_norm": 1.0 + normal(ks[14], (Ld, SSD_INNER), 0.05),
        "w_branch_ssd": normal(ks[15], (Ld, SSD_INNER, D), SSD_INNER ** -0.5),
        "w_branch_fourier": normal(ks[16], (Ld, FOURIER_WIDTH, D), FOURIER_WIDTH ** -0.5),
        "w_out": normal(ks[17], (Ld, D, D), D ** -0.5),
        "w_router": normal(ks[18], (Ld, D, N_EXPERTS), D ** -0.5),
        "router_bias": normal(ks[19], (Ld, N_EXPERTS), 0.01),
        "w13_experts": normal(ks[20], (Ld, N_EXPERTS, D, 2 * EXPERT_HIDDEN), D ** -0.5),
        "w2_experts": normal(ks[21], (Ld, N_EXPERTS, EXPERT_HIDDEN, D), EXPERT_HIDDEN ** -0.5),
        "w13_shared": normal(ks[22], (Ld, D, 2 * SHARED_HIDDEN), D ** -0.5),
        "w2_shared": normal(ks[23], (Ld, SHARED_HIDDEN, D), SHARED_HIDDEN ** -0.5),
    }


def reference(x, c, w_ada, b_ada, pre_norm_mix, post_norm_mix, pre_norm_ffn, post_norm_ffn, w_in,
              conv_w, conv_b, dt_bias_fwd, dt_bias_bwd, a_log_fwd, a_log_bwd, d_skip, ssd_norm,
              w_branch_ssd, w_branch_fourier, w_out, w_router, router_bias, w13_experts, w2_experts,
              w13_shared, w2_shared):
    for layer in range(DEPTH):
        x = hybrid_layer(x, c, w_ada[layer], b_ada[layer], pre_norm_mix[layer], post_norm_mix[layer],
                         pre_norm_ffn[layer], post_norm_ffn[layer], w_in[layer], conv_w[layer], conv_b[layer],
                         dt_bias_fwd[layer], dt_bias_bwd[layer], a_log_fwd[layer], a_log_bwd[layer],
                         d_skip[layer], ssd_norm[layer], w_branch_ssd[layer], w_branch_fourier[layer],
                         w_out[layer], w_router[layer], router_bias[layer], w13_experts[layer],
                         w2_experts[layer], w13_shared[layer], w2_shared[layer])
    return x
```

```cpp
#include <hip/hip_runtime.h>
#include <cstdio>
#include <cstdint>
#include <cmath>
#define MULTI_LAUNCH 0
#define DEV_CHECKS 0
#define EMIT_AFTER -1
#define DFT_DEBUG 0
#define KSTART_INV 0
#define DUP_MASK 0
namespace pg8 {
#define PG8_LAS __attribute__((address_space(3)))
typedef unsigned short bf16_t;
typedef short bf16x8 __attribute__((ext_vector_type(8)));
typedef float f32x4 __attribute__((ext_vector_type(4)));
typedef unsigned u32x4 __attribute__((ext_vector_type(4)));
typedef unsigned u32x2 __attribute__((ext_vector_type(2)));
constexpr int BM = 256, BK = 64, HALF = 128, HTB = HALF * BK * 2  , STAGE_BYTES = 8 * HTB, NXCD = 8, WGM = 8;

__host__ __device__ __forceinline__ int lds_byte(int r, int c) { const int st = (r >> 4) * 2 + (c >> 5), rr = r & 15, cc = c & 31, ob = rr * 64 + cc * 2; return st * 1024 + (ob ^ (((ob >> 9) & 1) << 5)); }
__host__ __device__ __forceinline__ void stage_rc(int b, int& R, int& C) { const int st = b / 1024, sb = b % 1024, swz = sb ^ (((sb >> 9) & 1) << 5); R = (st >> 1) * 16 + swz / 64; C = (st & 1) * 32 + (swz % 64) / 2; }
__host__ __device__ __forceinline__ int perm32(int rho) { const int n = rho >> 4, i = rho & 15; return 8 * (i >> 2) + 4 * n + (i & 3); }

struct Unit { int pm, pn; };
struct Gemm { const bf16_t* A; const bf16_t* Bt; int M, N, K; const int* rowtok; };

struct StaticOrder {
    int nM, nN, nwg, G, c;
    __host__ __device__ void init(int M, int N, int G_, int c_) { nM = M / BM; nN = N / BM; nwg = nM * nN; G = G_; c = c_; }
    __host__ __device__ bool next(int i, Unit& u) const {
        const long L = (long)i * G + c; if (L >= nwg) return false;
        int wgid = (int)L; { const int q = nwg / NXCD, r = nwg % NXCD, xcd = wgid % NXCD, off = wgid / NXCD; wgid = (xcd < r ? xcd * (q + 1) : r * (q + 1) + (xcd - r) * q) + off; }
        const int nig = WGM * nN, gid = wgid / nig, fm = gid * WGM, gsz = (nM - fm) < WGM ? (nM - fm) : WGM;
        u.pm = fm + ((wgid % nig) % gsz); u.pn = (wgid % nig) / gsz; return true;
    }
};
template <int NJ> struct GroupedOrder {
    const PG8_LAS int* tile_e; int ntiles, G, c;
    __device__ bool next(int i, Unit& u) const {
        const int L = i * G + c; if (L >= ntiles * NJ) return false;
        const int t = L / NJ, j = L % NJ; u.pm = t; u.pn = __builtin_amdgcn_readfirstlane(tile_e[t]) * NJ + j; return true;
    }
};

__device__ __forceinline__ unsigned cvt_pk_bf16(float lo, float hi) { unsigned r; asm volatile("v_cvt_pk_bf16_f32 %0, %1, %2" : "=v"(r) : "v"(lo), "v"(hi)); return r; }
__device__ __forceinline__ float bf_lo(unsigned w) { return __uint_as_float(w << 16); }
__device__ __forceinline__ float bf_hi(unsigned w) { return __uint_as_float(w & 0xffff0000u); }
__device__ __forceinline__ float sigmoidf_(float x) { return __builtin_amdgcn_rcpf(1.f + __expf(-x)); }

struct EpiF32 {
    static constexpr bool PERM = false;
    float* C; int ldc;
    __device__ __forceinline__ void operator()(const f32x4 (&acc)[2][2][4][2], const Unit& u, int wr, int wc, int fr, int fq) const {
        const int row0 = u.pm * BM + wr * 64 + fr, col0 = u.pn * BM + wc * 32 + 4 * fq;
#pragma unroll
        for (int ai = 0; ai < 2; ++ai)
#pragma unroll
            for (int m = 0; m < 4; ++m) { float* rowp = C + (size_t)(row0 + ai * HALF + m * 16) * ldc + col0;
#pragma unroll
                for (int bj = 0; bj < 2; ++bj)
#pragma unroll
                    for (int n = 0; n < 2; ++n) *(f32x4*)(rowp + bj * HALF + n * 16) = acc[ai][bj][m][n]; }
    }
};
template <int NCOLT> struct EpiBf16 {
    static constexpr bool PERM = true;
    bf16_t* O; int ldc;
    __device__ __forceinline__ void operator()(const f32x4 (&acc)[2][2][4][2], const Unit& u, int wr, int wc, int fr, int fq) const {
        const int row0 = u.pm * BM + wr * 64 + fr; const int col0 = (u.pn & (NCOLT - 1)) * BM + wc * 32 + 8 * fq;
#pragma unroll
        for (int ai = 0; ai < 2; ++ai)
#pragma unroll
            for (int m = 0; m < 4; ++m) { bf16_t* rowp = O + (size_t)(row0 + ai * HALF + m * 16) * ldc + col0;
#pragma unroll
                for (int bj = 0; bj < 2; ++bj) { const f32x4 v0 = acc[ai][bj][m][0], v1 = acc[ai][bj][m][1];
                    u32x4 w; w.x = cvt_pk_bf16(v0[0], v0[1]); w.y = cvt_pk_bf16(v0[2], v0[3]); w.z = cvt_pk_bf16(v1[0], v1[1]); w.w = cvt_pk_bf16(v1[2], v1[3]);
                    *(u32x4*)(rowp + bj * HALF) = w; } }
    }
};
struct EpiProj {
    static constexpr bool PERM = true;
    bf16_t* O; int ldc; float* DT;
    __device__ __forceinline__ void operator()(const f32x4 (&acc)[2][2][4][2], const Unit& u, int wr, int wc, int fr, int fq) const {
        const int row0 = u.pm * BM + wr * 64 + fr;
        if (u.pn < 28) {
            const int col0 = u.pn * BM + wc * 32 + 8 * fq; const bool sg = u.pn >= 20;
#pragma unroll
            for (int ai = 0; ai < 2; ++ai)
#pragma unroll
                for (int m = 0; m < 4; ++m) { bf16_t* rowp = O + (size_t)(row0 + ai * HALF + m * 16) * ldc + col0;
#pragma unroll
                    for (int bj = 0; bj < 2; ++bj) { f32x4 v0 = acc[ai][bj][m][0], v1 = acc[ai][bj][m][1];
                        if (sg) {
#pragma unroll
                            for (int j = 0; j < 4; ++j) { v0[j] = sigmoidf_(v0[j]); v1[j] = sigmoidf_(v1[j]); } }
                        u32x4 w; w.x = cvt_pk_bf16(v0[0], v0[1]); w.y = cvt_pk_bf16(v0[2], v0[3]); w.z = cvt_pk_bf16(v1[0], v1[1]); w.w = cvt_pk_bf16(v1[2], v1[3]);
                        *(u32x4*)(rowp + bj * HALF) = w; } }
        } else {
            const int c0 = wc * 32 + 8 * fq;
            if (c0 + 7 < 48) {
#pragma unroll
                for (int ai = 0; ai < 2; ++ai)
#pragma unroll
                    for (int m = 0; m < 4; ++m) { float* rowp = DT + (size_t)(row0 + ai * HALF + m * 16) * 64 + c0;
                        *(f32x4*)(rowp) = acc[ai][0][m][0]; *(f32x4*)(rowp + 4) = acc[ai][0][m][1]; }
            }
        }
    }
};
template <bool ADD> struct EpiGate {
    static constexpr bool PERM = true;
    bf16_t* O; int ldc; const bf16_t* G; int ldg; int gcol0;
    __device__ __forceinline__ void operator()(const f32x4 (&acc)[2][2][4][2], const Unit& u, int wr, int wc, int fr, int fq) const {
        const int row0 = u.pm * BM + wr * 64 + fr; const int col0 = u.pn * BM + wc * 32 + 8 * fq;
#pragma unroll
        for (int ai = 0; ai < 2; ++ai)
#pragma unroll
            for (int m = 0; m < 4; ++m) { const size_t r = (size_t)(row0 + ai * HALF + m * 16); bf16_t* rowp = O + r * ldc + col0; const bf16_t* gp = G + r * ldg + gcol0 + col0;
#pragma unroll
                for (int bj = 0; bj < 2; ++bj) { const f32x4 v0 = acc[ai][bj][m][0], v1 = acc[ai][bj][m][1];
                    const u32x4 gw = *(const u32x4*)(gp + bj * HALF);
                    float o[8] = { v0[0] * bf_lo(gw.x), v0[1] * bf_hi(gw.x), v0[2] * bf_lo(gw.y), v0[3] * bf_hi(gw.y), v1[0] * bf_lo(gw.z), v1[1] * bf_hi(gw.z), v1[2] * bf_lo(gw.w), v1[3] * bf_hi(gw.w) };
                    if (ADD) { const u32x4 pw = *(const u32x4*)(rowp + bj * HALF);
                        o[0] += bf_lo(pw.x); o[1] += bf_hi(pw.x); o[2] += bf_lo(pw.y); o[3] += bf_hi(pw.y); o[4] += bf_lo(pw.z); o[5] += bf_hi(pw.z); o[6] += bf_lo(pw.w); o[7] += bf_hi(pw.w); }
                    u32x4 w; w.x = cvt_pk_bf16(o[0], o[1]); w.y = cvt_pk_bf16(o[2], o[3]); w.z = cvt_pk_bf16(o[4], o[5]); w.w = cvt_pk_bf16(o[6], o[7]);
                    *(u32x4*)(rowp + bj * HALF) = w; } }
    }
};
struct EpiSwiglu {
    static constexpr bool PERM = true;
    bf16_t* O; int ldc;
    __device__ __forceinline__ void operator()(const f32x4 (&acc)[2][2][4][2], const Unit& u, int wr, int wc, int fr, int fq) const {
        const int row0 = u.pm * BM + wr * 64 + fr; const int col0 = (u.pn & 1) * HALF + wc * 32 + 8 * fq;
#pragma unroll
        for (int ai = 0; ai < 2; ++ai)
#pragma unroll
            for (int m = 0; m < 4; ++m) { bf16_t* rowp = O + (size_t)(row0 + ai * HALF + m * 16) * ldc + col0;
                float o[8];
#pragma unroll
                for (int n = 0; n < 2; ++n)
#pragma unroll
                    for (int j = 0; j < 4; ++j) { const float a = acc[ai][0][m][n][j], gg = acc[ai][1][m][n][j]; o[4 * n + j] = a * sigmoidf_(a) * gg; }
                u32x4 w; w.x = cvt_pk_bf16(o[0], o[1]); w.y = cvt_pk_bf16(o[2], o[3]); w.z = cvt_pk_bf16(o[4], o[5]); w.w = cvt_pk_bf16(o[6], o[7]);
                *(u32x4*)(rowp) = w; }
    }
};

template <class Epi, class Sched, bool ALIGN_EPI, bool GATHER>
__device__ __forceinline__ void gemm_phase(PG8_LAS unsigned char* lds, const Gemm g, const Sched& S, const Epi& E) {
    int tid_ = threadIdx.x; asm volatile("" : "+v"(tid_));
    const int tid = tid_, wid = __builtin_amdgcn_readfirstlane(tid >> 6), lane = tid & 63, wr = wid >> 2, wc = wid & 3, fr = lane & 15, fq = lane >> 4;
    const int K = g.K, nt = K / BK;
    unsigned voffA[2], voffB[2];
#pragma unroll
    for (int i = 0; i < 2; ++i) { int R, C; stage_rc(tid * 16 + i * 8192, R, C); const int Rb = Epi::PERM ? ((R & ~31) + perm32(R & 31)) : R;
        voffA[i] = (unsigned)(R * K + C) * 2u; voffB[i] = (unsigned)(Rb * K + C) * 2u; }
    const size_t kstep = (size_t)(BK * 2);
    const size_t hstep = (size_t)HALF * K * 2;
    const size_t tstep = 2 * hstep;
    const unsigned rowB = (unsigned)K * 2u;
    const unsigned ldsw = (unsigned)wid * 1024u;
    const int aoff = lds_byte(wr * 64 + fr, fq * 8), boff = lds_byte(wc * 32 + fr, fq * 8);
#define PG8_SA(b, h) (((b) * 2 + (h)) * HTB)
#define PG8_SB(b, h) ((4 + (b) * 2 + (h)) * HTB)
#define PG8_STAGE(bufoff, gbase, voff) do { _Pragma("unroll") for (int _i = 0; _i < 2; ++_i) \
        __builtin_amdgcn_global_load_lds((const unsigned*)((const char*)(gbase) + (voff)[_i]), (PG8_LAS unsigned*)(lds + (bufoff) + ldsw + _i * 8192), 16, 0, 0); } while (0)
#define PG8_STAGE_A(bufoff, ptr_ng, offs, h, kb) do { _Pragma("unroll") for (int _i = 0; _i < 2; ++_i) { const char* _src; \
        if constexpr (GATHER) _src = (const char*)g.A + (size_t)(offs)[h][_i] + (size_t)(kb); else _src = (const char*)(ptr_ng) + voffA[_i]; \
        __builtin_amdgcn_global_load_lds((const unsigned*)_src, (PG8_LAS unsigned*)(lds + (bufoff) + ldsw + _i * 8192), 16, 0, 0); } } while (0)
#define PG8_LDA(dst, b, h) do { _Pragma("unroll") for (int m = 0; m < 4; ++m) _Pragma("unroll") for (int k = 0; k < 2; ++k) dst[m][k] = *(const PG8_LAS bf16x8*)(lds + PG8_SA(b, h) + aoff + m * 2048 + k * 1024); } while (0)
#define PG8_LDB(dst, b, h) do { _Pragma("unroll") for (int n = 0; n < 2; ++n) _Pragma("unroll") for (int k = 0; k < 2; ++k) dst[n][k] = *(const PG8_LAS bf16x8*)(lds + PG8_SB(b, h) + boff + n * 2048 + k * 1024); } while (0)
#define PG8_MMA(ai, bj, At, Bt) do { __builtin_amdgcn_s_setprio(1); _Pragma("unroll") for (int m = 0; m < 4; ++m) _Pragma("unroll") for (int n = 0; n < 2; ++n) _Pragma("unroll") for (int k = 0; k < 2; ++k) \
        acc[ai][bj][m][n] = __builtin_amdgcn_mfma_f32_16x16x32_bf16(Bt[n][k], At[m][k], acc[ai][bj][m][n], 0, 0, 0); __builtin_amdgcn_s_setprio(0); } while (0)
#define PG8_WAIT_V(n) asm volatile("s_waitcnt vmcnt(" #n ")" ::: "memory")
#define PG8_WAIT_L(n) asm volatile("s_waitcnt lgkmcnt(" #n ")" ::: "memory")
#define PG8_BAR __builtin_amdgcn_s_barrier()
#define PG8_SCHED __builtin_amdgcn_sched_barrier(0)
#define PG8_GOFFS(dst, unit) do { _Pragma("unroll") for (int _i = 0; _i < 2; ++_i) { int _R, _C; stage_rc(tid * 16 + _i * 8192, _R, _C); _Pragma("unroll") for (int _h = 0; _h < 2; ++_h) \
        dst[_h][_i] = (unsigned)g.rowtok[(unit).pm * BM + _h * HALF + _R] * rowB + (unsigned)_C * 2u; } } while (0)
    Unit cur, nxt; int ui = 0;
    if (!S.next(0, cur)) return;
    f32x4 acc[2][2][4][2];
#pragma unroll
    for (int a = 0; a < 2; ++a)
#pragma unroll
        for (int b = 0; b < 2; ++b)
#pragma unroll
            for (int m = 0; m < 4; ++m)
#pragma unroll
                for (int n = 0; n < 2; ++n) acc[a][b][m][n] = (f32x4){0.f, 0.f, 0.f, 0.f};
    bf16x8 At[4][2], B0[2][2], B1[2][2];
    unsigned co[2][2] = {{0u, 0u}, {0u, 0u}}, no[2][2] = {{0u, 0u}, {0u, 0u}};
    const char* cA = (const char*)g.A + (GATHER ? (size_t)0 : (size_t)cur.pm * tstep); const char* cB = (const char*)g.Bt + (size_t)cur.pn * tstep;
    if constexpr (GATHER) { PG8_GOFFS(co, cur); }
    PG8_STAGE(PG8_SB(0, 0), cB, voffB); PG8_STAGE(PG8_SB(0, 1), cB + hstep, voffB); PG8_STAGE_A(PG8_SA(0, 0), cA, co, 0, 0); PG8_STAGE_A(PG8_SA(0, 1), cA + hstep, co, 1, 0);
    if (wr == 1) PG8_BAR;
    PG8_WAIT_V(2); PG8_BAR;
    PG8_STAGE(PG8_SB(1, 0), cB + kstep, voffB); PG8_STAGE_A(PG8_SA(1, 0), cA + kstep, co, 0, kstep); PG8_STAGE(PG8_SB(1, 1), cB + hstep + kstep, voffB);
    PG8_WAIT_V(6); PG8_BAR;
    for (;;) {
        const bool has_next = S.next(ui + 1, nxt);
        const char* nA = (has_next && !GATHER) ? (const char*)g.A + (size_t)nxt.pm * tstep : cA; const char* nB = has_next ? (const char*)g.Bt + (size_t)nxt.pn * tstep : cB;
        if constexpr (GATHER) { if (has_next) { PG8_GOFFS(no, nxt); } else {
#pragma unroll
            for (int _h = 0; _h < 2; ++_h)
#pragma unroll
                for (int _i = 0; _i < 2; ++_i) no[_h][_i] = co[_h][_i]; } }
#pragma unroll 1
        for (int t = 0; t < nt; t += 2) {
            const bool last = (t == nt - 2);
            const char* a1 = cA + (size_t)(t + 1) * kstep;
            const char* a2 = last ? nA : cA + (size_t)(t + 2) * kstep; const char* b2 = last ? nB : cB + (size_t)(t + 2) * kstep;
            const char* a3 = a2 + kstep; const char* b3 = b2 + kstep;
            unsigned so[2][2];
#pragma unroll
            for (int _h = 0; _h < 2; ++_h)
#pragma unroll
                for (int _i = 0; _i < 2; ++_i) so[_h][_i] = last ? no[_h][_i] : co[_h][_i];
            const size_t kb1 = (size_t)(t + 1) * kstep, kb2 = last ? (size_t)0 : (size_t)(t + 2) * kstep, kb3 = kb2 + kstep;
            PG8_LDB(B0, 0, 0); PG8_LDB(B1, 0, 1); PG8_SCHED; PG8_LDA(At, 0, 0); PG8_STAGE_A(PG8_SA(1, 1), a1 + hstep, co, 1, kb1);
            PG8_WAIT_V(8); PG8_WAIT_L(0); PG8_BAR; PG8_MMA(0, 0, At, B0); PG8_MMA(0, 1, At, B1); PG8_BAR; PG8_SCHED;
            PG8_LDA(At, 0, 1); PG8_STAGE(PG8_SB(0, 0), b2, voffB); PG8_STAGE(PG8_SB(0, 1), b2 + hstep, voffB); PG8_STAGE_A(PG8_SA(0, 0), a2, so, 0, kb2);
            PG8_WAIT_V(8); PG8_WAIT_L(0); PG8_BAR; PG8_MMA(1, 0, At, B0); PG8_MMA(1, 1, At, B1); PG8_BAR; PG8_SCHED;
            PG8_LDB(B0, 1, 0); PG8_LDB(B1, 1, 1); PG8_SCHED; PG8_LDA(At, 1, 0); PG8_STAGE_A(PG8_SA(0, 1), a2 + hstep, so, 1, kb2);
            PG8_WAIT_V(8); PG8_WAIT_L(0); PG8_BAR; PG8_MMA(0, 0, At, B0); PG8_MMA(0, 1, At, B1); PG8_BAR; PG8_SCHED;
            PG8_LDA(At, 1, 1); PG8_STAGE(PG8_SB(1, 0), b3, voffB); PG8_STAGE(PG8_SB(1, 1), b3 + hstep, voffB); PG8_STAGE_A(PG8_SA(1, 0), a3, so, 0, kb3);
            PG8_WAIT_V(8); PG8_WAIT_L(0); PG8_BAR; PG8_MMA(1, 0, At, B0); PG8_MMA(1, 1, At, B1); PG8_BAR; PG8_SCHED;
        }
        if constexpr (ALIGN_EPI) { if (wr == 0) PG8_BAR; }
        PG8_SCHED; asm volatile("s_nop 15\n\ts_nop 15\n\ts_nop 15\n\ts_nop 15" ::: "memory"); PG8_SCHED;
        E(acc, cur, wr, wc, fr, fq);
        if (!has_next) break;
#pragma unroll
        for (int a = 0; a < 2; ++a)
#pragma unroll
            for (int b = 0; b < 2; ++b)
#pragma unroll
                for (int m = 0; m < 4; ++m)
#pragma unroll
                    for (int n = 0; n < 2; ++n) acc[a][b][m][n] = (f32x4){0.f, 0.f, 0.f, 0.f};
        cur = nxt; cA = nA; cB = nB; ++ui;
#pragma unroll
        for (int _h = 0; _h < 2; ++_h)
#pragma unroll
            for (int _i = 0; _i < 2; ++_i) co[_h][_i] = no[_h][_i];
        if constexpr (ALIGN_EPI) { if (wr == 1) PG8_BAR; }
    }
    PG8_WAIT_V(0);
    if constexpr (!ALIGN_EPI) { if (wr == 0) PG8_BAR; }
    PG8_BAR;
#undef PG8_SA
#undef PG8_SB
#undef PG8_STAGE
#undef PG8_STAGE_A
#undef PG8_LDA
#undef PG8_LDB
#undef PG8_MMA
#undef PG8_WAIT_V
#undef PG8_WAIT_L
#undef PG8_BAR
#undef PG8_SCHED
#undef PG8_GOFFS
}
}
constexpr int NWAVES = 8, NTHR = 512;
constexpr int NB = 4, SEQ = 8192, T = NB * SEQ, D = 1024;
constexpr int HEADS = 24, HD = 64, INNER = 1536, NG = 4, NS = 128, CHUNK = 128, NCHUNK = SEQ / CHUNK, HPG = HEADS / NG;
constexpr int INW = 6704;
constexpr int SRC_DT = 4096, SRC_F = 4144, SRC_G = 4656;
constexpr int NE = 256, TOPK = 8, EH = 256, NEX = NE + 1;
constexpr int PC_Z = 0, PC_X = 1536, PC_B = 3072, PC_C = 3584, PC_FR = 4096, PC_FI = 4608, PC_GS = 5120, PC_GF = 6144, PW = 7168, NPROJ = 7424;
constexpr float RMS_EPS = 1e-6f;
constexpr int ROWS_R = T * TOPK + NE * 256;
constexpr int ROWS_ALL = ROWS_R + T;
constexpr int MAXTILES = ROWS_ALL / 256;

constexpr size_t MiB = 1u << 20;
constexpr size_t WS_CTL = 0, CTL_ZERO_BYTES = 1 * MiB;
constexpr size_t WS_MOD = 1 * MiB;
constexpr size_t WS_TW = WS_MOD + 128 * 1024;
constexpr size_t WS_WM1 = WS_TW + 64 * 1024;
constexpr size_t WS_WM2 = WS_WM1 + 32 * 1024;
constexpr size_t WS_CD = WS_WM2 + 64 * 1024;
constexpr size_t WS_BCNT = 2 * MiB;
constexpr size_t WS_TILEE = WS_BCNT + 256 * 1024;
constexpr size_t WS_WINT = 4 * MiB;
constexpr size_t WS_WBST = 19 * MiB;
constexpr size_t WS_WBFT = 22 * MiB;
constexpr size_t WS_WOUTT = 23 * MiB;
constexpr size_t WS_WRT = 25 * MiB;
constexpr size_t WS_W13T = 26 * MiB;
constexpr size_t WS_W2T = 283 * MiB;
constexpr size_t WS_H = 412 * MiB;
constexpr size_t WS_PROJ = 476 * MiB;
constexpr size_t WS_DT = 924 * MiB;
constexpr size_t WS_ST = 932 * MiB;
constexpr size_t WS_YN = 1124 * MiB;
constexpr size_t WS_GB = 1220 * MiB;
constexpr size_t WS_FO = 1284 * MiB;
constexpr size_t WS_MIX = 1316 * MiB;
constexpr size_t WS_MIXED = 1380 * MiB;
constexpr size_t WS_LOG = 1444 * MiB;
constexpr size_t WS_TOPI = 1476 * MiB, WS_TOPW = 1477 * MiB, WS_TOKPOS = 1478 * MiB, WS_ROWTOK = 1479 * MiB;
constexpr size_t WS_HB = 1481 * MiB;
constexpr size_t WS_YB = 476 * MiB;
constexpr size_t WS_END = 1657 * MiB;
static_assert(WS_YB + (size_t)ROWS_ALL * 1024 * 2 <= WS_YN + (size_t)T * 1536 * 2, "YB overlay must end inside PROJ..YN");
constexpr int CW_ERR = 16;
constexpr int CW_NTILES = 64, CW_BASESH = 65;
constexpr int CW_BAR = 4096;
#define XCD_BAR_WORDS 3456
static_assert((CW_BAR + XCD_BAR_WORDS) * 4 <= (int)CTL_ZERO_BYTES, "ctl");

constexpr int LDS_BYTES = 160 * 1024;
constexpr int MISC_OFF = LDS_BYTES - 256;

#define GAS __attribute__((address_space(1)))
#define LAS __attribute__((address_space(3)))
typedef unsigned short bf16;
typedef unsigned v4u __attribute__((ext_vector_type(4)));
typedef unsigned v2u __attribute__((ext_vector_type(2)));
typedef float f32x4 __attribute__((ext_vector_type(4)));
typedef float f32x2 __attribute__((ext_vector_type(2)));
typedef short bf16x8 __attribute__((ext_vector_type(8)));
typedef GAS unsigned gu32;
#define RLX_AGENT __ATOMIC_RELAXED, __HIP_MEMORY_SCOPE_AGENT
#define LDS_WAIT() asm volatile("s_waitcnt lgkmcnt(0)" ::: "memory")
#define VM_WAIT() asm volatile("s_waitcnt vmcnt(0)" ::: "memory")
__device__ __forceinline__ unsigned f2bf(float f) { unsigned u = __builtin_bit_cast(unsigned, f); return (u + 0x7fffu + ((u >> 16) & 1u)) >> 16; }
__device__ __forceinline__ unsigned pk2(float lo, float hi) { unsigned r; asm volatile("v_cvt_pk_bf16_f32 %0, %1, %2" : "=v"(r) : "v"(lo), "v"(hi)); return r; }
__device__ __forceinline__ float bflo(unsigned w) { return __uint_as_float(w << 16); }
__device__ __forceinline__ float bfhi(unsigned w) { return __uint_as_float(w & 0xffff0000u); }
__device__ __forceinline__ float bf2f(bf16 b) { return __uint_as_float(((unsigned)b) << 16); }
__device__ __forceinline__ float siluf_(float x) { return x * __builtin_amdgcn_rcpf(1.f + __expf(-x)); }
__device__ __forceinline__ float softplusf_(float x) { return x > 20.f ? x : log1pf(expf(x)); }
__device__ __forceinline__ float wave_sum(float v) {
#pragma unroll
    for (int o = 1; o < 64; o <<= 1) v += __shfl_xor(v, o);
    return v;
}

#define XB_TMO      128
#define XB_XCNT(j)  (256  + 64 * (j))
#define XB_XSUB(j)  (1280 + 64 * (j))
#define XB_XGEN(j)  (2304 + 64 * (j))
#define XB_TOP      3328
#define XB_TOPGEN   3392
#define XB_SPIN_CAP (1u << 18)
__device__ __forceinline__ unsigned xb_ld(unsigned* p)              { return __hip_atomic_load(p, __ATOMIC_RELAXED, __HIP_MEMORY_SCOPE_AGENT); }
__device__ __forceinline__ unsigned xb_add(unsigned* p, unsigned v) { return __hip_atomic_fetch_add(p, v, __ATOMIC_RELAXED, __HIP_MEMORY_SCOPE_AGENT); }
__device__ __forceinline__ unsigned xb_xcc_id() { return (unsigned)__builtin_amdgcn_s_getreg((3 << 11) | 20) & 0xFu; }
#define XB_SPIN(cond, bar) do { unsigned _sp = 0; while (cond) { __builtin_amdgcn_s_sleep(1); \
    if ((++_sp & 255u) == 0u) { if (xb_ld(&(bar)[XB_TMO])) break; if (_sp > XB_SPIN_CAP) { atomicAdd(&(bar)[XB_TMO], 1u); break; } } } } while (0)
struct XcdBarrier { unsigned* bar; unsigned x; volatile LAS unsigned* st; };
__device__ __forceinline__ XcdBarrier xcd_barrier_post(unsigned* bar, volatile LAS unsigned* st) {
    XcdBarrier b; b.bar = bar; b.x = xb_xcc_id(); b.st = st;
    if (threadIdx.x == 0) (void)xb_add(&bar[XB_XCNT(b.x)], 1u);
    return b;
}
__device__ __forceinline__ void xcd_barrier_complete(unsigned* bar, unsigned x, unsigned& nloc, unsigned& nx) {
    const unsigned G = gridDim.x * gridDim.y * gridDim.z;
    unsigned sum, cnt, mine, sp = 0u;
    for (;;) {
        sum = 0u; cnt = 0u; mine = 0u;
#pragma unroll
        for (unsigned j = 0; j < 16; ++j) { const unsigned c = xb_ld(&bar[XB_XCNT(j)]); sum += c; cnt += (c > 0u) ? 1u : 0u; mine = (j == x) ? c : mine; }
        if (sum == G) break;
        __builtin_amdgcn_s_sleep(1);
        if ((++sp & 255u) == 0u) { if (xb_ld(&bar[XB_TMO])) break; if (sp > XB_SPIN_CAP) { atomicAdd(&bar[XB_TMO], 1u); break; } }
    }
    nloc = mine > 0u ? mine : 1u; nx = cnt > 0u ? cnt : 1u;
}
__device__ __forceinline__ void xcd_barrier(const XcdBarrier& b) {
    asm volatile("s_waitcnt vmcnt(0)" ::: "memory");
    __syncthreads();
    if (threadIdx.x == 0) {
        unsigned* bar = b.bar;
        __builtin_amdgcn_s_waitcnt(0);
        unsigned nloc = b.st[0], nx = b.st[1];
        if (nloc == 0u) { xcd_barrier_complete(bar, b.x, nloc, nx); b.st[0] = nloc; b.st[1] = nx; }
        const unsigned old = xb_add(&bar[XB_XSUB(b.x)], 1u);
        const unsigned gen = old / nloc;
        if (old + 1u == (gen + 1u) * nloc) {
            __builtin_amdgcn_fence(__ATOMIC_RELEASE, "agent");
            asm volatile("s_waitcnt vmcnt(0)" ::: "memory");
            const unsigned og = xb_add(&bar[XB_TOP], 1u);
            const unsigned tg = og / nx;
            if (og + 1u == (tg + 1u) * nx) xb_add(&bar[XB_TOPGEN], 1u);
            else XB_SPIN(xb_ld(&bar[XB_TOPGEN]) == tg, bar);
            __builtin_amdgcn_fence(__ATOMIC_ACQUIRE, "agent");
            xb_add(&bar[XB_XGEN(b.x)], 1u);
            asm volatile("s_waitcnt vmcnt(0)" ::: "memory");
        } else {
            XB_SPIN(xb_ld(&bar[XB_XGEN(b.x)]) == gen, bar);
            __builtin_amdgcn_fence(__ATOMIC_ACQUIRE, "agent");
            asm volatile("s_waitcnt vmcnt(0)" ::: "memory");
        }
    }
    __syncthreads();
}

struct Frame {
    LAS unsigned char* lds;
    gu32* ctl;
    unsigned char* ws;
    int tid, lane, wave, G, bx;
    float* out;
};
#define FIN(i) (((const float* const __attribute__((address_space(4)))*)__builtin_amdgcn_kernarg_segment_ptr())[i])
#define WSP(T_, off) ((T_*)(F.ws + (off)))

__device__ __forceinline__ bf16x8 ldfrag(const LAS unsigned char* base, int pitchB, int row, int kel) { return *(const LAS bf16x8*)(base + row * pitchB + kel * 2); }
__device__ __forceinline__ void tr_item(const float* W, int K, int Nsrc, int k0, int scol0, int nvalid, bf16* WT, size_t drow0, const float* kscale, LAS float* scr, int lane) {
    const int n4 = (lane & 15) * 4, kr = lane >> 4; const bool ok = n4 < nvalid;
    f32x4 v[16];
#pragma unroll
    for (int i = 0; i < 16; ++i) { const int kk = 4 * i + kr; v[i] = ok ? *(const GAS f32x4*)(W + (size_t)(k0 + kk) * Nsrc + scol0 + n4) : (f32x4){0.f, 0.f, 0.f, 0.f}; }
#pragma unroll
    for (int i = 0; i < 16; ++i) { const int kk = 4 * i + kr; f32x4 x = v[i]; if (kscale) x = x * kscale[k0 + kk]; LAS float* d = scr + kk * 65 + n4; d[0] = x.x; d[1] = x.y; d[2] = x.z; d[3] = x.w; }
    LDS_WAIT(); asm volatile("" ::: "memory");
    const int c = lane & 7;
#pragma unroll
    for (int j = 0; j < 8; ++j) { const int n = (lane >> 3) + 8 * j; const LAS float* s = scr + (8 * c) * 65 + n;
        v4u o; o.x = pk2(s[0 * 65], s[1 * 65]); o.y = pk2(s[2 * 65], s[3 * 65]); o.z = pk2(s[4 * 65], s[5 * 65]); o.w = pk2(s[6 * 65], s[7 * 65]);
        *(GAS v4u*)(WT + (drow0 + n) * (size_t)K + k0 + 8 * c) = o; }
    LDS_WAIT(); asm volatile("" ::: "memory");
}

__device__ __forceinline__ void phase_prologue(Frame& F) {
    const float* c_in = FIN(1); const float* w_ada = FIN(2); const float* b_ada = FIN(3);
    const float* w_in = FIN(8);
    for (int it = F.bx; it < 160; it += F.G) {
        __syncthreads();
        if (it < 96) {
            LAS float* sc = (LAS float*)(F.lds);
            LAS float* red = (LAS float*)(F.lds + 16384);
            for (int i = F.tid; i < 4096; i += NTHR) sc[i] = siluf_(c_in[i]);
            __syncthreads();
            const int col = it * 64 + F.lane; float a0 = 0.f, a1 = 0.f, a2 = 0.f, a3 = 0.f;
            const int kb = F.wave * 128;
#pragma unroll 8
            for (int k = 0; k < 128; ++k) { const float w = w_ada[(size_t)(kb + k) * 6144 + col]; a0 += sc[kb + k] * w; a1 += sc[1024 + kb + k] * w; a2 += sc[2048 + kb + k] * w; a3 += sc[3072 + kb + k] * w; }
            red[(F.wave * 4 + 0) * 64 + F.lane] = a0; red[(F.wave * 4 + 1) * 64 + F.lane] = a1; red[(F.wave * 4 + 2) * 64 + F.lane] = a2; red[(F.wave * 4 + 3) * 64 + F.lane] = a3;
            __syncthreads();
            if (F.tid < 256) { const int b = F.tid >> 6, l = F.tid & 63; float s = b_ada[it * 64 + l];
#pragma unroll
                for (int w = 0; w < 8; ++w) s += red[(w * 4 + b) * 64 + l];
                WSP(float, WS_MOD)[b * 6144 + it * 64 + l] = s; }
        } else {
            const int it2 = it - 96, kb = it2 >> 2, g = it2 & 3;
            LAS float* Wt = (LAS float*)(F.lds);
            LAS float* cs = (LAS float*)(F.lds + 64 * 129 * 4);
            LAS float* sn = cs + 128;
            for (int i = F.tid; i < 8192; i += NTHR) { const int kk = i >> 7, c = i & 127; Wt[kk * 129 + c] = w_in[(size_t)(kb * 64 + kk) * INW + SRC_F + g * 128 + c]; }
            if (F.tid < 128) { float s_, c_; sincospif((float)F.tid / 64.f, &s_, &c_); cs[F.tid] = c_; sn[F.tid] = s_; }
            __syncthreads();
            const int kk = F.lane; bf16* WINT = WSP(bf16, WS_WINT);
            for (int q = 0; q < 16; ++q) { const int j = F.wave + 8 * q; float ar = 0.f, ai = 0.f;
#pragma unroll 8
                for (int c = 0; c < 128; ++c) { const float w = Wt[kk * 129 + c]; const int id = (c * j) & 127; ar += w * cs[id]; ai -= w * sn[id]; }
                const float sc_ = 0.08838834764831845f;
                WINT[(size_t)(PC_FR + g * 128 + j) * 1024 + kb * 64 + kk] = (bf16)f2bf(ar * sc_);
                WINT[(size_t)(PC_FI + g * 128 + j) * 1024 + kb * 64 + kk] = (bf16)f2bf(ai * sc_); }
        }
    }
    __syncthreads();
    const int gt = F.bx * NTHR + F.tid, NGT = F.G * NTHR;
    for (int i = gt; i < 8192; i += NGT) { float s_, c_; sincospif((float)i / 4096.f, &s_, &c_); WSP(f32x2, WS_TW)[i] = (f32x2){c_, s_}; }
    for (int i = gt; i < 128 * 128; i += NGT) { const int m = i >> 7, k = i & 127; const int k1 = m & 63, s1 = k & 63; float s_, c_; sincospif((float)((k1 * s1) & 63) / 32.f, &s_, &c_);
        float v; if (m < 64) v = (k < 64) ? c_ : s_; else v = (k < 64) ? -s_ : c_;
        WSP(bf16, WS_WM1)[i] = (bf16)f2bf(v * 0.125f); }
    for (int i = gt; i < 128 * 256; i += NGT) { const int k2 = i >> 8, k = i & 255; const int s2 = k & 127; float s_, c_; sincospif((float)((k2 * s2) & 127) / 64.f, &s_, &c_);
        WSP(bf16, WS_WM2)[i] = (bf16)f2bf(((k < 128) ? c_ : s_) * 0.08838834764831845f); }
    LAS float* scr = (LAS float*)(F.lds + F.wave * 16896);
    const int gw = F.bx * NWAVES + F.wave, NGW = F.G * NWAVES;
    constexpr int I_IN = 100 * 16, I_BS = 24 * 16, I_BF = 8 * 16, I_OUT = 16 * 16, I_R = 16 * 4, I_13 = NEX * 128, I_2 = NEX * 64;
    constexpr int NITEMS = I_IN + I_BS + I_BF + I_OUT + I_R + I_13 + I_2;
    for (int it = gw; it < NITEMS; it += NGW) {
        int r = it;
        if (r < I_IN) { const int kb = r / 100, db = r % 100; const int d0 = (db < 64) ? db * 64 : 5120 + (db - 64) * 64; int src, nv = 64;
            if (d0 < 4096) src = d0; else if (d0 < 7168) src = SRC_G + (d0 - 5120); else { src = SRC_DT + (d0 - 7168); nv = 48 - (d0 - 7168); nv = nv < 0 ? 0 : (nv > 64 ? 64 : nv); }
            tr_item(w_in, 1024, INW, kb * 64, src, nv, WSP(bf16, WS_WINT), (size_t)d0, nullptr, scr, F.lane); continue; } r -= I_IN;
        if (r < I_BS) { const int kb = r / 16, nb = r % 16; tr_item(FIN(17), 1536, 1024, kb * 64, nb * 64, 64, WSP(bf16, WS_WBST), (size_t)nb * 64, FIN(16), scr, F.lane); continue; } r -= I_BS;
        if (r < I_BF) { const int kb = r / 16, nb = r % 16; tr_item(FIN(18), 512, 1024, kb * 64, nb * 64, 64, WSP(bf16, WS_WBFT), (size_t)nb * 64, nullptr, scr, F.lane); continue; } r -= I_BF;
        if (r < I_OUT) { const int kb = r / 16, nb = r % 16; tr_item(FIN(19), 1024, 1024, kb * 64, nb * 64, 64, WSP(bf16, WS_WOUTT), (size_t)nb * 64, nullptr, scr, F.lane); continue; } r -= I_OUT;
        if (r < I_R) { const int kb = r / 4, nb = r % 4; tr_item(FIN(20), 1024, 256, kb * 64, nb * 64, 64, WSP(bf16, WS_WRT), (size_t)nb * 64, nullptr, scr, F.lane); continue; } r -= I_R;
        if (r < I_13) { const int e = r >> 7, q = r & 127, kb = q >> 3, db = q & 7; const int rho0 = db * 64, pn = rho0 >> 8, bj = (rho0 >> 7) & 1, jj = rho0 & 127;
            const float* src = (e < NE) ? FIN(22) + (size_t)e * 1024 * 512 : FIN(24);
            tr_item(src, 1024, 512, kb * 64, bj * 256 + pn * 128 + jj, 64, WSP(bf16, WS_W13T), (size_t)e * 512 + rho0, nullptr, scr, F.lane); continue; } r -= I_13;
        { const int e = r >> 6, q = r & 63, kb = q >> 4, nb = q & 15;
            const float* src = (e < NE) ? FIN(23) + (size_t)e * 256 * 1024 : FIN(25);
            tr_item(src, 256, 1024, kb * 64, nb * 64, 64, WSP(bf16, WS_W2T), (size_t)e * 1024 + nb * 64, nullptr, scr, F.lane); }
    }
}

__device__ __forceinline__ void phase_norm1(Frame& F) {
    LAS float* GS = (LAS float*)(F.lds); LAS float* SH = GS + 4096;
    const float* mod = WSP(float, WS_MOD); const float* g = FIN(4);
    for (int i = F.tid; i < 4096; i += NTHR) { const int b = i >> 10, col = i & 1023; GS[i] = g[col] * (1.f + mod[b * 6144 + 1024 + col]); SH[i] = mod[b * 6144 + col]; }
    __syncthreads();
    const int gw = F.bx * NWAVES + F.wave, NGW = F.G * NWAVES; const float* x = FIN(0); bf16* H = WSP(bf16, WS_H);
    for (int m = gw; m < T; m += NGW) { const int b = m / SEQ;
        const GAS f32x4* xr = (const GAS f32x4*)(x + (size_t)m * D) + F.lane; f32x4 v[4]; float ss = 0.f;
#pragma unroll
        for (int j = 0; j < 4; ++j) { v[j] = xr[64 * j]; ss += (v[j].x * v[j].x + v[j].y * v[j].y) + (v[j].z * v[j].z + v[j].w * v[j].w); }
        const float rstd = 1.f / sqrtf(wave_sum(ss) * (1.f / D) + RMS_EPS);
        GAS unsigned long long* o8 = (GAS unsigned long long*)(H + (size_t)m * D) + F.lane;
#pragma unroll
        for (int j = 0; j < 4; ++j) { const int col = 4 * F.lane + 256 * j; const LAS float* gs = GS + b * 1024 + col; const LAS float* sh = SH + b * 1024 + col;
            o8[64 * j] = (unsigned long long)pk2(v[j].x * rstd * gs[0] + sh[0], v[j].y * rstd * gs[1] + sh[1]) | ((unsigned long long)pk2(v[j].z * rstd * gs[2] + sh[2], v[j].w * rstd * gs[3] + sh[3]) << 32); }
    }
}

#define MFMA_BEGIN() do { asm volatile("s_waitcnt lgkmcnt(0)" ::: "memory"); __builtin_amdgcn_sched_barrier(0); } while (0)
#define MFMA_END() do { __builtin_amdgcn_sched_barrier(0); asm volatile("s_nop 15\n\ts_nop 15\n\ts_nop 15\n\ts_nop 15" ::: "memory"); __builtin_amdgcn_sched_barrier(0); } while (0)
#define MFMA_END2() do { __builtin_amdgcn_sched_barrier(0); asm volatile("s_nop 15\n\ts_nop 15" ::: "memory"); __builtin_amdgcn_sched_barrier(0); } while (0)
#define LDS_BARRIER() do { asm volatile("s_waitcnt lgkmcnt(0)" ::: "memory"); __builtin_amdgcn_s_barrier(); asm volatile("" ::: "memory"); } while (0)
constexpr int PT = 272;
__device__ __forceinline__ void wave_scan128(float a0, float a1, int lane, float& i0, float& i1, float& tot) {
    float p = a0 + a1;
#pragma unroll
    for (int o = 1; o < 64; o <<= 1) { const float t = __shfl_up(p, o); if (lane >= o) p += t; }
    i1 = p; i0 = p - a1; tot = __shfl(p, 63);
}
__device__ __forceinline__ void raw_load(unsigned (&r)[12], const bf16* P, int b, int c, int col, int tid) {
    const int pp = tid & 31, sr = tid >> 5;
#pragma unroll
    for (int i = 0; i < 12; ++i) { const int s = c * CHUNK + 8 * sr - 2 + i; r[i] = (s >= 0 && s < SEQ) ? *(const GAS unsigned*)(P + (size_t)(b * SEQ + s) * PW + col + 2 * pp) : 0u; }
}
__device__ __forceinline__ void conv8(const unsigned (&r)[12], const LAS float* cw, int nch, int chl, float (&o0)[8], float (&o1)[8]) {
    float w0[5], w1[5];
#pragma unroll
    for (int i = 0; i < 5; ++i) { const f32x2 w = *(const LAS f32x2*)(cw + i * nch + chl); w0[i] = w.x; w1[i] = w.y; }
    const f32x2 bb = *(const LAS f32x2*)(cw + 5 * nch + chl);
#pragma unroll
    for (int j = 0; j < 8; ++j) { float a = bb.x, d = bb.y;
#pragma unroll
        for (int i = 0; i < 5; ++i) { a += w0[i] * bflo(r[j + i]); d += w1[i] * bfhi(r[j + i]); }
        o0[j] = siluf_(a); o1[j] = siluf_(d); }
}
__device__ __forceinline__ void store_T(LAS unsigned char* dst, int ch, int s0, const float (&o0)[8], const float (&o1)[8], const LAS float* sc) {
    float k[8];
    if (sc) { const f32x4 a = *(const LAS f32x4*)(sc + s0), d = *(const LAS f32x4*)(sc + s0 + 4); k[0] = a.x; k[1] = a.y; k[2] = a.z; k[3] = a.w; k[4] = d.x; k[5] = d.y; k[6] = d.z; k[7] = d.w; }
    else {
#pragma unroll
        for (int j = 0; j < 8; ++j) k[j] = 1.f; }
    v4u w0, w1;
    w0.x = pk2(o0[0] * k[0], o0[1] * k[1]); w0.y = pk2(o0[2] * k[2], o0[3] * k[3]); w0.z = pk2(o0[4] * k[4], o0[5] * k[5]); w0.w = pk2(o0[6] * k[6], o0[7] * k[7]);
    w1.x = pk2(o1[0] * k[0], o1[1] * k[1]); w1.y = pk2(o1[2] * k[2], o1[3] * k[3]); w1.z = pk2(o1[4] * k[4], o1[5] * k[5]); w1.w = pk2(o1[6] * k[6], o1[7] * k[7]);
    *(LAS v4u*)(dst + ch * PT + s0 * 2) = w0; *(LAS v4u*)(dst + (ch + 1) * PT + s0 * 2) = w1;
}
__device__ __forceinline__ void head_vec(Frame& F, int b, int c, int h, int d, float& dt0, float& dt1, float& ac0, float& ac1, float& ex0, float& ex1, float& tot) {
    const float* DTR = WSP(float, WS_DT); const float bias = d ? FIN(12)[h] : FIN(11)[h]; const float A = -expf(d ? FIN(14)[h] : FIN(13)[h]);
    const size_t row = (size_t)(b * SEQ + c * CHUNK + 2 * F.lane);
    dt0 = softplusf_(DTR[row * 64 + d * 24 + h] + bias); dt1 = softplusf_(DTR[(row + 1) * 64 + d * 24 + h] + bias);
    const float a0 = A * dt0, a1 = A * dt1; float i0, i1;
    wave_scan128(a0, a1, F.lane, i0, i1, tot);
    ex0 = i0 - a0; ex1 = i1 - a1;
    if (d == 0) { ac0 = i0; ac1 = i1; } else { ac0 = tot - ex0; ac1 = tot - ex1; }
}

__device__ __forceinline__ void phase_states(Frame& F) {
    LAS unsigned char* BT = F.lds;
    LAS unsigned char* XTB = F.lds + 34816;
    LAS float* CWA = (LAS float*)(F.lds + 104448);
    LAS float* WSF = (LAS float*)(F.lds + 116736);
    LAS float* WSB = WSF + 768;
    const bf16* P = WSP(bf16, WS_PROJ); bf16* ST = WSP(bf16, WS_ST); float* CD = WSP(float, WS_CD);
    const int fr = F.lane & 15, fq = F.lane >> 4, pp = F.tid & 31, sr = F.tid >> 5;
    int gtab = -1;
    for (int u = F.bx; u < NB * NCHUNK * NG; u += F.G) {
        const int g = u & 3, c = (u >> 2) & 63, b = u >> 8;
        LDS_BARRIER();
        if (g != gtab) { gtab = g;
            for (int i = F.tid; i < 6 * 512; i += NTHR) { const int t = i >> 9, ch = i & 511; const int xc = ch < 384 ? g * 384 + ch : 1536 + g * 128 + (ch - 384);
                CWA[i] = t < 5 ? FIN(9)[t * 2560 + xc] : FIN(10)[xc]; } }
        if (F.wave < HPG) { const int h = g * HPG + F.wave;
#pragma unroll
            for (int d = 0; d < 2; ++d) { float dt0, dt1, ac0, ac1, ex0, ex1, tot; head_vec(F, b, c, h, d, dt0, dt1, ac0, ac1, ex0, ex1, tot);
                LAS float* W = (d ? WSB : WSF) + F.wave * 128 + 2 * F.lane;
                if (d == 0) { W[0] = dt0 * __expf(tot - ac0); W[1] = dt1 * __expf(tot - ac1); } else { W[0] = dt0 * __expf(ex0); W[1] = dt1 * __expf(ex1); }
                if (F.lane == 0) CD[((size_t)(b * NCHUNK + c) * HEADS + h) * 2 + d] = __expf(tot); } }
        unsigned rc[12], rn[12];
        raw_load(rc, P, b, c, PC_B + g * 128, F.tid);
        LDS_BARRIER();
#pragma unroll 1
        for (int pc = 0; pc < 8; ++pc) {
            if (pc < 7) { const int col = (pc + 1 < 2) ? PC_B + g * 128 + 64 : PC_X + (g * HPG + (pc + 1 - 2)) * 64; raw_load(rn, P, b, c, col, F.tid); }
            float o0[8], o1[8];
            if (pc < 2) { conv8(rc, CWA, 512, 384 + pc * 64 + 2 * pp, o0, o1); store_T(BT + pc * 64 * PT, 2 * pp, 8 * sr, o0, o1, nullptr); }
            else { const int hh = pc - 2; conv8(rc, CWA, 512, hh * 64 + 2 * pp, o0, o1);
                LAS unsigned char* xf = XTB + ((hh & 1) * 2) * 17408; store_T(xf, 2 * pp, 8 * sr, o0, o1, WSF + hh * 128); store_T(xf + 17408, 2 * pp, 8 * sr, o0, o1, WSB + hh * 128); }
            LDS_BARRIER();
            if (pc >= 2) { const int hh = pc - 2, h = g * HPG + hh; const LAS unsigned char* xf = XTB + ((hh & 1) * 2) * 17408;
                const int ptile = F.wave & 3, nt0 = 4 * (F.wave >> 2);
                f32x4 af[4], ab[4];
#pragma unroll
                for (int j = 0; j < 4; ++j) { af[j] = (f32x4){0.f, 0.f, 0.f, 0.f}; ab[j] = (f32x4){0.f, 0.f, 0.f, 0.f}; }
#pragma unroll
                for (int half = 0; half < 2; ++half) { bf16x8 qf[2], qb[2], pf[2][4];
#pragma unroll
                    for (int k2 = 0; k2 < 2; ++k2) { const int kk = 2 * half + k2; qf[k2] = ldfrag(xf, PT, 16 * ptile + fr, 32 * kk + 8 * fq); qb[k2] = ldfrag(xf + 17408, PT, 16 * ptile + fr, 32 * kk + 8 * fq);
#pragma unroll
                        for (int j = 0; j < 4; ++j) pf[k2][j] = ldfrag(BT, PT, 16 * (nt0 + j) + fr, 32 * kk + 8 * fq); }
                    MFMA_BEGIN();
#pragma unroll
                    for (int k2 = 0; k2 < 2; ++k2)
#pragma unroll
                        for (int j = 0; j < 4; ++j) { af[j] = __builtin_amdgcn_mfma_f32_16x16x32_bf16(pf[k2][j], qf[k2], af[j], 0, 0, 0); ab[j] = __builtin_amdgcn_mfma_f32_16x16x32_bf16(pf[k2][j], qb[k2], ab[j], 0, 0, 0); }
                    MFMA_END(); }
                bf16* so = ST + ((size_t)((b * NCHUNK + c) * HEADS + h) * 2) * 8192 + (16 * ptile + fr) * 128;
#pragma unroll
                for (int j = 0; j < 4; ++j) { v2u w; w.x = pk2(af[j][0], af[j][1]); w.y = pk2(af[j][2], af[j][3]); *(GAS v2u*)(so + 16 * (nt0 + j) + 4 * fq) = w;
                    w.x = pk2(ab[j][0], ab[j][1]); w.y = pk2(ab[j][2], ab[j][3]); *(GAS v2u*)(so + 8192 + 16 * (nt0 + j) + 4 * fq) = w; }
            }
#pragma unroll
            for (int i = 0; i < 12; ++i) rc[i] = rn[i];
        }
    }
}

__device__ __forceinline__ void phase_scan(Frame& F) {
    bf16* ST = WSP(bf16, WS_ST); const float* CD = WSP(float, WS_CD);
    const int gt = F.bx * NTHR + F.tid, NGT = F.G * NTHR;
    for (int e = gt; e < NB * HEADS * 2 * 2048; e += NGT) {
        const int q4 = e & 2047, d = (e >> 11) & 1, bh = e >> 12, h = bh % HEADS, b = bh / HEADS;
        f32x4 prev = (f32x4){0.f, 0.f, 0.f, 0.f};
        for (int c0 = 0; c0 < NCHUNK; c0 += 8) {
            v2u st[8]; float dec[8];
#pragma unroll
            for (int i = 0; i < 8; ++i) { const int c = d ? (NCHUNK - 1 - (c0 + i)) : (c0 + i); const size_t si = ((size_t)((b * NCHUNK + c) * HEADS + h) * 2 + d);
                st[i] = *(const GAS v2u*)(ST + si * 8192 + q4 * 4); dec[i] = CD[si]; }
#pragma unroll
            for (int i = 0; i < 8; ++i) { const int c = d ? (NCHUNK - 1 - (c0 + i)) : (c0 + i); const size_t si = ((size_t)((b * NCHUNK + c) * HEADS + h) * 2 + d);
                v2u w; w.x = pk2(prev[0], prev[1]); w.y = pk2(prev[2], prev[3]); *(GAS v2u*)(ST + si * 8192 + q4 * 4) = w;
                prev[0] = prev[0] * dec[i] + bflo(st[i].x); prev[1] = prev[1] * dec[i] + bfhi(st[i].x); prev[2] = prev[2] * dec[i] + bflo(st[i].y); prev[3] = prev[3] * dec[i] + bfhi(st[i].y); }
        }
    }
}

__device__ __forceinline__ void phase_ssd_out(Frame& F) {
    LAS unsigned char* CS = F.lds;
    LAS unsigned char* BS = F.lds + 34816;
    LAS unsigned char* XTB = F.lds + 69632;
    LAS unsigned char* PVB = F.lds + 104448;
    LAS float* CWX = (LAS float*)(F.lds + 139264);
    LAS float* DTF = (LAS float*)(F.lds + 148480);
    LAS float* DTB = DTF + 768; LAS float* ACF = DTB + 768; LAS float* ACB = ACF + 768;
    LAS float* CWBC = (LAS float*)XTB;
    const bf16* ST = WSP(bf16, WS_ST); const bf16* P = WSP(bf16, WS_PROJ); bf16* YN = WSP(bf16, WS_YN);
    const int fr = F.lane & 15, fq = F.lane >> 4, w = F.wave, pp = F.tid & 31, sr = F.tid >> 5;
    LAS unsigned char* LB = BS + w * 16 * PT;
    int gtab = -1;
    for (int u = F.bx; u < NB * NCHUNK * NG; u += F.G) {
        const int g = u & 3, c = (u >> 2) & 63, b = u >> 8;
        unsigned rbc[4][12];
#pragma unroll
        for (int pc = 0; pc < 4; ++pc) raw_load(rbc[pc], P, b, c, ((pc >> 1) ? PC_C : PC_B) + g * 128 + (pc & 1) * 64, F.tid);
        LDS_BARRIER();
        if (g != gtab) { gtab = g; for (int i = F.tid; i < 6 * 384; i += NTHR) { const int t = i / 384, ch = i % 384; CWX[i] = t < 5 ? FIN(9)[t * 2560 + g * 384 + ch] : FIN(10)[g * 384 + ch]; } }
        for (int i = F.tid; i < 6 * 256; i += NTHR) { const int t = i >> 8, ch = i & 255; const int xc = 1536 + (ch >> 7) * 512 + g * 128 + (ch & 127); CWBC[i] = t < 5 ? FIN(9)[t * 2560 + xc] : FIN(10)[xc]; }
        if (w < HPG) { const int h = g * HPG + w;
#pragma unroll
            for (int d = 0; d < 2; ++d) { float dt0, dt1, ac0, ac1, ex0, ex1, tot; head_vec(F, b, c, h, d, dt0, dt1, ac0, ac1, ex0, ex1, tot);
                LAS float* D_ = (d ? DTB : DTF) + w * 128 + 2 * F.lane; LAS float* A_ = (d ? ACB : ACF) + w * 128 + 2 * F.lane; D_[0] = dt0; D_[1] = dt1; A_[0] = ac0; A_[1] = ac1; } }
        LDS_BARRIER();
        {
#pragma unroll
            for (int pc = 0; pc < 4; ++pc) { const int isC = pc >> 1, half = pc & 1;
                float o0[8], o1[8]; conv8(rbc[pc], CWBC, 256, isC * 128 + half * 64 + 2 * pp, o0, o1);
                LAS unsigned char* dst = (isC ? CS : BS) + (half * 64 + 2 * pp) * 2;
#pragma unroll
                for (int j = 0; j < 8; ++j) *(LAS unsigned*)(dst + (8 * sr + j) * PT) = pk2(o0[j], o1[j]); } }
        unsigned rx[12];
        raw_load(rx, P, b, c, PC_X + (g * HPG) * 64, F.tid);
        LDS_BARRIER();
        f32x4 cb[8];
#pragma unroll
        for (int t = 0; t < 8; ++t) cb[t] = (f32x4){0.f, 0.f, 0.f, 0.f};
#pragma unroll
        for (int kk = 0; kk < 4; ++kk) { const bf16x8 q = ldfrag(CS, PT, 16 * w + fr, 32 * kk + 8 * fq); bf16x8 pf[8];
#pragma unroll
            for (int t = 0; t < 8; ++t) pf[t] = ldfrag(BS, PT, 16 * t + fr, 32 * kk + 8 * fq);
            MFMA_BEGIN();
#pragma unroll
            for (int t = 0; t < 8; ++t) cb[t] = __builtin_amdgcn_mfma_f32_16x16x32_bf16(pf[t], q, cb[t], 0, 0, 0);
            MFMA_END(); }
        LDS_BARRIER();
        const int l = 16 * w + fr;
        float ssq = 0.f;
        v4u pv0, pv1; { const bf16* src = ST + ((size_t)((b * NCHUNK + c) * HEADS + g * HPG) * 2) * 8192; pv0 = *(const GAS v4u*)(src + F.tid * 8); pv1 = *(const GAS v4u*)(src + 4096 + F.tid * 8); }
#pragma unroll 1
        for (int hh = 0; hh < HPG; ++hh) { const int h = g * HPG + hh;
            LAS unsigned char* XT = XTB + (hh & 1) * 17408;
            { float o0[8], o1[8]; conv8(rx, CWX, 384, hh * 64 + 2 * pp, o0, o1); store_T(XT, 2 * pp, 8 * sr, o0, o1, nullptr); }
            if (hh + 1 < HPG) raw_load(rx, P, b, c, PC_X + (h + 1) * 64, F.tid);
            f32x4 Y[4];
#pragma unroll
            for (int pt = 0; pt < 4; ++pt) Y[pt] = (f32x4){0.f, 0.f, 0.f, 0.f};
            const float dsk = FIN(15)[h];
            v2u zw[4]; { const bf16* zrow = P + (size_t)(b * SEQ + c * CHUNK + l) * PW + PC_Z + h * 64;
#pragma unroll
                for (int pt = 0; pt < 4; ++pt) zw[pt] = *(const GAS v2u*)(zrow + 16 * pt + 4 * fq); }
#pragma unroll 1
            for (int d = 0; d < 2; ++d) {
                LAS unsigned char* PV = PVB + d * 17408;
                const LAS float* AC = (d ? ACB : ACF) + hh * 128; const LAS float* DT_ = (d ? DTB : DTF) + hh * 128;
                const float al = AC[l];
#pragma unroll
                for (int t = 0; t < 8; ++t) { float o[4]; const f32x4 as = *(const LAS f32x4*)(AC + 16 * t + 4 * fq), ds = *(const LAS f32x4*)(DT_ + 16 * t + 4 * fq);
#pragma unroll
                    for (int r = 0; r < 4; ++r) { const int s = 16 * t + 4 * fq + r; const bool keep = d ? (s >= l) : (s <= l);
                        float v = cb[t][r] * __expf(al - as[r]) * ds[r]; v = keep ? v : 0.f; if (d == 0 && s == l) v += dsk; o[r] = v; }
                    v2u pw; pw.x = pk2(o[0], o[1]); pw.y = pk2(o[2], o[3]); *(LAS v2u*)(LB + fr * PT + (16 * t + 4 * fq) * 2) = pw; }
                { const int r0 = F.tid >> 4, part = F.tid & 15; *(LAS v4u*)(PV + r0 * PT + part * 16) = pv0; *(LAS v4u*)(PV + (r0 + 32) * PT + part * 16) = pv1; }
                { const int nit = hh * 2 + d + 1; if (nit < 2 * HPG) { const bf16* src = ST + ((size_t)((b * NCHUNK + c) * HEADS + g * HPG) * 2 + nit) * 8192; pv0 = *(const GAS v4u*)(src + F.tid * 8); pv1 = *(const GAS v4u*)(src + 4096 + F.tid * 8); } }
                LDS_BARRIER();
                f32x4 Z[4];
#pragma unroll
                for (int pt = 0; pt < 4; ++pt) Z[pt] = (f32x4){0.f, 0.f, 0.f, 0.f};
#pragma unroll
                for (int kk = 0; kk < 4; ++kk) { const bf16x8 lq = ldfrag(LB, PT, fr, 32 * kk + 8 * fq), cq = ldfrag(CS, PT, 16 * w + fr, 32 * kk + 8 * fq); bf16x8 xp[4], pq[4];
#pragma unroll
                    for (int pt = 0; pt < 4; ++pt) { xp[pt] = ldfrag(XT, PT, 16 * pt + fr, 32 * kk + 8 * fq); pq[pt] = ldfrag(PV, PT, 16 * pt + fr, 32 * kk + 8 * fq); }
                    MFMA_BEGIN();
#pragma unroll
                    for (int pt = 0; pt < 4; ++pt) { Y[pt] = __builtin_amdgcn_mfma_f32_16x16x32_bf16(xp[pt], lq, Y[pt], 0, 0, 0); Z[pt] = __builtin_amdgcn_mfma_f32_16x16x32_bf16(pq[pt], cq, Z[pt], 0, 0, 0); }
                    MFMA_END(); }
                const float el = __expf(al);
#pragma unroll
                for (int pt = 0; pt < 4; ++pt) Y[pt] = Y[pt] + Z[pt] * el;
            }
            bf16* yrow0 = YN + (size_t)(b * SEQ + c * CHUNK + l) * INNER + g * 384 + hh * 64;
#pragma unroll
            for (int pt = 0; pt < 4; ++pt) {
                const float v0 = Y[pt][0] * siluf_(bflo(zw[pt].x)), v1 = Y[pt][1] * siluf_(bfhi(zw[pt].x)), v2 = Y[pt][2] * siluf_(bflo(zw[pt].y)), v3 = Y[pt][3] * siluf_(bfhi(zw[pt].y));
                ssq += (v0 * v0 + v1 * v1) + (v2 * v2 + v3 * v3); v2u o; o.x = pk2(v0, v1); o.y = pk2(v2, v3); *(GAS v2u*)(yrow0 + 16 * pt + 4 * fq) = o; }
        }
        ssq += __shfl_xor(ssq, 16); ssq += __shfl_xor(ssq, 32);
        const float rstd = 1.f / sqrtf(ssq * (1.f / 384.f) + RMS_EPS);
        VM_WAIT();
        bf16* yrow = YN + (size_t)(b * SEQ + c * CHUNK + l) * INNER + g * 384;
        for (int hh = 0; hh < HPG; ++hh)
#pragma unroll
            for (int pt = 0; pt < 4; ++pt) { const v2u vv = *(const GAS v2u*)(yrow + hh * 64 + 16 * pt + 4 * fq); v2u o; o.x = pk2(bflo(vv.x) * rstd, bfhi(vv.x) * rstd); o.y = pk2(bflo(vv.y) * rstd, bfhi(vv.y) * rstd);
                *(GAS v2u*)(yrow + hh * 64 + 16 * pt + 4 * fq) = o; }
    }
}

__device__ __forceinline__ void zt_put(LAS unsigned char* ZT, int pb, int ch0, int kidx, v4u v, bool odd) {
    const unsigned w[4] = { v.x, v.y, v.z, v.w };
#pragma unroll
    for (int m = 0; m < 4; ++m) { const unsigned send = odd ? (w[m] & 0xffffu) : (w[m] >> 16); const unsigned recv = (unsigned)__shfl_xor((int)send, 1);
        const unsigned val = odd ? (recv | (w[m] & 0xffff0000u)) : ((w[m] & 0xffffu) | (recv << 16));
        const int off = odd ? (ch0 + 2 * m + 1) * pb + (kidx - 1) * 2 : (ch0 + 2 * m) * pb + kidx * 2;
        *(LAS unsigned*)(ZT + off) = val; }
}
__device__ __forceinline__ void phase_dft1(Frame& F) {
    LAS unsigned char* WM = F.lds;
    LAS unsigned char* ZT = F.lds + 34816;
    const bf16* P = WSP(bf16, WS_PROJ); bf16* GB = WSP(bf16, WS_GB); const f32x2* TW = WSP(f32x2, WS_TW);
    LDS_BARRIER();
    for (int q = F.tid; q < 128 * 16; q += NTHR) { const int r = q >> 4, part = q & 15; *(LAS v4u*)(WM + r * PT + part * 16) = *(const GAS v4u*)(WSP(bf16, WS_WM1) + r * 128 + part * 8); }
    const int fr = F.lane & 15, fq = F.lane >> 4;
    for (int u = F.bx; u < NB * 128 * 2; u += F.G) {
        const int jh = u & 1, s2 = (u >> 1) & 127, b = u >> 8;
        LDS_BARRIER();
        { const int s1 = F.lane; const bf16* row = P + (size_t)(b * SEQ + 128 * s1 + s2) * PW; v4u vv[8];
#pragma unroll
          for (int q = 0; q < 8; ++q) { const int cc = F.wave * 8 + q; const int im = cc >= 32, chunk = cc & 31;
              vv[q] = *(const GAS v4u*)(row + (im ? PC_FI : PC_FR) + jh * 256 + chunk * 8); }
#pragma unroll
          for (int q = 0; q < 8; ++q) { const int cc = F.wave * 8 + q; const int im = cc >= 32, chunk = cc & 31; zt_put(ZT, PT, chunk * 8, im * 64 + s1, vv[q], s1 & 1); } }
        LDS_BARRIER();
        const int mi = F.wave & 3, jq = F.wave >> 2;
        f32x4 acc[2][8];
#pragma unroll
        for (int a = 0; a < 2; ++a)
#pragma unroll
            for (int j = 0; j < 8; ++j) acc[a][j] = (f32x4){0.f, 0.f, 0.f, 0.f};
#pragma unroll
        for (int kk = 0; kk < 4; ++kk) { const bf16x8 q0 = ldfrag(WM, PT, 16 * mi + fr, 32 * kk + 8 * fq), q1 = ldfrag(WM, PT, 64 + 16 * mi + fr, 32 * kk + 8 * fq); bf16x8 pf[8];
#pragma unroll
            for (int j = 0; j < 8; ++j) pf[j] = ldfrag(ZT, PT, 128 * jq + 16 * j + fr, 32 * kk + 8 * fq);
            MFMA_BEGIN();
#pragma unroll
            for (int j = 0; j < 8; ++j) { acc[0][j] = __builtin_amdgcn_mfma_f32_16x16x32_bf16(pf[j], q0, acc[0][j], 0, 0, 0); acc[1][j] = __builtin_amdgcn_mfma_f32_16x16x32_bf16(pf[j], q1, acc[1][j], 0, 0, 0); }
            MFMA_END(); }
        const int k1 = 16 * mi + fr;
        const f32x2 tw = TW[(s2 * k1) & 8191];
        bf16* orow = GB + ((size_t)(b * 128 + s2) * 64 + k1) * 1024 + jh * 256 + 128 * jq + 4 * fq;
#pragma unroll
        for (int j = 0; j < 8; ++j) { float gr[4], gi[4];
#pragma unroll
            for (int r = 0; r < 4; ++r) { const float a = acc[0][j][r], bq = acc[1][j][r]; gr[r] = a * tw.x + bq * tw.y; gi[r] = bq * tw.x - a * tw.y; }
            v2u o; o.x = pk2(gr[0], gr[1]); o.y = pk2(gr[2], gr[3]); *(GAS v2u*)(orow + 16 * j) = o;
            o.x = pk2(gi[0], gi[1]); o.y = pk2(gi[2], gi[3]); *(GAS v2u*)(orow + 512 + 16 * j) = o; }
    }
}
constexpr int PT2 = 528;
__device__ __forceinline__ void phase_dft2(Frame& F) {
    LAS unsigned char* WM = F.lds;
    LAS unsigned char* ZT = F.lds + 67584;
    const bf16* GB = WSP(bf16, WS_GB); bf16* FO = WSP(bf16, WS_FO);
    LDS_BARRIER();
    for (int q = F.tid; q < 128 * 32; q += NTHR) { const int r = q >> 5, part = q & 31; *(LAS v4u*)(WM + r * PT2 + part * 16) = *(const GAS v4u*)(WSP(bf16, WS_WM2) + r * 256 + part * 8); }
    const int fr = F.lane & 15, fq = F.lane >> 4, w = F.wave;
    for (int u = F.bx; u < NB * 64 * 4; u += F.G) {
        const int jb = u & 3, k1 = (u >> 2) & 63, b = u >> 8;
        LDS_BARRIER();
        { const int s2 = 64 * (w & 1) + F.lane; const bf16* row = GB + ((size_t)(b * 128 + s2) * 64 + k1) * 1024; v4u vv[8];
#pragma unroll
          for (int q = 0; q < 8; ++q) { const int cc = (w >> 1) + 4 * q; const int im = cc >= 16, chunk = cc & 15;
              vv[q] = *(const GAS v4u*)(row + im * 512 + jb * 128 + chunk * 8); }
#pragma unroll
          for (int q = 0; q < 8; ++q) { const int cc = (w >> 1) + 4 * q; const int im = cc >= 16, chunk = cc & 15; zt_put(ZT, PT2, chunk * 8, im * 128 + s2, vv[q], s2 & 1); } }
        LDS_BARRIER();
        f32x4 acc[8];
#pragma unroll
        for (int j = 0; j < 8; ++j) acc[j] = (f32x4){0.f, 0.f, 0.f, 0.f};
#pragma unroll
        for (int kk = 0; kk < 8; ++kk) { const bf16x8 q = ldfrag(WM, PT2, 16 * w + fr, 32 * kk + 8 * fq); bf16x8 pf[8];
#pragma unroll
            for (int j = 0; j < 8; ++j) pf[j] = ldfrag(ZT, PT2, 16 * j + fr, 32 * kk + 8 * fq);
            MFMA_BEGIN();
#pragma unroll
            for (int j = 0; j < 8; ++j) acc[j] = __builtin_amdgcn_mfma_f32_16x16x32_bf16(pf[j], q, acc[j], 0, 0, 0);
            MFMA_END(); }
        const int k2 = 16 * w + fr; bf16* orow = FO + (size_t)(b * SEQ + k1 + 64 * k2) * 512 + jb * 128 + 4 * fq;
#pragma unroll
        for (int j = 0; j < 8; ++j) { v2u o; o.x = pk2(acc[j][0], acc[j][1]); o.y = pk2(acc[j][2], acc[j][3]); *(GAS v2u*)(orow + 16 * j) = o; }
    }
}

__device__ __forceinline__ void phase_norm2(Frame& F) {
    LAS float* GM = (LAS float*)(F.lds); LAS float* GS = GM + 4096; LAS float* SH = GS + 4096;
    const float* mod = WSP(float, WS_MOD);
    __syncthreads();
    for (int i = F.tid; i < 4096; i += NTHR) { const int b = i >> 10, col = i & 1023; GM[i] = mod[b * 6144 + 2048 + col] * FIN(5)[col]; GS[i] = FIN(6)[col] * (1.f + mod[b * 6144 + 4096 + col]); SH[i] = mod[b * 6144 + 3072 + col]; }
    __syncthreads();
    const int gw = F.bx * NWAVES + F.wave, NGW = F.G * NWAVES; const float* x = FIN(0); bf16* H = WSP(bf16, WS_H); const bf16* MX = WSP(bf16, WS_MIXED);
    for (int m = gw; m < T; m += NGW) { const int b = m / SEQ;
        const GAS v2u* mr = (const GAS v2u*)(MX + (size_t)m * D) + F.lane; const GAS f32x4* xr = (const GAS f32x4*)(x + (size_t)m * D) + F.lane;
        f32x4 v[4], xv[4]; float ss = 0.f;
#pragma unroll
        for (int j = 0; j < 4; ++j) { const v2u mw = mr[64 * j]; xv[j] = xr[64 * j]; v[j] = (f32x4){bflo(mw.x), bfhi(mw.x), bflo(mw.y), bfhi(mw.y)}; ss += (v[j].x * v[j].x + v[j].y * v[j].y) + (v[j].z * v[j].z + v[j].w * v[j].w); }
        const float rstd = 1.f / sqrtf(wave_sum(ss) * (1.f / D) + RMS_EPS); float s2 = 0.f;
        GAS f32x4* o4 = (GAS f32x4*)(F.out + (size_t)m * D) + F.lane;
#pragma unroll
        for (int j = 0; j < 4; ++j) { const LAS float* gm = GM + b * 1024 + 4 * F.lane + 256 * j;
            v[j].x = xv[j].x + gm[0] * v[j].x * rstd; v[j].y = xv[j].y + gm[1] * v[j].y * rstd; v[j].z = xv[j].z + gm[2] * v[j].z * rstd; v[j].w = xv[j].w + gm[3] * v[j].w * rstd;
            o4[64 * j] = v[j]; s2 += (v[j].x * v[j].x + v[j].y * v[j].y) + (v[j].z * v[j].z + v[j].w * v[j].w); }
        const float rstd2 = 1.f / sqrtf(wave_sum(s2) * (1.f / D) + RMS_EPS);
        GAS unsigned long long* o8 = (GAS unsigned long long*)(H + (size_t)m * D) + F.lane;
#pragma unroll
        for (int j = 0; j < 4; ++j) { const int col = 4 * F.lane + 256 * j; const LAS float* gs = GS + b * 1024 + col; const LAS float* sh = SH + b * 1024 + col;
            o8[64 * j] = (unsigned long long)pk2(v[j].x * rstd2 * gs[0] + sh[0], v[j].y * rstd2 * gs[1] + sh[1]) | ((unsigned long long)pk2(v[j].z * rstd2 * gs[2] + sh[2], v[j].w * rstd2 * gs[3] + sh[3]) << 32); }
    }
}

__device__ __forceinline__ void phase_route(Frame& F) {
    LAS int* hist = (LAS int*)(F.lds);
    const float* LOG = WSP(float, WS_LOG); const float* rb = FIN(21); int* TOPI = WSP(int, WS_TOPI); float* TOPW = WSP(float, WS_TOPW); int* BCNT = WSP(int, WS_BCNT);
    const int lane = F.lane;
    for (int vb = F.bx; vb < 256; vb += F.G) {
        __syncthreads();
        if (F.tid < 256) hist[F.tid] = 0;
        __syncthreads();
        for (int ti = F.wave; ti < 128; ti += NWAVES) { const int t = vb * 128 + ti;
            const f32x4 lg = *(const GAS f32x4*)(LOG + (size_t)t * 256 + 4 * lane); const f32x4 bb = *(const GAS f32x4*)(rb + 4 * lane);
            float sc[4], bs[4];
#pragma unroll
            for (int j = 0; j < 4; ++j) { sc[j] = 1.f / (1.f + expf(-lg[j])); bs[j] = sc[j] + bb[j]; }
            float m1 = fmaxf(fmaxf(bs[0], bs[1]), fmaxf(bs[2], bs[3])), m2;
            { float a = fmaxf(bs[0], bs[1]), a2 = fminf(bs[0], bs[1]), c_ = fmaxf(bs[2], bs[3]), c2 = fminf(bs[2], bs[3]); m2 = fmaxf(fminf(a, c_), fmaxf(a2, c2)); }
#pragma unroll
            for (int o = 1; o < 8; o <<= 1) { const float o1 = __shfl_xor(m1, o), o2 = __shfl_xor(m2, o); const float n1 = fmaxf(m1, o1), n2 = fmaxf(fminf(m1, o1), fmaxf(m2, o2)); m1 = n1; m2 = n2; }
            const float gs = m1 + m2; const int mygrp = lane >> 3; int rank = 0;
#pragma unroll
            for (int j = 0; j < 8; ++j) { const float og = __shfl(gs, 8 * j); rank += (og > gs || (og == gs && j < mygrp)) ? 1 : 0; }
            const bool gsel = rank < 4;
            float cand[4];
#pragma unroll
            for (int j = 0; j < 4; ++j) cand[j] = gsel ? bs[j] : -INFINITY;
            int myidx = 0; float mysc = 0.f; float wsum = 0.f;
            for (int k = 0; k < TOPK; ++k) {
                float bv = cand[0]; int bi = 4 * lane;
#pragma unroll
                for (int j = 1; j < 4; ++j) if (cand[j] > bv) { bv = cand[j]; bi = 4 * lane + j; }
#pragma unroll
                for (int o = 1; o < 64; o <<= 1) { const float ov = __shfl_xor(bv, o); const int oi = __shfl_xor(bi, o); if (ov > bv || (ov == bv && oi < bi)) { bv = ov; bi = oi; } }
                const int own = bi >> 2, sub = bi & 3;
                const float s_own = sub == 0 ? sc[0] : (sub == 1 ? sc[1] : (sub == 2 ? sc[2] : sc[3]));
                const float ssel = __shfl(s_own, own);
                if (lane == own) {
#pragma unroll
                    for (int j = 0; j < 4; ++j) if (j == sub) cand[j] = -INFINITY; }
                wsum += ssel; if (lane == k) { myidx = bi; mysc = ssel; }
            }
            if (lane < TOPK) { TOPI[t * TOPK + lane] = myidx; TOPW[t * TOPK + lane] = mysc / wsum * 2.5f; atomicAdd((int*)&hist[myidx], 1); }
        }
        __syncthreads();
        if (F.tid < 256) BCNT[vb * 256 + F.tid] = hist[F.tid];
    }
}

__device__ __forceinline__ void phase_lists(Frame& F) {
    LAS int* tot = (LAS int*)(F.lds);
    LAS int* base = tot + 256;
    LAS int* pre = base + 260;
    LAS int* cur = pre + 256;
    LAS int* part = cur + 256;
    const int* BCNT = WSP(int, WS_BCNT); const int* TOPI = WSP(int, WS_TOPI); int* TOKPOS = WSP(int, WS_TOKPOS); int* ROWTOK = WSP(int, WS_ROWTOK); int* TILEE = WSP(int, WS_TILEE);
    __syncthreads();
    { const int e = F.tid & 255, half = F.tid >> 8; int s = 0; for (int vb = half * 128; vb < half * 128 + 128; ++vb) s += BCNT[vb * 256 + e]; part[F.tid] = s; }
    __syncthreads();
    if (F.tid < 256) tot[F.tid] = part[F.tid] + part[256 + F.tid];
    __syncthreads();
    if (F.tid == 0) { int run = 0; for (int e = 0; e < 256; ++e) { base[e] = run; run += (tot[e] + 255) & ~255; } base[256] = run; }
    __syncthreads();
    const int nrt = base[256] >> 8;
    if (F.bx == 0) {
        if (F.tid < 256) { const int e = F.tid; for (int t = base[e] >> 8; t < (base[e + 1] >> 8); ++t) TILEE[t] = e; }
        for (int t = F.tid; t < T / 256; t += NTHR) TILEE[nrt + t] = NE;
        if (F.tid == 0) { F.ctl[CW_NTILES] = (unsigned)(nrt + T / 256); F.ctl[CW_BASESH] = (unsigned)base[256]; }
    }
    for (int e = F.bx; e < 256; e += F.G) for (int r = base[e] + tot[e] + F.tid; r < base[e + 1]; r += NTHR) ROWTOK[r] = 0;
    { const int gt = F.bx * NTHR + F.tid, NGT = F.G * NTHR; for (int t = gt; t < T; t += NGT) ROWTOK[base[256] + t] = t; }
    for (int vb = F.bx; vb < 256; vb += F.G) {
        __syncthreads();
        { const int e = F.tid & 255, half = F.tid >> 8; int s = 0; const int lo = half * 128, hi = (half * 128 + 128 < vb) ? half * 128 + 128 : vb; for (int v = lo; v < hi; ++v) s += BCNT[v * 256 + e]; part[F.tid] = s; }
        __syncthreads();
        if (F.tid < 256) { pre[F.tid] = part[F.tid] + part[256 + F.tid]; cur[F.tid] = 0; }
        __syncthreads();
        for (int i = F.tid; i < 128 * TOPK; i += NTHR) { const int t = vb * 128 + (i >> 3); const int e = TOPI[t * TOPK + (i & 7)]; const int pos = base[e] + pre[e] + atomicAdd((int*)&cur[e], 1);
            ROWTOK[pos] = t; TOKPOS[t * TOPK + (i & 7)] = pos; }
    }
}

__device__ __forceinline__ void phase_final(Frame& F) {
    LAS float* GF = (LAS float*)(F.lds);
    const float* mod = WSP(float, WS_MOD);
    __syncthreads();
    for (int i = F.tid; i < 4096; i += NTHR) { const int b = i >> 10, col = i & 1023; GF[i] = mod[b * 6144 + 5120 + col] * FIN(7)[col]; }
    __syncthreads();
    const int gw = F.bx * NWAVES + F.wave, NGW = F.G * NWAVES; const bf16* YB = WSP(bf16, WS_YB); const int* TOKPOS = WSP(int, WS_TOKPOS); const float* TOPW = WSP(float, WS_TOPW);
    const int basesh = (int)__hip_atomic_load(F.ctl + CW_BASESH, RLX_AGENT);
    for (int m = gw; m < T; m += NGW) { const int b = m / SEQ;
        float a[16];
#pragma unroll
        for (int j = 0; j < 16; ++j) a[j] = 0.f;
#pragma unroll
        for (int k = 0; k < TOPK + 1; ++k) { const int pos = (k < TOPK) ? TOKPOS[m * TOPK + k] : basesh + m; const float wk = (k < TOPK) ? TOPW[m * TOPK + k] : 1.f;
            const GAS v4u* yr = (const GAS v4u*)(YB + (size_t)pos * 1024) + F.lane; const v4u y0 = yr[0], y1 = yr[64];
            a[0] += wk * bflo(y0.x); a[1] += wk * bfhi(y0.x); a[2] += wk * bflo(y0.y); a[3] += wk * bfhi(y0.y); a[4] += wk * bflo(y0.z); a[5] += wk * bfhi(y0.z); a[6] += wk * bflo(y0.w); a[7] += wk * bfhi(y0.w);
            a[8] += wk * bflo(y1.x); a[9] += wk * bfhi(y1.x); a[10] += wk * bflo(y1.y); a[11] += wk * bfhi(y1.y); a[12] += wk * bflo(y1.z); a[13] += wk * bfhi(y1.z); a[14] += wk * bflo(y1.w); a[15] += wk * bfhi(y1.w); }
        float ss = 0.f;
#pragma unroll
        for (int j = 0; j < 16; ++j) ss += a[j] * a[j];
        const float rstd = 1.f / sqrtf(wave_sum(ss) * (1.f / D) + RMS_EPS);
        float* orow = F.out + (size_t)m * D;
#pragma unroll
        for (int hlf = 0; hlf < 2; ++hlf) { const int col = hlf * 512 + 8 * F.lane; const LAS float* gf = GF + b * 1024 + col;
            f32x4 x0 = *(GAS f32x4*)(orow + col), x1 = *(GAS f32x4*)(orow + col + 4);
            x0.x += gf[0] * a[8 * hlf + 0] * rstd; x0.y += gf[1] * a[8 * hlf + 1] * rstd; x0.z += gf[2] * a[8 * hlf + 2] * rstd; x0.w += gf[3] * a[8 * hlf + 3] * rstd;
            x1.x += gf[4] * a[8 * hlf + 4] * rstd; x1.y += gf[5] * a[8 * hlf + 5] * rstd; x1.z += gf[6] * a[8 * hlf + 6] * rstd; x1.w += gf[7] * a[8 * hlf + 7] * rstd;
            *(GAS f32x4*)(orow + col) = x0; *(GAS f32x4*)(orow + col + 4) = x1; }
    }
}
constexpr int NPH = 18;
struct Args { const float* in[26]; float* out; unsigned char* ws; };
template <int LO, int HI>
__global__ void __launch_bounds__(NTHR, 2) fwd(Args args) {
    extern __shared__ __attribute__((aligned(16))) unsigned char lds[];
    Frame F;
    F.lds = (LAS unsigned char*)lds; F.ws = args.ws; F.ctl = (gu32*)(args.ws + WS_CTL);
    F.tid = threadIdx.x; F.lane = F.tid & 63; F.wave = __builtin_amdgcn_readfirstlane(F.tid >> 6); F.G = gridDim.x; F.bx = blockIdx.x;
    F.out = args.out;
    volatile LAS unsigned* MISC = (volatile LAS unsigned*)(F.lds + MISC_OFF);
    if (F.tid < 64) MISC[F.tid] = 0u;
#if KSTART_INV
    if (F.tid == 0) { __builtin_amdgcn_fence(__ATOMIC_ACQUIRE, "agent"); asm volatile("s_waitcnt vmcnt(0)" ::: "memory"); }
#endif
    __syncthreads();
    XcdBarrier bar; bar.bar = (unsigned*)(F.ctl + CW_BAR); bar.x = 0; bar.st = nullptr;
    if constexpr (HI - LO > 1) bar = xcd_barrier_post((unsigned*)(F.ctl + CW_BAR), MISC + 8);
#define IN(k) (LO <= (k) && (k) < HI)
#define FRESH() do { int _t = threadIdx.x; asm volatile("" : "+v"(_t)); F.tid = _t; F.lane = _t & 63; F.wave = __builtin_amdgcn_readfirstlane(_t >> 6); \
        unsigned long long _w = (unsigned long long)args.ws; asm volatile("" : "+s"(_w)); F.ws = (unsigned char*)_w; F.ctl = (gu32*)(F.ws + WS_CTL); \
        unsigned long long _o = (unsigned long long)args.out; asm volatile("" : "+s"(_o)); F.out = (float*)_o; } while (0)
#define SEAM(k) do { if constexpr (IN(k) && IN((k) + 1)) xcd_barrier(bar); } while (0)
    if constexpr (IN(0)) { FRESH(); phase_prologue(F); } SEAM(0);
    if constexpr (IN(1)) { FRESH(); phase_norm1(F); } SEAM(1);
    if constexpr (IN(2)) { FRESH();
        __syncthreads();
        pg8::Gemm g{WSP(bf16, WS_H), WSP(bf16, WS_WINT), T, NPROJ, D, nullptr}; pg8::StaticOrder S; S.init(T, NPROJ, F.G, F.bx);
        pg8::EpiProj E{WSP(bf16, WS_PROJ), PW, WSP(float, WS_DT)};
        pg8::gemm_phase<pg8::EpiProj, pg8::StaticOrder, true, false>(F.lds, g, S, E);
    } SEAM(2);
    if constexpr (IN(3)) { FRESH(); phase_states(F); }
    if constexpr (IN(4)) { FRESH(); phase_dft1(F); } SEAM(4);
    if constexpr (IN(5)) { FRESH(); phase_scan(F); }
    if constexpr (IN(6)) { FRESH(); phase_dft2(F); } SEAM(6);
    if constexpr (IN(7)) { FRESH(); phase_ssd_out(F); } SEAM(7);
    if constexpr (IN(8)) { FRESH();
        __syncthreads();
        pg8::Gemm g{WSP(bf16, WS_YN), WSP(bf16, WS_WBST), T, D, INNER, nullptr}; pg8::StaticOrder S; S.init(T, D, F.G, F.bx);
        pg8::EpiGate<false> E{WSP(bf16, WS_MIX), D, WSP(bf16, WS_PROJ), PW, PC_GS};
        pg8::gemm_phase<pg8::EpiGate<false>, pg8::StaticOrder, true, false>(F.lds, g, S, E);
    }
    if constexpr (IN(9)) { FRESH();
        __syncthreads();
        pg8::Gemm g{WSP(bf16, WS_FO), WSP(bf16, WS_WBFT), T, D, 512, nullptr}; pg8::StaticOrder S; S.init(T, D, F.G, F.bx);
        pg8::EpiGate<true> E{WSP(bf16, WS_MIX), D, WSP(bf16, WS_PROJ), PW, PC_GF};
        pg8::gemm_phase<pg8::EpiGate<true>, pg8::StaticOrder, true, false>(F.lds, g, S, E);
    } SEAM(9);
    if constexpr (IN(10)) { FRESH();
        __syncthreads();
        pg8::Gemm g{WSP(bf16, WS_MIX), WSP(bf16, WS_WOUTT), T, D, D, nullptr}; pg8::StaticOrder S; S.init(T, D, F.G, F.bx);
        pg8::EpiBf16<4> E{WSP(bf16, WS_MIXED), D};
        pg8::gemm_phase<pg8::EpiBf16<4>, pg8::StaticOrder, true, false>(F.lds, g, S, E);
    } SEAM(10);
    if constexpr (IN(11)) { FRESH(); phase_norm2(F); } SEAM(11);
    if constexpr (IN(12)) { FRESH();
        __syncthreads();
        pg8::Gemm g{WSP(bf16, WS_H), WSP(bf16, WS_WRT), T, NE, D, nullptr}; pg8::StaticOrder S; S.init(T, NE, F.G, F.bx);
        pg8::EpiF32 E{WSP(float, WS_LOG), NE};
        pg8::gemm_phase<pg8::EpiF32, pg8::StaticOrder, true, false>(F.lds, g, S, E);
    } SEAM(12);
    if constexpr (IN(13)) { FRESH(); phase_route(F); } SEAM(13);
    if constexpr (IN(14)) { FRESH(); phase_lists(F); } SEAM(14);
    if constexpr (IN(15)) { FRESH();
        __syncthreads();
        const int ntiles = (int)__hip_atomic_load(F.ctl + CW_NTILES, RLX_AGENT);
        LAS int* te = (LAS int*)(F.lds + 131072); for (int i = F.tid; i < MAXTILES; i += NTHR) te[i] = (i < ntiles) ? WSP(int, WS_TILEE)[i] : 0;
        __syncthreads();
        pg8::Gemm g{WSP(bf16, WS_H), WSP(bf16, WS_W13T), ROWS_ALL, NEX * 512, D, WSP(int, WS_ROWTOK)}; pg8::GroupedOrder<2> S{te, ntiles, F.G, F.bx};
        pg8::EpiSwiglu E{WSP(bf16, WS_HB), EH};
        pg8::gemm_phase<pg8::EpiSwiglu, pg8::GroupedOrder<2>, true, true>(F.lds, g, S, E);
    } SEAM(15);
    if constexpr (IN(16)) { FRESH();
        __syncthreads();
        const int ntiles = (int)__hip_atomic_load(F.ctl + CW_NTILES, RLX_AGENT);
        LAS int* te = (LAS int*)(F.lds + 131072); for (int i = F.tid; i < MAXTILES; i += NTHR) te[i] = (i < ntiles) ? WSP(int, WS_TILEE)[i] : 0;
        __syncthreads();
        pg8::Gemm g{WSP(bf16, WS_HB), WSP(bf16, WS_W2T), ROWS_ALL, NEX * 1024, EH, nullptr}; pg8::GroupedOrder<4> S{te, ntiles, F.G, F.bx};
        pg8::EpiBf16<4> E{WSP(bf16, WS_YB), D};
        pg8::gemm_phase<pg8::EpiBf16<4>, pg8::GroupedOrder<4>, true, false>(F.lds, g, S, E);
    } SEAM(16);
    if constexpr (IN(17)) { FRESH(); phase_final(F); }
#undef IN
#undef SEAM
}
#if DEV_CHECKS
struct CArgs { const float* in[26]; float* out; unsigned char* ws; };
#define CW(T_, off) ((T_*)(a.ws + (off)))
__device__ __forceinline__ unsigned hsh(unsigned x) { x ^= x >> 16; x *= 0x7feb352du; x ^= x >> 15; x *= 0x846ca68bu; x ^= x >> 16; return x; }
__device__ __forceinline__ void chk_acc(unsigned char* ws, int k, float num, float den) {
    num = wave_sum(num); den = wave_sum(den);
    if ((threadIdx.x & 63) == 0) { float* e = (float*)(ws + WS_CTL) + CW_ERR + 2 * k; atomicAdd(e, num); atomicAdd(e + 1, den); }
}
__device__ __forceinline__ float bfr(float f) { return __uint_as_float(f2bf(f) << 16); }
__device__ float c_convsilu(const CArgs& a, int b, int s, int ch) {
    const bf16* P = CW(bf16, WS_PROJ); float o = a.in[10][ch];
    for (int i = 0; i < 5; ++i) { const int ss = s + i - 2; if (ss >= 0 && ss < SEQ) o += a.in[9][i * 2560 + ch] * bf2f(P[(size_t)(b * SEQ + ss) * PW + PC_X + ch]); }
    return siluf_(o);
}
__device__ float c_dt(const CArgs& a, int b, int s, int h, int d) { return softplusf_(CW(float, WS_DT)[(size_t)(b * SEQ + s) * 64 + d * 24 + h] + (d ? a.in[12][h] : a.in[11][h])); }
__device__ float c_a(const CArgs& a, int b, int s, int h, int d) { return -expf(d ? a.in[14][h] : a.in[13][h]) * c_dt(a, b, s, h, d); }

__global__ void chk0(CArgs a) {
    const unsigned sid = blockIdx.x * blockDim.x + threadIdx.x; const unsigned r = hsh(sid * 3u + 1u), r2 = hsh(sid * 3u + 2u);
    float num = 0.f, den = 0.f;
    { const int b = r & 3, col = (r >> 2) % 6144; float s = a.in[3][col]; for (int k = 0; k < 1024; ++k) s += siluf_(a.in[1][b * 1024 + k]) * a.in[2][(size_t)k * 6144 + col];
      const float f = CW(float, WS_MOD)[b * 6144 + col]; num += (f - s) * (f - s); den += s * s; }
    { const int d = r2 % NPROJ, k = (r2 >> 13) & 1023; float e;
      if (d < 4096) e = a.in[8][(size_t)k * INW + d];
      else if (d < 5120) { const int im = d >= PC_FI, q = (d - 4096) & 511, g = q >> 7, j = q & 127; float s = 0.f;
          for (int c = 0; c < 128; ++c) { float sn, cs; sincospif((float)((c * j) & 127) / 64.f, &sn, &cs); s += a.in[8][(size_t)k * INW + SRC_F + g * 128 + c] * (im ? -sn : cs); } e = s * 0.08838834764831845f; }
      else if (d < 7168) e = a.in[8][(size_t)k * INW + SRC_G + d - 5120];
      else e = (d - 7168 < 48) ? a.in[8][(size_t)k * INW + SRC_DT + d - 7168] : 0.f;
      const float f = bf2f(CW(bf16, WS_WINT)[(size_t)d * 1024 + k]); num += (f - e) * (f - e); den += e * e + 1e-6f; }
    { const int n = r & 1023, k = (r >> 10) % 1536; const float e = a.in[17][(size_t)k * 1024 + n] * a.in[16][k], f = bf2f(CW(bf16, WS_WBST)[(size_t)n * 1536 + k]); num += (f - e) * (f - e); den += e * e; }
    { const int n = r2 & 1023, k = (r2 >> 10) & 511; const float e = a.in[18][(size_t)k * 1024 + n], f = bf2f(CW(bf16, WS_WBFT)[(size_t)n * 512 + k]); num += (f - e) * (f - e); den += e * e; }
    { const int n = r & 1023, k = (r >> 10) & 1023; const float e = a.in[19][(size_t)k * 1024 + n], f = bf2f(CW(bf16, WS_WOUTT)[(size_t)n * 1024 + k]); num += (f - e) * (f - e); den += e * e; }
    { const int n = r2 & 255, k = (r2 >> 8) & 1023; const float e = a.in[20][(size_t)k * 256 + n], f = bf2f(CW(bf16, WS_WRT)[(size_t)n * 1024 + k]); num += (f - e) * (f - e); den += e * e; }
    { const int e_ = hsh(sid + 77u) % NEX, rho = r & 511, k = (r >> 9) & 1023; const int pn = rho >> 8, bj = (rho >> 7) & 1, jj = rho & 127, sc = bj * 256 + pn * 128 + jj;
      const float e = (e_ < NE) ? a.in[22][((size_t)e_ * 1024 + k) * 512 + sc] : a.in[24][(size_t)k * 512 + sc]; const float f = bf2f(CW(bf16, WS_W13T)[((size_t)e_ * 512 + rho) * 1024 + k]); num += (f - e) * (f - e); den += e * e; }
    { const int e_ = hsh(sid + 99u) % NEX, n = r2 & 1023, k = (r2 >> 10) & 255;
      const float e = (e_ < NE) ? a.in[23][((size_t)e_ * 256 + k) * 1024 + n] : a.in[25][(size_t)k * 1024 + n]; const float f = bf2f(CW(bf16, WS_W2T)[((size_t)e_ * 1024 + n) * 256 + k]); num += (f - e) * (f - e); den += e * e; }
    chk_acc(a.ws, 0, num, den);
}
__global__ void chk1(CArgs a) {
    const unsigned sid = blockIdx.x * blockDim.x + threadIdx.x; if (sid >= 4096) return; const unsigned r = hsh(sid + 11u);
    const int m = r % T, b = m / SEQ; const float* x = a.in[0] + (size_t)m * D; float ss = 0.f; for (int k = 0; k < D; ++k) ss += x[k] * x[k];
    const float rstd = 1.f / sqrtf(ss / D + RMS_EPS); const float* mod = CW(float, WS_MOD) + b * 6144; float num = 0.f, den = 0.f;
    for (int q = 0; q < 8; ++q) { const int col = (r >> 15) * 8 % 1024 + q; const float e = x[col] * rstd * a.in[4][col] * (1.f + mod[1024 + col]) + mod[col]; const float f = bf2f(CW(bf16, WS_H)[(size_t)m * D + col]); num += (f - e) * (f - e); den += e * e; }
    chk_acc(a.ws, 1, num, den);
}
__device__ float c_dot_bf(const bf16* A, const bf16* B, int K) { float s = 0.f; for (int k = 0; k < K; ++k) s += bf2f(A[k]) * bf2f(B[k]); return s; }
__global__ void chk2(CArgs a) {
    const unsigned sid = blockIdx.x * blockDim.x + threadIdx.x; const unsigned r = hsh(sid + 21u);
    const int m = r % T; int col = (r >> 15) % (PW + 48); float num = 0.f, den = 0.f;
    const float e = c_dot_bf(CW(bf16, WS_H) + (size_t)m * D, CW(bf16, WS_WINT) + (size_t)col * D, D); float f, ee = e;
    if (col < PW) { if (col >= PC_GS) ee = 1.f / (1.f + expf(-e)); f = bf2f(CW(bf16, WS_PROJ)[(size_t)m * PW + col]); } else f = CW(float, WS_DT)[(size_t)m * 64 + col - PW];
    num = (f - ee) * (f - ee); den = ee * ee; chk_acc(a.ws, 2, num, den);
}
__global__ void chk3(CArgs a) {
    const unsigned sid = blockIdx.x * blockDim.x + threadIdx.x; if (sid >= 8192) return; const unsigned r = hsh(sid + 31u);
    const int b = r & 3, c = (r >> 2) & 63, h = (r >> 8) % 24, d = (r >> 13) & 1, p = (r >> 14) & 63, n = (r >> 20) & 127, g = h / HPG;
    float tot = 0.f; for (int s = 0; s < 128; ++s) tot += c_a(a, b, c * 128 + s, h, d);
    float st = 0.f, run = 0.f;
    if (d == 0) { for (int s = 0; s < 128; ++s) { run += c_a(a, b, c * 128 + s, h, 0); st += c_convsilu(a, b, c * 128 + s, h * 64 + p) * c_dt(a, b, c * 128 + s, h, 0) * expf(tot - run) * c_convsilu(a, b, c * 128 + s, 1536 + g * 128 + n); } }
    else { for (int s = 127; s >= 0; --s) { run += c_a(a, b, c * 128 + s, h, 1); st += c_convsilu(a, b, c * 128 + s, h * 64 + p) * c_dt(a, b, c * 128 + s, h, 1) * expf(tot - run) * c_convsilu(a, b, c * 128 + s, 1536 + g * 128 + n); } }
    const size_t si = ((size_t)((b * NCHUNK + c) * HEADS + h) * 2 + d); const float f = bf2f(CW(bf16, WS_ST)[si * 8192 + p * 128 + n]);
    float num = (f - st) * (f - st), den = st * st; const float cd = CW(float, WS_CD)[si], ce = expf(tot); num += (cd - ce) * (cd - ce); den += ce * ce;
    chk_acc(a.ws, 3, num, den);
}
__global__ void chk4(CArgs a) {
    const unsigned sid = blockIdx.x * blockDim.x + threadIdx.x; const unsigned r = hsh(sid + 41u);
    const int b = r & 3, s2 = (r >> 2) & 127, k1 = (r >> 9) & 63, j = (r >> 15) & 511; const bf16* P = CW(bf16, WS_PROJ);
    float gr = 0.f, gi = 0.f;
    for (int s1 = 0; s1 < 64; ++s1) { const size_t row = (size_t)(b * SEQ + 128 * s1 + s2) * PW; const float zr = bf2f(P[row + PC_FR + j]), zi = bf2f(P[row + PC_FI + j]);
        float sn, cs; sincospif((float)((s1 * k1) & 63) / 32.f, &sn, &cs); gr += zr * cs + zi * sn; gi += zi * cs - zr * sn; }
    float sn, cs; sincospif((float)((s2 * k1) & 8191) / 4096.f, &sn, &cs); const float er = (gr * cs + gi * sn) * 0.125f, ei = (gi * cs - gr * sn) * 0.125f;
    const bf16* G = CW(bf16, WS_GB) + ((size_t)(b * 128 + s2) * 64 + k1) * 1024; const float fr_ = bf2f(G[j]), fi = bf2f(G[512 + j]);
    chk_acc(a.ws, 4, (fr_ - er) * (fr_ - er) + (fi - ei) * (fi - ei), er * er + ei * ei);
}
__global__ void chk5(CArgs a) {
    const unsigned sid = blockIdx.x * blockDim.x + threadIdx.x; if (sid >= 8192) return; const unsigned r = hsh(sid + 51u);
    const int b = r & 3, c = (r >> 2) & 63, h = (r >> 8) % 24, d = (r >> 13) & 1, p = (r >> 14) & 63, n = (r >> 20) & 127, g = h / HPG;
    const int cn = d ? c - 1 : c + 1; const bf16* ST = CW(bf16, WS_ST); float num = 0.f, den = 0.f;
    const size_t si = ((size_t)((b * NCHUNK + c) * HEADS + h) * 2 + d);
    if ((d == 0 && c == 0) || (d == 1 && c == 63)) { const float f = bf2f(ST[si * 8192 + p * 128 + n]); num += f * f; }
    if (cn >= 0 && cn < 64) {
        float tot = 0.f; for (int s = 0; s < 128; ++s) tot += c_a(a, b, c * 128 + s, h, d);
        float st = 0.f, run = 0.f;
        for (int q = 0; q < 128; ++q) { const int s = d ? 127 - q : q; run += c_a(a, b, c * 128 + s, h, d); st += c_convsilu(a, b, c * 128 + s, h * 64 + p) * c_dt(a, b, c * 128 + s, h, d) * expf(tot - run) * c_convsilu(a, b, c * 128 + s, 1536 + g * 128 + n); }
        const size_t sn_ = ((size_t)((b * NCHUNK + cn) * HEADS + h) * 2 + d);
        const float e = bf2f(ST[si * 8192 + p * 128 + n]) * expf(tot) + st, f = bf2f(ST[sn_ * 8192 + p * 128 + n]); num += (f - e) * (f - e); den += e * e + st * st; }
    chk_acc(a.ws, 5, num, den);
}
__global__ void chk6(CArgs a) {
    const unsigned sid = blockIdx.x * blockDim.x + threadIdx.x; const unsigned r = hsh(sid + 61u);
    const int b = r & 3, k = (r >> 2) & 8191, j = (r >> 15) & 511, k1 = k & 63, k2 = k >> 6; float num = 0.f, den = 0.f;
    { float s = 0.f; for (int s2 = 0; s2 < 128; ++s2) { const bf16* G = CW(bf16, WS_GB) + ((size_t)(b * 128 + s2) * 64 + k1) * 1024; float sn, cs; sincospif((float)((s2 * k2) & 127) / 64.f, &sn, &cs); s += bf2f(G[j]) * cs + bf2f(G[512 + j]) * sn; }
      s *= 0.08838834764831845f; const float f = bf2f(CW(bf16, WS_FO)[(size_t)(b * SEQ + k) * 512 + j]); num += (f - s) * (f - s); den += s * s; }
    if (sid < 512) { const bf16* P = CW(bf16, WS_PROJ); double s = 0.0; for (int t = 0; t < SEQ; ++t) { const size_t row = (size_t)(b * SEQ + t) * PW; float sn, cs; sincospif((float)(((long)k * t) & 8191) / 4096.f, &sn, &cs); s += bf2f(P[row + PC_FR + j]) * cs + bf2f(P[row + PC_FI + j]) * sn; }
      const float e = (float)s * 0.125f * 0.08838834764831845f; const float f = bf2f(CW(bf16, WS_FO)[(size_t)(b * SEQ + k) * 512 + j]); num += 16.f * (f - e) * (f - e); den += 16.f * e * e; }
    chk_acc(a.ws, 6, num, den);
}
__global__ void chk7(CArgs a) {
    __shared__ float Cl[128], CBs[2][128], red[384]; __shared__ float acf[6][128], acb[6][128];
    const unsigned r = hsh(blockIdx.x + 71u); const int b = r & 3, c = (r >> 2) & 63, l = (r >> 8) & 127, g = (r >> 15) & 3, tid = threadIdx.x;
    if (tid < 128) Cl[tid] = c_convsilu(a, b, c * 128 + l, 2048 + g * 128 + tid);
    if (tid < 12) { const int d = tid / 6, hh = tid % 6, h = g * HPG + hh; float run = 0.f;
        if (!d) for (int s = 0; s < 128; ++s) { run += c_a(a, b, c * 128 + s, h, 0); acf[hh][s] = run; } else for (int s = 127; s >= 0; --s) { run += c_a(a, b, c * 128 + s, h, 1); acb[hh][s] = run; } }
    __syncthreads();
    if (tid < 128) { float s = 0.f; for (int n = 0; n < 128; ++n) s += Cl[n] * c_convsilu(a, b, c * 128 + tid, 1536 + g * 128 + n); CBs[0][tid] = s; }
    __syncthreads();
    const int hh = tid / 64, p = tid % 64, h = g * HPG + hh; float y = 0.f;
    for (int s = 0; s < 128; ++s) { const float x = c_convsilu(a, b, c * 128 + s, h * 64 + p); float wgt = 0.f;
        if (s <= l) wgt += expf(acf[hh][l] - acf[hh][s]) * c_dt(a, b, c * 128 + s, h, 0);
        if (s >= l) wgt += expf(acb[hh][l] - acb[hh][s]) * c_dt(a, b, c * 128 + s, h, 1);
        y += CBs[0][s] * wgt * x; if (s == l) y += a.in[15][h] * x; }
    for (int d = 0; d < 2; ++d) { const bf16* pv = CW(bf16, WS_ST) + ((size_t)((b * NCHUNK + c) * HEADS + h) * 2 + d) * 8192 + p * 128; float s = 0.f; for (int n = 0; n < 128; ++n) s += Cl[n] * bf2f(pv[n]);
        y += s * expf(d ? acb[hh][l] : acf[hh][l]); }
    const size_t trow = (size_t)(b * SEQ + c * 128 + l);
    const float v = y * siluf_(bf2f(CW(bf16, WS_PROJ)[trow * PW + PC_Z + h * 64 + p])); red[tid] = v * v; __syncthreads();
    if (tid == 0) { float s = 0.f; for (int i = 0; i < 384; ++i) s += red[i]; red[0] = s; } __syncthreads();
    const float e = v / sqrtf(red[0] / 384.f + RMS_EPS), f = bf2f(CW(bf16, WS_YN)[trow * INNER + g * 384 + tid]);
    float num = (f - e) * (f - e), den = e * e; num = wave_sum(num); den = wave_sum(den);
    if ((tid & 63) == 0) { float* ew = (float*)(a.ws + WS_CTL) + CW_ERR + 2 * 7; atomicAdd(ew, num); atomicAdd(ew + 1, den); }
}
__global__ void chk9(CArgs a) {
    const unsigned sid = blockIdx.x * blockDim.x + threadIdx.x; const unsigned r = hsh(sid + 91u); const int m = r % T, col = (r >> 15) & 1023;
    const float y1 = c_dot_bf(CW(bf16, WS_YN) + (size_t)m * INNER, CW(bf16, WS_WBST) + (size_t)col * INNER, INNER), y2 = c_dot_bf(CW(bf16, WS_FO) + (size_t)m * 512, CW(bf16, WS_WBFT) + (size_t)col * 512, 512);
    const bf16* P = CW(bf16, WS_PROJ) + (size_t)m * PW; const float e = bfr(bf2f(P[PC_GS + col]) * y1) + bf2f(P[PC_GF + col]) * y2, f = bf2f(CW(bf16, WS_MIX)[(size_t)m * D + col]);
    chk_acc(a.ws, 9, (f - e) * (f - e), e * e);
}
__global__ void chk10(CArgs a) {
    const unsigned sid = blockIdx.x * blockDim.x + threadIdx.x; const unsigned r = hsh(sid + 101u); const int m = r % T, col = (r >> 15) & 1023;
    const float e = c_dot_bf(CW(bf16, WS_MIX) + (size_t)m * D, CW(bf16, WS_WOUTT) + (size_t)col * D, D), f = bf2f(CW(bf16, WS_MIXED)[(size_t)m * D + col]);
    chk_acc(a.ws, 10, (f - e) * (f - e), e * e);
}
__global__ void chk11(CArgs a) {
    const unsigned sid = blockIdx.x * blockDim.x + threadIdx.x; if (sid >= 4096) return; const unsigned r = hsh(sid + 111u);
    const int m = r % T, b = m / SEQ; const bf16* mx = CW(bf16, WS_MIXED) + (size_t)m * D; const float* mod = CW(float, WS_MOD) + b * 6144; const float* x = a.in[0] + (size_t)m * D;
    float ss = 0.f; for (int k = 0; k < D; ++k) ss += bf2f(mx[k]) * bf2f(mx[k]); const float rstd = 1.f / sqrtf(ss / D + RMS_EPS);
    float s2 = 0.f; for (int k = 0; k < D; ++k) { const float v = x[k] + mod[2048 + k] * (bf2f(mx[k]) * rstd * a.in[5][k]); s2 += v * v; } const float rstd2 = 1.f / sqrtf(s2 / D + RMS_EPS);
    float num = 0.f, den = 0.f;
    for (int q = 0; q < 8; ++q) { const int col = ((r >> 15) * 8 + q) & 1023; const float x1 = x[col] + mod[2048 + col] * (bf2f(mx[col]) * rstd * a.in[5][col]);
        const float f1 = a.out[(size_t)m * D + col]; num += (f1 - x1) * (f1 - x1); den += x1 * x1;
        const float e2 = x1 * rstd2 * a.in[6][col] * (1.f + mod[4096 + col]) + mod[3072 + col], f2 = bf2f(CW(bf16, WS_H)[(size_t)m * D + col]); num += (f2 - e2) * (f2 - e2); den += e2 * e2; }
    chk_acc(a.ws, 11, num, den);
}
__global__ void chk12(CArgs a) {
    const unsigned sid = blockIdx.x * blockDim.x + threadIdx.x; const unsigned r = hsh(sid + 121u); const int m = r % T, col = (r >> 15) & 255;
    const float e = c_dot_bf(CW(bf16, WS_H) + (size_t)m * D, CW(bf16, WS_WRT) + (size_t)col * D, D), f = CW(float, WS_LOG)[(size_t)m * NE + col];
    chk_acc(a.ws, 12, (f - e) * (f - e), e * e);
}
__global__ void chk13(CArgs a) {
    const unsigned sid = blockIdx.x * blockDim.x + threadIdx.x; if (sid >= 8192) return; const int t = hsh(sid + 131u) % T; const float* lg = CW(float, WS_LOG) + (size_t)t * NE;
    float gsc[8]; for (int g = 0; g < 8; ++g) { float m1 = -INFINITY, m2 = -INFINITY; for (int j = 0; j < 32; ++j) { const float v = 1.f / (1.f + expf(-lg[g * 32 + j])) + a.in[21][g * 32 + j]; if (v > m1) { m2 = m1; m1 = v; } else if (v > m2) m2 = v; } gsc[g] = m1 + m2; }
    unsigned gm = 0; for (int g = 0; g < 8; ++g) { int rank = 0; for (int j = 0; j < 8; ++j) rank += (gsc[j] > gsc[g] || (gsc[j] == gsc[g] && j < g)); if (rank < 4) gm |= 1u << g; }
    int idx[8]; float sc[8]; unsigned long long taken[4] = {0, 0, 0, 0}; float wsum = 0.f;
    for (int k = 0; k < 8; ++k) { float bv = -INFINITY; int bi = -1; for (int e = 0; e < 256; ++e) { if (!((gm >> (e >> 5)) & 1u) || ((taken[e >> 6] >> (e & 63)) & 1ull)) continue; const float v = 1.f / (1.f + expf(-lg[e])) + a.in[21][e]; if (v > bv) { bv = v; bi = e; } }
        idx[k] = bi; sc[k] = 1.f / (1.f + expf(-lg[bi])); wsum += sc[k]; taken[bi >> 6] |= 1ull << (bi & 63); }
    float num = 0.f, den = 8.f;
    for (int k = 0; k < 8; ++k) { if (CW(int, WS_TOPI)[t * 8 + k] != idx[k]) num += 1.f; const float e = sc[k] / wsum * 2.5f, f = CW(float, WS_TOPW)[t * 8 + k]; if (fabsf(e - f) > 1e-4f) num += 1.f; }
    chk_acc(a.ws, 13, num, den);
}
__global__ void chk14(CArgs a) {
    const unsigned sid = blockIdx.x * blockDim.x + threadIdx.x; const unsigned* ctl = (const unsigned*)(a.ws + WS_CTL); const int ntiles = (int)ctl[CW_NTILES], basesh = (int)ctl[CW_BASESH];
    float num = 0.f, den = 1.f;
    { const int t = sid % T, k = (sid / T) & 7; const int pos = CW(int, WS_TOKPOS)[t * 8 + k]; if (pos < 0 || pos >= basesh) num += 1.f; else { if (CW(int, WS_ROWTOK)[pos] != t) num += 1.f; if (CW(int, WS_TILEE)[pos >> 8] != CW(int, WS_TOPI)[t * 8 + k]) num += 1.f; } }
    for (int r = sid; r < ntiles * 256; r += gridDim.x * blockDim.x) { const int tk = CW(int, WS_ROWTOK)[r]; if (tk < 0 || tk >= T) num += 1.f; if (r >= basesh && tk != r - basesh) num += 1.f; }
    if (sid == 0) { if (ntiles != basesh / 256 + T / 256 || ntiles > MAXTILES || (basesh & 255)) num += 100.f; for (int t = basesh / 256; t < ntiles; ++t) if (CW(int, WS_TILEE)[t] != NE) num += 1.f; }
    chk_acc(a.ws, 14, num, den);
}
__global__ void chk15(CArgs a) {
    const unsigned sid = blockIdx.x * blockDim.x + threadIdx.x; const unsigned r = hsh(sid + 151u); const unsigned* ctl = (const unsigned*)(a.ws + WS_CTL); const int ntiles = (int)ctl[CW_NTILES];
    const int row = r % (ntiles * 256), j = (r >> 20) & 255, e_ = CW(int, WS_TILEE)[row >> 8], tok = CW(int, WS_ROWTOK)[row];
    const float* w = (e_ < NE) ? a.in[22] + (size_t)e_ * 1024 * 512 : a.in[24]; const bf16* h = CW(bf16, WS_H) + (size_t)tok * D; float s1 = 0.f, s2 = 0.f;
    for (int k = 0; k < D; ++k) { const float hv = bf2f(h[k]); s1 += hv * bfr(w[(size_t)k * 512 + j]); s2 += hv * bfr(w[(size_t)k * 512 + 256 + j]); }
    const float e = siluf_(s1) * s2, f = bf2f(CW(bf16, WS_HB)[(size_t)row * EH + j]); chk_acc(a.ws, 15, (f - e) * (f - e), e * e);
}
__global__ void chk16(CArgs a) {
    const unsigned sid = blockIdx.x * blockDim.x + threadIdx.x; const unsigned r = hsh(sid + 161u); const unsigned* ctl = (const unsigned*)(a.ws + WS_CTL); const int ntiles = (int)ctl[CW_NTILES];
    const int row = r % (ntiles * 256), col = (r >> 20) & 1023, e_ = CW(int, WS_TILEE)[row >> 8];
    const float* w = (e_ < NE) ? a.in[23] + (size_t)e_ * 256 * 1024 : a.in[25]; const bf16* h = CW(bf16, WS_HB) + (size_t)row * EH; float s = 0.f;
    for (int k = 0; k < EH; ++k) s += bf2f(h[k]) * bfr(w[(size_t)k * 1024 + col]);
    const float f = bf2f(CW(bf16, WS_YB)[(size_t)row * D + col]); chk_acc(a.ws, 16, (f - s) * (f - s), s * s);
}
__global__ void chk_verdict(CArgs a) {
    const float* e = (const float*)(a.ws + WS_CTL) + CW_ERR; const unsigned* ctl = (const unsigned*)(a.ws + WS_CTL); int bad = -1;
    for (int k = 0; k < 17; ++k) { const float num = e[2 * k], den = e[2 * k + 1]; if (k == 8) continue; if (!(num <= 2e-3f * den) || !(den > 0.f)) { bad = k; break; } }
    if (ctl[CW_BAR + XB_TMO]) bad = 27;
    if (bad < 0) return; const float al = 3.f + bad;
    for (size_t i = (size_t)blockIdx.x * blockDim.x + threadIdx.x; i < (size_t)T * D; i += (size_t)gridDim.x * blockDim.x) a.out[i] = al * a.in[0][i];
}
#endif
#if EMIT_AFTER >= 0
__global__ void emit_k(CArgs a, int k) {
    const unsigned* ctl = (const unsigned*)(a.ws + WS_CTL);
    for (size_t i = (size_t)blockIdx.x * blockDim.x + threadIdx.x; i < (size_t)T * D; i += (size_t)gridDim.x * blockDim.x) {
        const int t = (int)(i >> 10), c = (int)(i & 1023); float v = 0.f;
        if (k == 1) v = bf2f(CW(bf16, WS_H)[i]) + CW(float, WS_MOD)[(t & 3) * 6144 + c] + bf2f(CW(bf16, WS_WINT)[(size_t)(t % NPROJ) * 1024 + c]) + bf2f(CW(bf16, WS_W13T)[(size_t)t * 4009 * 1024 % ((size_t)NEX * 512 * 1024) + c]);
        if (k == 2) { for (int q = 0; q < 7; ++q) v += bf2f(CW(bf16, WS_PROJ)[(size_t)t * PW + q * 1024 + c]); if ((c & 63) < 48) v += CW(float, WS_DT)[(size_t)t * 64 + (c & 63)]; }
        if (k == 20) v = bf2f(CW(bf16, WS_PROJ)[(size_t)t * PW + PC_FR + c]);
        if (k == 21) v = bf2f(CW(bf16, WS_WINT)[(size_t)(PC_FR + (t & 1023)) * 1024 + c]) + bf2f(CW(bf16, WS_WM1)[(i & 16383)]) + CW(f32x2, WS_TW)[i & 8191].x + CW(f32x2, WS_TW)[i & 8191].y;
        if (k == 3) { v = bf2f(CW(bf16, WS_ST)[i]) + bf2f(CW(bf16, WS_ST)[i + (size_t)T * D]) + bf2f(CW(bf16, WS_ST)[i + 2 * (size_t)T * D]); }
        if (k == 5) { v = bf2f(CW(bf16, WS_ST)[i]) + bf2f(CW(bf16, WS_ST)[i + (size_t)T * D]) + bf2f(CW(bf16, WS_ST)[i + 2 * (size_t)T * D]); }
        if (k == 4) v = a.in[0][i] + 1000.f * (bf2f(CW(bf16, WS_GB)[i]) - bf2f(CW(bf16, WS_MIX)[i]));
        if (k == 6) v = bf2f(CW(bf16, WS_GB)[i]) + bf2f(CW(bf16, WS_FO)[(size_t)t * 512 + (c & 511)]);
        if (k == 7) v = bf2f(CW(bf16, WS_YN)[(size_t)t * INNER + c]) + bf2f(CW(bf16, WS_YN)[(size_t)t * INNER + 512 + c]);
        if (k == 9) v = bf2f(CW(bf16, WS_MIX)[i]);
        if (k == 10) v = bf2f(CW(bf16, WS_MIXED)[i]);
        if (k == 12) v = CW(float, WS_LOG)[(size_t)t * 256 + (c & 255)] + bf2f(CW(bf16, WS_H)[i]) + a.out[i];
        if (k == 13) v = (float)CW(int, WS_TOPI)[t * 8 + (c & 7)] + CW(float, WS_TOPW)[t * 8 + (c & 7)];
        if (k == 15) { for (int q = 0; q < 8; ++q) v += bf2f(CW(bf16, WS_HB)[(size_t)CW(int, WS_TOKPOS)[t * 8 + q] * EH + (c & 255)]); v += bf2f(CW(bf16, WS_HB)[(size_t)(ctl[CW_BASESH] + t) * EH + (c & 255)]); }
        if (k == 16) { for (int q = 0; q < 8; ++q) v += CW(float, WS_TOPW)[t * 8 + q] * bf2f(CW(bf16, WS_YB)[(size_t)CW(int, WS_TOKPOS)[t * 8 + q] * D + c]); v += bf2f(CW(bf16, WS_YB)[(size_t)(ctl[CW_BASESH] + t) * D + c]); }
        a.out[i] = v;
    }
}
#endif
template <int K> static void launch_phase(const Args& a, int grid, hipStream_t stream) {
    static bool attr = false;
    if (!attr) { (void)hipFuncSetAttribute((const void*)fwd<K, K + 1>, hipFuncAttributeMaxDynamicSharedMemorySize, LDS_BYTES); attr = true; }
    hipLaunchKernelGGL((fwd<K, K + 1>), dim3(grid), dim3(NTHR), LDS_BYTES, stream, a);
}
extern "C" void kernel_launch(void* const* d_in, const int* in_sizes, int n_in, void* d_out, int out_size, void* d_ws, size_t ws_size, hipStream_t stream) {
    static int grid = 0;
    if (grid == 0) {
        if (n_in != 26 || out_size != T * D || ws_size < WS_END) { fprintf(stderr, "kernel_launch: unexpected shapes (n_in %d, out %d, ws %zu < %zu)\n", n_in, out_size, ws_size, (size_t)WS_END); grid = -1; return; }
        int dev = 0, cus = 0;
        if (hipGetDevice(&dev) != hipSuccess || hipDeviceGetAttribute(&cus, hipDeviceAttributeMultiprocessorCount, dev) != hipSuccess) { grid = -1; return; }
#if !MULTI_LAUNCH
        if (hipFuncSetAttribute((const void*)fwd<0, NPH>, hipFuncAttributeMaxDynamicSharedMemorySize, LDS_BYTES) != hipSuccess) { fprintf(stderr, "kernel_launch: hipFuncSetAttribute failed\n"); grid = -1; return; }
        int per_cu = 0; (void)hipOccupancyMaxActiveBlocksPerMultiprocessor(&per_cu, (const void*)fwd<0, NPH>, NTHR, LDS_BYTES); (void)hipGetLastError();
        if (per_cu < 1) fprintf(stderr, "kernel_launch: note: occupancy query reports %d\n", per_cu);
#endif
        grid = cus;
    }
    if (grid < 0) return;
    (void)hipMemsetAsync((char*)d_ws + WS_CTL, 0, CTL_ZERO_BYTES, stream);
    Args a{};
    for (int i = 0; i < 26; ++i) a.in[i] = (const float*)d_in[i];
    a.out = (float*)d_out; a.ws = (unsigned char*)d_ws;
#if MULTI_LAUNCH
#if DEV_CHECKS
    CArgs ca{}; for (int i = 0; i < 26; ++i) ca.in[i] = a.in[i]; ca.out = a.out; ca.ws = a.ws;
#define CHK(k, g, b) hipLaunchKernelGGL(chk##k, dim3(g), dim3(b), 0, stream, ca)
#else
#define CHK(k, g, b) do {} while (0)
#endif
    launch_phase<0>(a, grid, stream); CHK(0, 256, 256);
#if (DUP_MASK >> 0) & 1
    launch_phase<0>(a, grid, stream);
#endif
#if EMIT_AFTER == 0
    { CArgs ce{}; for (int i = 0; i < 26; ++i) ce.in[i] = a.in[i]; ce.out = a.out; ce.ws = a.ws; hipLaunchKernelGGL(emit_k, dim3(2048), dim3(256), 0, stream, ce, 0); return; }
#endif
    launch_phase<1>(a, grid, stream); CHK(1, 16, 256);
#if (DUP_MASK >> 1) & 1
    launch_phase<1>(a, grid, stream);
#endif
#if EMIT_AFTER == 1
    { CArgs ce{}; for (int i = 0; i < 26; ++i) ce.in[i] = a.in[i]; ce.out = a.out; ce.ws = a.ws; hipLaunchKernelGGL(emit_k, dim3(2048), dim3(256), 0, stream, ce, 1); return; }
#endif
    launch_phase<2>(a, grid, stream); CHK(2, 256, 256);
#if (DUP_MASK >> 2) & 1
    launch_phase<2>(a, grid, stream);
#endif
#if EMIT_AFTER == 20 || EMIT_AFTER == 21
    { CArgs ce{}; for (int i = 0; i < 26; ++i) ce.in[i] = a.in[i]; ce.out = a.out; ce.ws = a.ws; hipLaunchKernelGGL(emit_k, dim3(2048), dim3(256), 0, stream, ce, EMIT_AFTER); return; }
#endif
#if EMIT_AFTER == 2
    { CArgs ce{}; for (int i = 0; i < 26; ++i) ce.in[i] = a.in[i]; ce.out = a.out; ce.ws = a.ws; hipLaunchKernelGGL(emit_k, dim3(2048), dim3(256), 0, stream, ce, 2); return; }
#endif
#if EMIT_AFTER != 4
    launch_phase<3>(a, grid, stream); CHK(3, 32, 256);
#if (DUP_MASK >> 3) & 1
    launch_phase<3>(a, grid, stream);
#endif
#endif
#if EMIT_AFTER == 3
    { CArgs ce{}; for (int i = 0; i < 26; ++i) ce.in[i] = a.in[i]; ce.out = a.out; ce.ws = a.ws; hipLaunchKernelGGL(emit_k, dim3(2048), dim3(256), 0, stream, ce, 3); return; }
#endif
    launch_phase<4>(a, grid, stream); CHK(4, 256, 256);
#if (DUP_MASK >> 4) & 1
    launch_phase<4>(a, grid, stream);
#endif
#if EMIT_AFTER == 4
    (void)hipMemcpyAsync((char*)d_ws + WS_MIX, (char*)d_ws + WS_GB, (size_t)T * D * 2, hipMemcpyDeviceToDevice, stream); launch_phase<4>(a, grid, stream);
    { CArgs ce{}; for (int i = 0; i < 26; ++i) ce.in[i] = a.in[i]; ce.out = a.out; ce.ws = a.ws; hipLaunchKernelGGL(emit_k, dim3(2048), dim3(256), 0, stream, ce, 4); return; }
#endif
    launch_phase<5>(a, grid, stream); CHK(5, 32, 256);
#if (DUP_MASK >> 5) & 1
    launch_phase<5>(a, grid, stream);
#endif
#if EMIT_AFTER == 5
    { CArgs ce{}; for (int i = 0; i < 26; ++i) ce.in[i] = a.in[i]; ce.out = a.out; ce.ws = a.ws; hipLaunchKernelGGL(emit_k, dim3(2048), dim3(256), 0, stream, ce, 5); return; }
#endif
    launch_phase<6>(a, grid, stream); CHK(6, 256, 256);
#if (DUP_MASK >> 6) & 1
    launch_phase<6>(a, grid, stream);
#endif
#if EMIT_AFTER == 6
    { CArgs ce{}; for (int i = 0; i < 26; ++i) ce.in[i] = a.in[i]; ce.out = a.out; ce.ws = a.ws; hipLaunchKernelGGL(emit_k, dim3(2048), dim3(256), 0, stream, ce, 6); return; }
#endif
    launch_phase<7>(a, grid, stream); CHK(7, 256, 384);
#if (DUP_MASK >> 7) & 1
    launch_phase<7>(a, grid, stream);
#endif
#if EMIT_AFTER == 7
    { CArgs ce{}; for (int i = 0; i < 26; ++i) ce.in[i] = a.in[i]; ce.out = a.out; ce.ws = a.ws; hipLaunchKernelGGL(emit_k, dim3(2048), dim3(256), 0, stream, ce, 7); return; }
#endif
    launch_phase<8>(a, grid, stream);
#if (DUP_MASK >> 8) & 1
    launch_phase<8>(a, grid, stream);
#endif
#if EMIT_AFTER == 8
    { CArgs ce{}; for (int i = 0; i < 26; ++i) ce.in[i] = a.in[i]; ce.out = a.out; ce.ws = a.ws; hipLaunchKernelGGL(emit_k, dim3(2048), dim3(256), 0, stream, ce, 8); return; }
#endif
    launch_phase<9>(a, grid, stream); CHK(9, 256, 256);
#if (DUP_MASK >> 9) & 1
    launch_phase<9>(a, grid, stream);
#endif
#if EMIT_AFTER == 9
    { CArgs ce{}; for (int i = 0; i < 26; ++i) ce.in[i] = a.in[i]; ce.out = a.out; ce.ws = a.ws; hipLaunchKernelGGL(emit_k, dim3(2048), dim3(256), 0, stream, ce, 9); return; }
#endif
    launch_phase<10>(a, grid, stream); CHK(10, 256, 256);
#if (DUP_MASK >> 10) & 1
    launch_phase<10>(a, grid, stream);
#endif
#if EMIT_AFTER == 10
    { CArgs ce{}; for (int i = 0; i < 26; ++i) ce.in[i] = a.in[i]; ce.out = a.out; ce.ws = a.ws; hipLaunchKernelGGL(emit_k, dim3(2048), dim3(256), 0, stream, ce, 10); return; }
#endif
    launch_phase<11>(a, grid, stream); CHK(11, 16, 256);
#if (DUP_MASK >> 11) & 1
    launch_phase<11>(a, grid, stream);
#endif
#if EMIT_AFTER == 11
    { CArgs ce{}; for (int i = 0; i < 26; ++i) ce.in[i] = a.in[i]; ce.out = a.out; ce.ws = a.ws; hipLaunchKernelGGL(emit_k, dim3(2048), dim3(256), 0, stream, ce, 11); return; }
#endif
    launch_phase<12>(a, grid, stream); CHK(12, 256, 256);
#if (DUP_MASK >> 12) & 1
    launch_phase<12>(a, grid, stream);
#endif
#if EMIT_AFTER == 12
    { CArgs ce{}; for (int i = 0; i < 26; ++i) ce.in[i] = a.in[i]; ce.out = a.out; ce.ws = a.ws; hipLaunchKernelGGL(emit_k, dim3(2048), dim3(256), 0, stream, ce, 12); return; }
#endif
    launch_phase<13>(a, grid, stream); CHK(13, 32, 256);
#if (DUP_MASK >> 13) & 1
    launch_phase<13>(a, grid, stream);
#endif
#if EMIT_AFTER == 13
    { CArgs ce{}; for (int i = 0; i < 26; ++i) ce.in[i] = a.in[i]; ce.out = a.out; ce.ws = a.ws; hipLaunchKernelGGL(emit_k, dim3(2048), dim3(256), 0, stream, ce, 13); return; }
#endif
    launch_phase<14>(a, grid, stream); CHK(14, 1024, 256);
#if (DUP_MASK >> 14) & 1
    launch_phase<14>(a, grid, stream);
#endif
#if EMIT_AFTER == 14
    { CArgs ce{}; for (int i = 0; i < 26; ++i) ce.in[i] = a.in[i]; ce.out = a.out; ce.ws = a.ws; hipLaunchKernelGGL(emit_k, dim3(2048), dim3(256), 0, stream, ce, 14); return; }
#endif
    launch_phase<15>(a, grid, stream); CHK(15, 256, 256);
#if (DUP_MASK >> 15) & 1
    launch_phase<15>(a, grid, stream);
#endif
#if EMIT_AFTER == 15
    { CArgs ce{}; for (int i = 0; i < 26; ++i) ce.in[i] = a.in[i]; ce.out = a.out; ce.ws = a.ws; hipLaunchKernelGGL(emit_k, dim3(2048), dim3(256), 0, stream, ce, 15); return; }
#endif
    launch_phase<16>(a, grid, stream); CHK(16, 256, 256);
#if (DUP_MASK >> 16) & 1
    launch_phase<16>(a, grid, stream);
#endif
#if EMIT_AFTER == 16
    { CArgs ce{}; for (int i = 0; i < 26; ++i) ce.in[i] = a.in[i]; ce.out = a.out; ce.ws = a.ws; hipLaunchKernelGGL(emit_k, dim3(2048), dim3(256), 0, stream, ce, 16); return; }
#endif
    launch_phase<17>(a, grid, stream);
#if (DUP_MASK >> 17) & 1
    launch_phase<17>(a, grid, stream);
#endif
#if EMIT_AFTER == 17
    { CArgs ce{}; for (int i = 0; i < 26; ++i) ce.in[i] = a.in[i]; ce.out = a.out; ce.ws = a.ws; hipLaunchKernelGGL(emit_k, dim3(2048), dim3(256), 0, stream, ce, 17); return; }
#endif
#if DEV_CHECKS
    hipLaunchKernelGGL(chk_verdict, dim3(1024), dim3(256), 0, stream, ca);
#endif
#else
    hipLaunchKernelGGL((fwd<0, NPH>), dim3(grid), dim3(NTHR), LDS_BYTES, stream, a);
#endif
}
```

```cpp
#include <hip/hip_runtime.h>
#include <cstdio>
#include <cstdint>
#include <cmath>
#define MULTI_LAUNCH 0
#define DEV_CHECKS 0
#define EMIT_AFTER -1
#define DFT_DEBUG 0
#define KSTART_INV 0
#define DUP_MASK 0
#define TIMING 0
#define TA_LO 0
#define TA_HI 0
#define TB_LO 0
#define TB_HI 0
#define PRE_K -1
namespace pg8 {
#define PG8_LAS __attribute__((address_space(3)))
typedef unsigned short bf16_t;
typedef short bf16x8 __attribute__((ext_vector_type(8)));
typedef float f32x4 __attribute__((ext_vector_type(4)));
typedef unsigned u32x4 __attribute__((ext_vector_type(4)));
typedef unsigned u32x2 __attribute__((ext_vector_type(2)));
constexpr int BM = 256, BK = 64, HALF = 128, HTB = HALF * BK * 2  , STAGE_BYTES = 8 * HTB, NXCD = 8, WGM = 8;

__host__ __device__ __forceinline__ int lds_byte(int r, int c) { const int st = (r >> 4) * 2 + (c >> 5), rr = r & 15, cc = c & 31, ob = rr * 64 + cc * 2; return st * 1024 + (ob ^ (((ob >> 9) & 1) << 5)); }
__host__ __device__ __forceinline__ void stage_rc(int b, int& R, int& C) { const int st = b / 1024, sb = b % 1024, swz = sb ^ (((sb >> 9) & 1) << 5); R = (st >> 1) * 16 + swz / 64; C = (st & 1) * 32 + (swz % 64) / 2; }
__host__ __device__ __forceinline__ int perm32(int rho) { const int n = rho >> 4, i = rho & 15; return 8 * (i >> 2) + 4 * n + (i & 3); }

struct Unit { int pm, pn; };
struct Gemm { const bf16_t* A; const bf16_t* Bt; int M, N, K; const int* rowtok; };

struct StaticOrder {
    int nM, nN, nwg, G, c;
    __host__ __device__ void init(int M, int N, int G_, int c_) { nM = M / BM; nN = N / BM; nwg = nM * nN; G = G_; c = c_; }
    __host__ __device__ bool next(int i, Unit& u) const {
        const long L = (long)i * G + c; if (L >= nwg) return false;
        int wgid = (int)L; { const int q = nwg / NXCD, r = nwg % NXCD, xcd = wgid % NXCD, off = wgid / NXCD; wgid = (xcd < r ? xcd * (q + 1) : r * (q + 1) + (xcd - r) * q) + off; }
        const int nig = WGM * nN, gid = wgid / nig, fm = gid * WGM, gsz = (nM - fm) < WGM ? (nM - fm) : WGM;
        u.pm = fm + ((wgid % nig) % gsz); u.pn = (wgid % nig) / gsz; return true;
    }
};
template <int NJ> struct GroupedOrder {
    const PG8_LAS int* tile_e; int ntiles, G, c, t0;
    __device__ bool next(int i, Unit& u) const {
        int t, j;
        if ((G & 7) == 0 && ((G >> 3) % NJ) == 0) { const int x = c & 7, slot = c >> 3, tpx = (G >> 3) / NJ; t = (i * 8 + x) * tpx + slot / NJ; j = slot % NJ; }
        else { const int L = i * G + c; t = L / NJ; j = L % NJ; }
        t += t0; if (t >= ntiles) return false;
        u.pm = t; u.pn = __builtin_amdgcn_readfirstlane(tile_e[t]) * NJ + j; return true;
    }
};

struct SharedOrder {
    int nt, e, c0, nb, c;
    __device__ bool next(int i, Unit& u) const { const int L = i * nb + (c - c0); if (c < c0 || L >= nt * 2) return false; u.pm = L >> 1; u.pn = e * 2 + (L & 1); return true; }
};
__device__ __forceinline__ unsigned cvt_pk_bf16(float lo, float hi) { unsigned r; asm volatile("v_cvt_pk_bf16_f32 %0, %1, %2" : "=v"(r) : "v"(lo), "v"(hi)); return r; }
__device__ __forceinline__ float bf_lo(unsigned w) { return __uint_as_float(w << 16); }
__device__ __forceinline__ float bf_hi(unsigned w) { return __uint_as_float(w & 0xffff0000u); }
__device__ __forceinline__ float sigmoidf_(float x) { return __builtin_amdgcn_rcpf(1.f + __expf(-x)); }

struct EpiF32 {
    static constexpr bool PERM = false;
    float* C; int ldc;
    __device__ __forceinline__ void operator()(const f32x4 (&acc)[2][2][4][2], const Unit& u, int wr, int wc, int fr, int fq) const {
        const int row0 = u.pm * BM + wr * 64 + fr, col0 = u.pn * BM + wc * 32 + 4 * fq;
#pragma unroll
        for (int ai = 0; ai < 2; ++ai)
#pragma unroll
            for (int m = 0; m < 4; ++m) { float* rowp = C + (size_t)(row0 + ai * HALF + m * 16) * ldc + col0;
#pragma unroll
                for (int bj = 0; bj < 2; ++bj)
#pragma unroll
                    for (int n = 0; n < 2; ++n) *(f32x4*)(rowp + bj * HALF + n * 16) = acc[ai][bj][m][n]; }
    }
};
template <int NCOLT> struct EpiBf16 {
    static constexpr bool PERM = true;
    bf16_t* O; int ldc;
    __device__ __forceinline__ void operator()(const f32x4 (&acc)[2][2][4][2], const Unit& u, int wr, int wc, int fr, int fq) const {
        const int row0 = u.pm * BM + wr * 64 + fr; const int col0 = (u.pn & (NCOLT - 1)) * BM + wc * 32 + 8 * fq;
#pragma unroll
        for (int ai = 0; ai < 2; ++ai)
#pragma unroll
            for (int m = 0; m < 4; ++m) { bf16_t* rowp = O + (size_t)(row0 + ai * HALF + m * 16) * ldc + col0;
#pragma unroll
                for (int bj = 0; bj < 2; ++bj) { const f32x4 v0 = acc[ai][bj][m][0], v1 = acc[ai][bj][m][1];
                    u32x4 w; w.x = cvt_pk_bf16(v0[0], v0[1]); w.y = cvt_pk_bf16(v0[2], v0[3]); w.z = cvt_pk_bf16(v1[0], v1[1]); w.w = cvt_pk_bf16(v1[2], v1[3]);
                    *(u32x4*)(rowp + bj * HALF) = w; } }
    }
};
template <int NCOLT> struct EpiFp8 {
    static constexpr bool PERM = true;
    unsigned char* O; int ldc; const PG8_LAS int* valid; float scale;
    __device__ __forceinline__ void operator()(const f32x4 (&acc)[2][2][4][2], const Unit& u, int wr, int wc, int fr, int fq) const {
        const int rl0 = wr * 64 + fr, nv = valid[u.pm]; const int col0 = (u.pn & (NCOLT - 1)) * BM + wc * 32 + 8 * fq;
#pragma unroll
        for (int ai = 0; ai < 2; ++ai)
#pragma unroll
            for (int m = 0; m < 4; ++m) { const int rl = rl0 + ai * HALF + m * 16; if (rl < nv) { unsigned char* rowp = O + (size_t)(u.pm * BM + rl) * ldc + col0;
#pragma unroll
                for (int bj = 0; bj < 2; ++bj) { const f32x4 v0 = acc[ai][bj][m][0] * scale, v1 = acc[ai][bj][m][1] * scale;
                    int w0 = __builtin_amdgcn_cvt_pk_fp8_f32(v0[0], v0[1], 0, false); w0 = __builtin_amdgcn_cvt_pk_fp8_f32(v0[2], v0[3], w0, true);
                    int w1 = __builtin_amdgcn_cvt_pk_fp8_f32(v1[0], v1[1], 0, false); w1 = __builtin_amdgcn_cvt_pk_fp8_f32(v1[2], v1[3], w1, true);
                    u32x2 w; w.x = (unsigned)w0; w.y = (unsigned)w1; *(u32x2*)(rowp + bj * HALF) = w; } } }
    }
};
struct EpiProj {
    static constexpr bool PERM = true;
    bf16_t* O; int ldc; float* DT;
    __device__ __forceinline__ void operator()(const f32x4 (&acc)[2][2][4][2], const Unit& u, int wr, int wc, int fr, int fq) const {
        const int row0 = u.pm * BM + wr * 64 + fr;
        if (u.pn < 28) {
            const int col0 = u.pn * BM + wc * 32 + 8 * fq; const bool sg = u.pn >= 20;
#pragma unroll
            for (int ai = 0; ai < 2; ++ai)
#pragma unroll
                for (int m = 0; m < 4; ++m) { bf16_t* rowp = O + (size_t)(row0 + ai * HALF + m * 16) * ldc + col0;
#pragma unroll
                    for (int bj = 0; bj < 2; ++bj) { f32x4 v0 = acc[ai][bj][m][0], v1 = acc[ai][bj][m][1];
                        if (sg) {
#pragma unroll
                            for (int j = 0; j < 4; ++j) { v0[j] = sigmoidf_(v0[j]); v1[j] = sigmoidf_(v1[j]); } }
                        u32x4 w; w.x = cvt_pk_bf16(v0[0], v0[1]); w.y = cvt_pk_bf16(v0[2], v0[3]); w.z = cvt_pk_bf16(v1[0], v1[1]); w.w = cvt_pk_bf16(v1[2], v1[3]);
                        *(u32x4*)(rowp + bj * HALF) = w; } }
        } else {
            const int c0 = wc * 32 + 8 * fq;
            if (c0 + 7 < 48) {
#pragma unroll
                for (int ai = 0; ai < 2; ++ai)
#pragma unroll
                    for (int m = 0; m < 4; ++m) { float* rowp = DT + (size_t)(row0 + ai * HALF + m * 16) * 64 + c0;
                        *(f32x4*)(rowp) = acc[ai][0][m][0]; *(f32x4*)(rowp + 4) = acc[ai][0][m][1]; }
            }
        }
    }
};
template <bool ADD> struct EpiGate {
    static constexpr bool PERM = true;
    bf16_t* O; int ldc; const bf16_t* G; int ldg; int gcol0;
    __device__ __forceinline__ void operator()(const f32x4 (&acc)[2][2][4][2], const Unit& u, int wr, int wc, int fr, int fq) const {
        const int row0 = u.pm * BM + wr * 64 + fr; const int col0 = u.pn * BM + wc * 32 + 8 * fq;
#pragma unroll
        for (int ai = 0; ai < 2; ++ai)
#pragma unroll
            for (int m = 0; m < 4; ++m) { const size_t r = (size_t)(row0 + ai * HALF + m * 16); bf16_t* rowp = O + r * ldc + col0; const bf16_t* gp = G + r * ldg + gcol0 + col0;
#pragma unroll
                for (int bj = 0; bj < 2; ++bj) { const f32x4 v0 = acc[ai][bj][m][0], v1 = acc[ai][bj][m][1];
                    const u32x4 gw = *(const u32x4*)(gp + bj * HALF);
                    float o[8] = { v0[0] * bf_lo(gw.x), v0[1] * bf_hi(gw.x), v0[2] * bf_lo(gw.y), v0[3] * bf_hi(gw.y), v1[0] * bf_lo(gw.z), v1[1] * bf_hi(gw.z), v1[2] * bf_lo(gw.w), v1[3] * bf_hi(gw.w) };
                    if (ADD) { const u32x4 pw = *(const u32x4*)(rowp + bj * HALF);
                        o[0] += bf_lo(pw.x); o[1] += bf_hi(pw.x); o[2] += bf_lo(pw.y); o[3] += bf_hi(pw.y); o[4] += bf_lo(pw.z); o[5] += bf_hi(pw.z); o[6] += bf_lo(pw.w); o[7] += bf_hi(pw.w); }
                    u32x4 w; w.x = cvt_pk_bf16(o[0], o[1]); w.y = cvt_pk_bf16(o[2], o[3]); w.z = cvt_pk_bf16(o[4], o[5]); w.w = cvt_pk_bf16(o[6], o[7]);
                    *(u32x4*)(rowp + bj * HALF) = w; } }
    }
};
struct EpiSwiglu {
    static constexpr bool PERM = true;
    bf16_t* O; int ldc;
    __device__ __forceinline__ void operator()(const f32x4 (&acc)[2][2][4][2], const Unit& u, int wr, int wc, int fr, int fq) const {
        const int row0 = u.pm * BM + wr * 64 + fr; const int col0 = (u.pn & 1) * HALF + wc * 32 + 8 * fq;
#pragma unroll
        for (int ai = 0; ai < 2; ++ai)
#pragma unroll
            for (int m = 0; m < 4; ++m) { bf16_t* rowp = O + (size_t)(row0 + ai * HALF + m * 16) * ldc + col0;
                float o[8];
#pragma unroll
                for (int n = 0; n < 2; ++n)
#pragma unroll
                    for (int j = 0; j < 4; ++j) { const float a = acc[ai][0][m][n][j], gg = acc[ai][1][m][n][j]; o[4 * n + j] = a * sigmoidf_(a) * gg; }
                u32x4 w; w.x = cvt_pk_bf16(o[0], o[1]); w.y = cvt_pk_bf16(o[2], o[3]); w.z = cvt_pk_bf16(o[4], o[5]); w.w = cvt_pk_bf16(o[6], o[7]);
                *(u32x4*)(rowp) = w; }
    }
};

template <class Epi, class Sched, bool ALIGN_EPI, bool GATHER>
__device__ __forceinline__ void gemm_phase(PG8_LAS unsigned char* lds, const Gemm g, const Sched& S, const Epi& E) {
    int tid_ = threadIdx.x; asm volatile("" : "+v"(tid_));
    const int tid = tid_, wid = __builtin_amdgcn_readfirstlane(tid >> 6), lane = tid & 63, wr = wid >> 2, wc = wid & 3, fr = lane & 15, fq = lane >> 4;
    const int K = g.K, nt = K / BK;
    unsigned voffA[2], voffB[2];
#pragma unroll
    for (int i = 0; i < 2; ++i) { int R, C; stage_rc(tid * 16 + i * 8192, R, C); const int Rb = Epi::PERM ? ((R & ~31) + perm32(R & 31)) : R;
        voffA[i] = (unsigned)(R * K + C) * 2u; voffB[i] = (unsigned)(Rb * K + C) * 2u; }
    const size_t kstep = (size_t)(BK * 2);
    const size_t hstep = (size_t)HALF * K * 2;
    const size_t tstep = 2 * hstep;
    const unsigned rowB = (unsigned)K * 2u;
    const unsigned ldsw = (unsigned)wid * 1024u;
    const int aoff = lds_byte(wr * 64 + fr, fq * 8), boff = lds_byte(wc * 32 + fr, fq * 8);
#define PG8_SA(b, h) (((b) * 2 + (h)) * HTB)
#define PG8_SB(b, h) ((4 + (b) * 2 + (h)) * HTB)
#define PG8_STAGE(bufoff, gbase, voff) do { _Pragma("unroll") for (int _i = 0; _i < 2; ++_i) \
        __builtin_amdgcn_global_load_lds((const unsigned*)((const char*)(gbase) + (voff)[_i]), (PG8_LAS unsigned*)(lds + (bufoff) + ldsw + _i * 8192), 16, 0, 0); } while (0)
#define PG8_STAGE_A(bufoff, ptr_ng, offs, h, kb) do { _Pragma("unroll") for (int _i = 0; _i < 2; ++_i) { const char* _src; \
        if constexpr (GATHER) _src = (const char*)g.A + (size_t)(offs)[h][_i] + (size_t)(kb); else _src = (const char*)(ptr_ng) + voffA[_i]; \
        __builtin_amdgcn_global_load_lds((const unsigned*)_src, (PG8_LAS unsigned*)(lds + (bufoff) + ldsw + _i * 8192), 16, 0, 0); } } while (0)
#define PG8_LDA(dst, b, h) do { _Pragma("unroll") for (int m = 0; m < 4; ++m) _Pragma("unroll") for (int k = 0; k < 2; ++k) dst[m][k] = *(const PG8_LAS bf16x8*)(lds + PG8_SA(b, h) + aoff + m * 2048 + k * 1024); } while (0)
#define PG8_LDB(dst, b, h) do { _Pragma("unroll") for (int n = 0; n < 2; ++n) _Pragma("unroll") for (int k = 0; k < 2; ++k) dst[n][k] = *(const PG8_LAS bf16x8*)(lds + PG8_SB(b, h) + boff + n * 2048 + k * 1024); } while (0)
#define PG8_MMA(ai, bj, At, Bt) do { __builtin_amdgcn_s_setprio(1); _Pragma("unroll") for (int m = 0; m < 4; ++m) _Pragma("unroll") for (int n = 0; n < 2; ++n) _Pragma("unroll") for (int k = 0; k < 2; ++k) \
        acc[ai][bj][m][n] = __builtin_amdgcn_mfma_f32_16x16x32_bf16(Bt[n][k], At[m][k], acc[ai][bj][m][n], 0, 0, 0); __builtin_amdgcn_s_setprio(0); } while (0)
#define PG8_WAIT_V(n) asm volatile("s_waitcnt vmcnt(" #n ")" ::: "memory")
#define PG8_WAIT_L(n) asm volatile("s_waitcnt lgkmcnt(" #n ")" ::: "memory")
#define PG8_BAR __builtin_amdgcn_s_barrier()
#define PG8_SCHED __builtin_amdgcn_sched_barrier(0)
#define PG8_GOFFS(dst, unit) do { _Pragma("unroll") for (int _i = 0; _i < 2; ++_i) { int _R, _C; stage_rc(tid * 16 + _i * 8192, _R, _C); _Pragma("unroll") for (int _h = 0; _h < 2; ++_h) \
        dst[_h][_i] = (unsigned)g.rowtok[(unit).pm * BM + _h * HALF + _R] * rowB + (unsigned)_C * 2u; } } while (0)
    Unit cur, nxt; int ui = 0;
    if (!S.next(0, cur)) return;
    f32x4 acc[2][2][4][2];
#pragma unroll
    for (int a = 0; a < 2; ++a)
#pragma unroll
        for (int b = 0; b < 2; ++b)
#pragma unroll
            for (int m = 0; m < 4; ++m)
#pragma unroll
                for (int n = 0; n < 2; ++n) acc[a][b][m][n] = (f32x4){0.f, 0.f, 0.f, 0.f};
    bf16x8 At[4][2], B0[2][2], B1[2][2];
    unsigned co[2][2] = {{0u, 0u}, {0u, 0u}}, no[2][2] = {{0u, 0u}, {0u, 0u}};
    const char* cA = (const char*)g.A + (GATHER ? (size_t)0 : (size_t)cur.pm * tstep); const char* cB = (const char*)g.Bt + (size_t)cur.pn * tstep;
    if constexpr (GATHER) { PG8_GOFFS(co, cur); }
    PG8_STAGE(PG8_SB(0, 0), cB, voffB); PG8_STAGE(PG8_SB(0, 1), cB + hstep, voffB); PG8_STAGE_A(PG8_SA(0, 0), cA, co, 0, 0); PG8_STAGE_A(PG8_SA(0, 1), cA + hstep, co, 1, 0);
    if (wr == 1) PG8_BAR;
    PG8_WAIT_V(2); PG8_BAR;
    PG8_STAGE(PG8_SB(1, 0), cB + kstep, voffB); PG8_STAGE_A(PG8_SA(1, 0), cA + kstep, co, 0, kstep); PG8_STAGE(PG8_SB(1, 1), cB + hstep + kstep, voffB);
    PG8_WAIT_V(6); PG8_BAR;
    for (;;) {
        const bool has_next = S.next(ui + 1, nxt);
        const char* nA = (has_next && !GATHER) ? (const char*)g.A + (size_t)nxt.pm * tstep : cA; const char* nB = has_next ? (const char*)g.Bt + (size_t)nxt.pn * tstep : cB;
        if constexpr (GATHER) { if (has_next) { PG8_GOFFS(no, nxt); } else {
#pragma unroll
            for (int _h = 0; _h < 2; ++_h)
#pragma unroll
                for (int _i = 0; _i < 2; ++_i) no[_h][_i] = co[_h][_i]; } }
#pragma unroll 1
        for (int t = 0; t < nt; t += 2) {
            const bool last = (t == nt - 2);
            const char* a1 = cA + (size_t)(t + 1) * kstep;
            const char* a2 = last ? nA : cA + (size_t)(t + 2) * kstep; const char* b2 = last ? nB : cB + (size_t)(t + 2) * kstep;
            const char* a3 = a2 + kstep; const char* b3 = b2 + kstep;
            unsigned so[2][2];
#pragma unroll
            for (int _h = 0; _h < 2; ++_h)
#pragma unroll
                for (int _i = 0; _i < 2; ++_i) so[_h][_i] = last ? no[_h][_i] : co[_h][_i];
            const size_t kb1 = (size_t)(t + 1) * kstep, kb2 = last ? (size_t)0 : (size_t)(t + 2) * kstep, kb3 = kb2 + kstep;
            PG8_LDB(B0, 0, 0); PG8_LDB(B1, 0, 1); PG8_SCHED; PG8_LDA(At, 0, 0); PG8_STAGE_A(PG8_SA(1, 1), a1 + hstep, co, 1, kb1);
            PG8_WAIT_V(8); PG8_WAIT_L(0); PG8_BAR; PG8_MMA(0, 0, At, B0); PG8_MMA(0, 1, At, B1); PG8_BAR; PG8_SCHED;
            PG8_LDA(At, 0, 1); PG8_STAGE(PG8_SB(0, 0), b2, voffB); PG8_STAGE(PG8_SB(0, 1), b2 + hstep, voffB); PG8_STAGE_A(PG8_SA(0, 0), a2, so, 0, kb2);
            PG8_WAIT_V(8); PG8_WAIT_L(0); PG8_BAR; PG8_MMA(1, 0, At, B0); PG8_MMA(1, 1, At, B1); PG8_BAR; PG8_SCHED;
            PG8_LDB(B0, 1, 0); PG8_LDB(B1, 1, 1); PG8_SCHED; PG8_LDA(At, 1, 0); PG8_STAGE_A(PG8_SA(0, 1), a2 + hstep, so, 1, kb2);
            PG8_WAIT_V(8); PG8_WAIT_L(0); PG8_BAR; PG8_MMA(0, 0, At, B0); PG8_MMA(0, 1, At, B1); PG8_BAR; PG8_SCHED;
            PG8_LDA(At, 1, 1); PG8_STAGE(PG8_SB(1, 0), b3, voffB); PG8_STAGE(PG8_SB(1, 1), b3 + hstep, voffB); PG8_STAGE_A(PG8_SA(1, 0), a3, so, 0, kb3);
            PG8_WAIT_V(8); PG8_WAIT_L(0); PG8_BAR; PG8_MMA(1, 0, At, B0); PG8_MMA(1, 1, At, B1); PG8_BAR; PG8_SCHED;
        }
        if constexpr (ALIGN_EPI) { if (wr == 0) PG8_BAR; }
        PG8_SCHED; asm volatile("s_nop 15\n\ts_nop 15\n\ts_nop 15\n\ts_nop 15" ::: "memory"); PG8_SCHED;
        E(acc, cur, wr, wc, fr, fq);
        if (!has_next) break;
#pragma unroll
        for (int a = 0; a < 2; ++a)
#pragma unroll
            for (int b = 0; b < 2; ++b)
#pragma unroll
                for (int m = 0; m < 4; ++m)
#pragma unroll
                    for (int n = 0; n < 2; ++n) acc[a][b][m][n] = (f32x4){0.f, 0.f, 0.f, 0.f};
        cur = nxt; cA = nA; cB = nB; ++ui;
#pragma unroll
        for (int _h = 0; _h < 2; ++_h)
#pragma unroll
            for (int _i = 0; _i < 2; ++_i) co[_h][_i] = no[_h][_i];
        if constexpr (ALIGN_EPI) { if (wr == 1) PG8_BAR; }
    }
    PG8_WAIT_V(0);
    if constexpr (!ALIGN_EPI) { if (wr == 0) PG8_BAR; }
    PG8_BAR;
#undef PG8_SA
#undef PG8_SB
#undef PG8_STAGE
#undef PG8_STAGE_A
#undef PG8_LDA
#undef PG8_LDB
#undef PG8_MMA
#undef PG8_WAIT_V
#undef PG8_WAIT_L
#undef PG8_BAR
#undef PG8_SCHED
#undef PG8_GOFFS
}
}
constexpr int NWAVES = 8, NTHR = 512;
constexpr int NB = 4, SEQ = 8192, T = NB * SEQ, D = 1024;
constexpr int HEADS = 24, HD = 64, INNER = 1536, NG = 4, NS = 128, CHUNK = 128, NCHUNK = SEQ / CHUNK, HPG = HEADS / NG;
constexpr int INW = 6704;
constexpr int SRC_DT = 4096, SRC_F = 4144, SRC_G = 4656;
constexpr int NE = 256, TOPK = 8, EH = 256, NEX = NE + 1;
constexpr int PC_Z = 0, PC_X = 1536, PC_B = 3072, PC_C = 3584, PC_FR = 4096, PC_FI = 4608, PC_GS = 5120, PC_GF = 6144, PW = 7168, NPROJ = 7424;
constexpr float RMS_EPS = 1e-6f;
constexpr int ROWS_R = T * TOPK + NE * 256;
constexpr int ROWS_ALL = ROWS_R + T;
constexpr int MAXTILES = ROWS_ALL / 256;

constexpr size_t MiB = 1u << 20;
constexpr size_t WS_CTL = 0, CTL_ZERO_BYTES = 1 * MiB;
constexpr size_t WS_MOD = 1 * MiB;
constexpr size_t WS_TW = WS_MOD + 128 * 1024;
constexpr size_t WS_WM1 = WS_TW + 64 * 1024;
constexpr size_t WS_WM2 = WS_WM1 + 32 * 1024;
constexpr size_t WS_CD = WS_WM2 + 64 * 1024;
constexpr size_t WS_BCNT = 2 * MiB;
constexpr size_t WS_TILEE = WS_BCNT + 256 * 1024;
constexpr size_t WS_TILEV = WS_TILEE + 8 * 1024;
constexpr float YB_SCALE = 8.f;
constexpr size_t WS_WINT = 4 * MiB;
constexpr size_t WS_WBST = 19 * MiB;
constexpr size_t WS_WBFT = 22 * MiB;
constexpr size_t WS_WOUTT = 23 * MiB;
constexpr size_t WS_WRT = 25 * MiB;
constexpr size_t WS_W13T = 26 * MiB;
constexpr size_t WS_W2T = 283 * MiB;
constexpr size_t WS_H = 412 * MiB;
constexpr size_t WS_PROJ = 476 * MiB;
constexpr size_t WS_DT = 924 * MiB;
constexpr size_t WS_ST = 932 * MiB;
constexpr size_t WS_STL = 1316 * MiB;
constexpr float STP_SCALE = 0.25f;
constexpr float STL_SCALE = 2.f;
constexpr size_t WS_XTG = 1508 * MiB;
constexpr size_t WS_BG = 1604 * MiB;
constexpr size_t WS_YN = 1124 * MiB;
constexpr size_t WS_GB = 1220 * MiB;
constexpr size_t WS_FO = 1284 * MiB;
constexpr size_t WS_MIX = 1316 * MiB;
constexpr size_t WS_MIXED = 1380 * MiB;
constexpr size_t WS_LOG = 1444 * MiB;
constexpr size_t WS_TOPI = 1476 * MiB, WS_TOPW = 1477 * MiB, WS_TOKPOS = 1478 * MiB, WS_ROWTOK = 1479 * MiB;
constexpr size_t WS_HB = 1481 * MiB;
constexpr size_t WS_YB = 476 * MiB;
constexpr size_t WS_END = 1657 * MiB;
static_assert(WS_YB + (size_t)ROWS_ALL * 1024 * 2 <= WS_YN + (size_t)T * 1536 * 2, "YB overlay must end inside PROJ..YN");
constexpr int CW_ERR = 16;
constexpr int CW_NTILES = 64, CW_BASESH = 65;
constexpr int CW_BAR = 4096;
#define XCD_BAR_WORDS 3456
static_assert((CW_BAR + XCD_BAR_WORDS) * 4 <= (int)CTL_ZERO_BYTES, "ctl");

constexpr int LDS_BYTES = 160 * 1024;
constexpr int MISC_OFF = LDS_BYTES - 256;

#define GAS __attribute__((address_space(1)))
#define LAS __attribute__((address_space(3)))
typedef unsigned short bf16;
typedef unsigned v4u __attribute__((ext_vector_type(4)));
typedef unsigned v2u __attribute__((ext_vector_type(2)));
typedef float f32x4 __attribute__((ext_vector_type(4)));
typedef float f32x2 __attribute__((ext_vector_type(2)));
typedef short bf16x8 __attribute__((ext_vector_type(8)));
typedef GAS unsigned gu32;
#define RLX_AGENT __ATOMIC_RELAXED, __HIP_MEMORY_SCOPE_AGENT
#define LDS_WAIT() asm volatile("s_waitcnt lgkmcnt(0)" ::: "memory")
#define VM_WAIT() asm volatile("s_waitcnt vmcnt(0)" ::: "memory")
__device__ __forceinline__ unsigned f2bf(float f) { unsigned u = __builtin_bit_cast(unsigned, f); return (u + 0x7fffu + ((u >> 16) & 1u)) >> 16; }
__device__ __forceinline__ unsigned pk2(float lo, float hi) { unsigned r; asm volatile("v_cvt_pk_bf16_f32 %0, %1, %2" : "=v"(r) : "v"(lo), "v"(hi)); return r; }
__device__ __forceinline__ float bflo(unsigned w) { return __uint_as_float(w << 16); }
__device__ __forceinline__ float bfhi(unsigned w) { return __uint_as_float(w & 0xffff0000u); }
__device__ __forceinline__ float bf2f(bf16 b) { return __uint_as_float(((unsigned)b) << 16); }
__device__ __forceinline__ float siluf_(float x) { return x * __builtin_amdgcn_rcpf(1.f + __expf(-x)); }
__device__ __forceinline__ float softplusf_(float x) { return x > 20.f ? x : log1pf(expf(x)); }
__device__ __forceinline__ float wave_sum(float v) {
#pragma unroll
    for (int o = 1; o < 64; o <<= 1) v += __shfl_xor(v, o);
    return v;
}

#define XB_TMO      128
#define XB_XCNT(j)  (256  + 64 * (j))
#define XB_XSUB(j)  (1280 + 64 * (j))
#define XB_XGEN(j)  (2304 + 64 * (j))
#define XB_TOP      3328
#define XB_TOPGEN   3392
#define XB_SPIN_CAP (1u << 18)
__device__ __forceinline__ unsigned xb_ld(unsigned* p)              { return __hip_atomic_load(p, __ATOMIC_RELAXED, __HIP_MEMORY_SCOPE_AGENT); }
__device__ __forceinline__ unsigned xb_add(unsigned* p, unsigned v) { return __hip_atomic_fetch_add(p, v, __ATOMIC_RELAXED, __HIP_MEMORY_SCOPE_AGENT); }
__device__ __forceinline__ unsigned xb_xcc_id() { return (unsigned)__builtin_amdgcn_s_getreg((3 << 11) | 20) & 0xFu; }
#define XB_SPIN(cond, bar) do { unsigned _sp = 0; while (cond) { __builtin_amdgcn_s_sleep(1); \
    if ((++_sp & 255u) == 0u) { if (xb_ld(&(bar)[XB_TMO])) break; if (_sp > XB_SPIN_CAP) { atomicAdd(&(bar)[XB_TMO], 1u); break; } } } } while (0)
struct XcdBarrier { unsigned* bar; unsigned x; volatile LAS unsigned* st; };
__device__ __forceinline__ XcdBarrier xcd_barrier_post(unsigned* bar, volatile LAS unsigned* st) {
    XcdBarrier b; b.bar = bar; b.x = xb_xcc_id(); b.st = st;
    if (threadIdx.x == 0) (void)xb_add(&bar[XB_XCNT(b.x)], 1u);
    return b;
}
__device__ __forceinline__ void xcd_barrier_complete(unsigned* bar, unsigned x, unsigned& nloc, unsigned& nx) {
    const unsigned G = gridDim.x * gridDim.y * gridDim.z;
    unsigned sum, cnt, mine, sp = 0u;
    for (;;) {
        sum = 0u; cnt = 0u; mine = 0u;
#pragma unroll
        for (unsigned j = 0; j < 16; ++j) { const unsigned c = xb_ld(&bar[XB_XCNT(j)]); sum += c; cnt += (c > 0u) ? 1u : 0u; mine = (j == x) ? c : mine; }
        if (sum == G) break;
        __builtin_amdgcn_s_sleep(1);
        if ((++sp & 255u) == 0u) { if (xb_ld(&bar[XB_TMO])) break; if (sp > XB_SPIN_CAP) { atomicAdd(&bar[XB_TMO], 1u); break; } }
    }
    nloc = mine > 0u ? mine : 1u; nx = cnt > 0u ? cnt : 1u;
}
__device__ __forceinline__ void xcd_barrier(const XcdBarrier& b) {
    asm volatile("s_waitcnt vmcnt(0)" ::: "memory");
    __syncthreads();
    if (threadIdx.x == 0) {
        unsigned* bar = b.bar;
        __builtin_amdgcn_s_waitcnt(0);
        unsigned nloc = b.st[0], nx = b.st[1];
        if (nloc == 0u) { xcd_barrier_complete(bar, b.x, nloc, nx); b.st[0] = nloc; b.st[1] = nx; }
        const unsigned old = xb_add(&bar[XB_XSUB(b.x)], 1u);
        const unsigned gen = old / nloc;
        if (old + 1u == (gen + 1u) * nloc) {
            __builtin_amdgcn_fence(__ATOMIC_RELEASE, "agent");
            asm volatile("s_waitcnt vmcnt(0)" ::: "memory");
            const unsigned og = xb_add(&bar[XB_TOP], 1u);
            const unsigned tg = og / nx;
            if (og + 1u == (tg + 1u) * nx) xb_add(&bar[XB_TOPGEN], 1u);
            else XB_SPIN(xb_ld(&bar[XB_TOPGEN]) == tg, bar);
            __builtin_amdgcn_fence(__ATOMIC_ACQUIRE, "agent");
            xb_add(&bar[XB_XGEN(b.x)], 1u);
            asm volatile("s_waitcnt vmcnt(0)" ::: "memory");
        } else {
            XB_SPIN(xb_ld(&bar[XB_XGEN(b.x)]) == gen, bar);
            __builtin_amdgcn_fence(__ATOMIC_ACQUIRE, "agent");
            asm volatile("s_waitcnt vmcnt(0)" ::: "memory");
        }
    }
    __syncthreads();
}

struct Frame {
    LAS unsigned char* lds;
    gu32* ctl;
    unsigned char* ws;
    int tid, lane, wave, G, bx;
    float* out;
};
#define FIN(i) (((const float* const __attribute__((address_space(4)))*)__builtin_amdgcn_kernarg_segment_ptr())[i])
#define WSP(T_, off) ((T_*)(F.ws + (off)))

__device__ __forceinline__ bf16x8 ldfrag(const LAS unsigned char* base, int pitchB, int row, int kel) { return *(const LAS bf16x8*)(base + row * pitchB + kel * 2); }
struct TrItem { const float* W; int K, Nsrc, k0, scol0, nvalid; bf16* WT; size_t drow0; const float* kscale; };
__device__ __forceinline__ void tr_load(const TrItem& t, f32x4 (&v)[16], int lane) {
    const int n4 = (lane & 15) * 4, kr = lane >> 4; const bool ok = n4 < t.nvalid;
#pragma unroll
    for (int i = 0; i < 16; ++i) { const int kk = 4 * i + kr; v[i] = ok ? __builtin_nontemporal_load((const GAS f32x4*)(t.W + (size_t)(t.k0 + kk) * t.Nsrc + t.scol0 + n4)) : (f32x4){0.f, 0.f, 0.f, 0.f}; }
}
__device__ __forceinline__ void tr_store(const TrItem& t, const f32x4 (&v)[16], LAS float* scr, int lane) {
    const int n4 = (lane & 15) * 4, kr = lane >> 4;
#pragma unroll
    for (int i = 0; i < 16; ++i) { const int kk = 4 * i + kr; f32x4 x = v[i]; if (t.kscale) x = x * t.kscale[t.k0 + kk]; LAS float* d = scr + kk * 65 + n4; d[0] = x.x; d[1] = x.y; d[2] = x.z; d[3] = x.w; }
    LDS_WAIT(); asm volatile("" ::: "memory");
    const int c = lane & 7;
#pragma unroll
    for (int j = 0; j < 8; ++j) { const int n = (lane >> 3) + 8 * j; const LAS float* s = scr + (8 * c) * 65 + n;
        v4u o; o.x = pk2(s[0 * 65], s[1 * 65]); o.y = pk2(s[2 * 65], s[3 * 65]); o.z = pk2(s[4 * 65], s[5 * 65]); o.w = pk2(s[6 * 65], s[7 * 65]);
        *(GAS v4u*)(t.WT + (t.drow0 + n) * (size_t)t.K + t.k0 + 8 * c) = o; }
    LDS_WAIT(); asm volatile("" ::: "memory");
}

__device__ __forceinline__ void phase_prologue(Frame& F) {
    const float* c_in = FIN(1); const float* w_ada = FIN(2); const float* b_ada = FIN(3);
    const float* w_in = FIN(8);
    for (int it = F.bx; it < 160; it += F.G) {
        __syncthreads();
        if (it < 96) {
            LAS float* sc = (LAS float*)(F.lds);
            LAS float* red = (LAS float*)(F.lds + 16384);
            for (int i = F.tid; i < 4096; i += NTHR) sc[i] = siluf_(c_in[i]);
            __syncthreads();
            const int col = it * 64 + F.lane; float a0 = 0.f, a1 = 0.f, a2 = 0.f, a3 = 0.f;
            const int kb = F.wave * 128;
#pragma unroll 8
            for (int k = 0; k < 128; ++k) { const float w = w_ada[(size_t)(kb + k) * 6144 + col]; a0 += sc[kb + k] * w; a1 += sc[1024 + kb + k] * w; a2 += sc[2048 + kb + k] * w; a3 += sc[3072 + kb + k] * w; }
            red[(F.wave * 4 + 0) * 64 + F.lane] = a0; red[(F.wave * 4 + 1) * 64 + F.lane] = a1; red[(F.wave * 4 + 2) * 64 + F.lane] = a2; red[(F.wave * 4 + 3) * 64 + F.lane] = a3;
            __syncthreads();
            if (F.tid < 256) { const int b = F.tid >> 6, l = F.tid & 63; float s = b_ada[it * 64 + l];
#pragma unroll
                for (int w = 0; w < 8; ++w) s += red[(w * 4 + b) * 64 + l];
                WSP(float, WS_MOD)[b * 6144 + it * 64 + l] = s; }
        } else {
            const int it2 = it - 96, kb = it2 >> 2, g = it2 & 3;
            LAS float* Wt = (LAS float*)(F.lds);
            LAS float* cs = (LAS float*)(F.lds + 64 * 129 * 4);
            LAS float* sn = cs + 128;
            for (int i = F.tid; i < 8192; i += NTHR) { const int kk = i >> 7, c = i & 127; Wt[kk * 129 + c] = w_in[(size_t)(kb * 64 + kk) * INW + SRC_F + g * 128 + c]; }
            if (F.tid < 128) { float s_, c_; sincospif((float)F.tid / 64.f, &s_, &c_); cs[F.tid] = c_; sn[F.tid] = s_; }
            __syncthreads();
            const int kk = F.lane; bf16* WINT = WSP(bf16, WS_WINT);
            for (int q = 0; q < 16; ++q) { const int j = F.wave + 8 * q; float ar = 0.f, ai = 0.f;
#pragma unroll 8
                for (int c = 0; c < 128; ++c) { const float w = Wt[kk * 129 + c]; const int id = (c * j) & 127; ar += w * cs[id]; ai -= w * sn[id]; }
                const float sc_ = 0.08838834764831845f;
                WINT[(size_t)(PC_FR + g * 128 + j) * 1024 + kb * 64 + kk] = (bf16)f2bf(ar * sc_);
                WINT[(size_t)(PC_FI + g * 128 + j) * 1024 + kb * 64 + kk] = (bf16)f2bf(ai * sc_); }
        }
    }
    __syncthreads();
    const int gt = F.bx * NTHR + F.tid, NGT = F.G * NTHR;
    for (int i = gt; i < 8192; i += NGT) { float s_, c_; sincospif((float)i / 4096.f, &s_, &c_); WSP(f32x2, WS_TW)[i] = (f32x2){c_, s_}; }
    for (int i = gt; i < 128 * 128; i += NGT) { const int m = i >> 7, k = i & 127; const int k1 = m & 63, s1 = k & 63; float s_, c_; sincospif((float)((k1 * s1) & 63) / 32.f, &s_, &c_);
        float v; if (m < 64) v = (k < 64) ? c_ : s_; else v = (k < 64) ? -s_ : c_;
        WSP(bf16, WS_WM1)[i] = (bf16)f2bf(v * 0.125f); }
    for (int i = gt; i < 128 * 256; i += NGT) { const int k2 = i >> 8, k = i & 255; const int s2 = k & 127; float s_, c_; sincospif((float)((k2 * s2) & 127) / 64.f, &s_, &c_);
        WSP(bf16, WS_WM2)[i] = (bf16)f2bf(((k < 128) ? c_ : s_) * 0.08838834764831845f); }
    LAS float* scr = (LAS float*)(F.lds + F.wave * 16896);
    const int gw = F.bx * NWAVES + F.wave, NGW = F.G * NWAVES;
    constexpr int I_IN = 100 * 16, I_BS = 24 * 16, I_BF = 8 * 16, I_OUT = 16 * 16, I_R = 16 * 4, I_13 = NEX * 128, I_2 = NEX * 64;
    constexpr int NITEMS = I_IN + I_BS + I_BF + I_OUT + I_R + I_13 + I_2;
    auto decode = [&](int it) -> TrItem {
        int r = it;
        if (r < I_IN) { const int kb = r / 100, db = r % 100; const int d0 = (db < 64) ? db * 64 : 5120 + (db - 64) * 64; int src, nv = 64;
            if (d0 < 4096) src = d0; else if (d0 < 7168) src = SRC_G + (d0 - 5120); else { src = SRC_DT + (d0 - 7168); nv = 48 - (d0 - 7168); nv = nv < 0 ? 0 : (nv > 64 ? 64 : nv); }
            return TrItem{w_in, 1024, INW, kb * 64, src, nv, WSP(bf16, WS_WINT), (size_t)d0, nullptr}; } r -= I_IN;
        if (r < I_BS) { const int kb = r / 16, nb = r % 16; return TrItem{FIN(17), 1536, 1024, kb * 64, nb * 64, 64, WSP(bf16, WS_WBST), (size_t)nb * 64, FIN(16)}; } r -= I_BS;
        if (r < I_BF) { const int kb = r / 16, nb = r % 16; return TrItem{FIN(18), 512, 1024, kb * 64, nb * 64, 64, WSP(bf16, WS_WBFT), (size_t)nb * 64, nullptr}; } r -= I_BF;
        if (r < I_OUT) { const int kb = r / 16, nb = r % 16; return TrItem{FIN(19), 1024, 1024, kb * 64, nb * 64, 64, WSP(bf16, WS_WOUTT), (size_t)nb * 64, nullptr}; } r -= I_OUT;
        if (r < I_R) { const int kb = r / 4, nb = r % 4; return TrItem{FIN(20), 1024, 256, kb * 64, nb * 64, 64, WSP(bf16, WS_WRT), (size_t)nb * 64, nullptr}; } r -= I_R;
        if (r < I_13) { const int e = r >> 7, q = r & 127, kb = q >> 3, db = q & 7; const int rho0 = db * 64, pn = rho0 >> 8, bj = (rho0 >> 7) & 1, jj = rho0 & 127;
            const float* src = (e < NE) ? FIN(22) + (size_t)e * 1024 * 512 : FIN(24);
            return TrItem{src, 1024, 512, kb * 64, bj * 256 + pn * 128 + jj, 64, WSP(bf16, WS_W13T), (size_t)e * 512 + rho0, nullptr}; } r -= I_13;
        { const int e = r >> 6, q = r & 63, kb = q >> 4, nb = q & 15;
            const float* src = (e < NE) ? FIN(23) + (size_t)e * 256 * 1024 : FIN(25);
            return TrItem{src, 256, 1024, kb * 64, nb * 64, 64, WSP(bf16, WS_W2T), (size_t)e * 1024 + nb * 64, nullptr}; }
    };
    if (gw < NITEMS) {
        f32x4 va[16], vb[16]; TrItem ta = decode(gw), tb = ta; tr_load(ta, va, F.lane);
        for (int it = gw; it < NITEMS; it += 2 * NGW) {
            const bool hb = it + NGW < NITEMS; if (hb) { tb = decode(it + NGW); tr_load(tb, vb, F.lane); }
            tr_store(ta, va, scr, F.lane);
            const bool ha = it + 2 * NGW < NITEMS; if (ha) { ta = decode(it + 2 * NGW); tr_load(ta, va, F.lane); }
            if (hb) tr_store(tb, vb, scr, F.lane);
        }
    }
}

__device__ __forceinline__ void phase_norm1(Frame& F) {
    LAS float* GS = (LAS float*)(F.lds); LAS float* SH = GS + 4096;
    const float* mod = WSP(float, WS_MOD); const float* g = FIN(4);
    for (int i = F.tid; i < 4096; i += NTHR) { const int b = i >> 10, col = i & 1023; GS[i] = g[col] * (1.f + mod[b * 6144 + 1024 + col]); SH[i] = mod[b * 6144 + col]; }
    __syncthreads();
    const int gw = F.bx * NWAVES + F.wave, NGW = F.G * NWAVES; const float* x = FIN(0); bf16* H = WSP(bf16, WS_H);
    f32x4 nx[4];
    if (gw < T) { const GAS f32x4* xr = (const GAS f32x4*)(x + (size_t)gw * D) + F.lane;
#pragma unroll
        for (int j = 0; j < 4; ++j) nx[j] = xr[64 * j]; }
    for (int m = gw; m < T; m += NGW) { const int b = m / SEQ;
        f32x4 v[4]; float ss = 0.f;
#pragma unroll
        for (int j = 0; j < 4; ++j) v[j] = nx[j];
        if (m + NGW < T) { const GAS f32x4* xr = (const GAS f32x4*)(x + (size_t)(m + NGW) * D) + F.lane;
#pragma unroll
            for (int j = 0; j < 4; ++j) nx[j] = xr[64 * j]; }
#pragma unroll
        for (int j = 0; j < 4; ++j) ss += (v[j].x * v[j].x + v[j].y * v[j].y) + (v[j].z * v[j].z + v[j].w * v[j].w);
        const float rstd = 1.f / sqrtf(wave_sum(ss) * (1.f / D) + RMS_EPS);
        GAS unsigned long long* o8 = (GAS unsigned long long*)(H + (size_t)m * D) + F.lane;
#pragma unroll
        for (int j = 0; j < 4; ++j) { const int col = 4 * F.lane + 256 * j; const LAS float* gs = GS + b * 1024 + col; const LAS float* sh = SH + b * 1024 + col;
            o8[64 * j] = (unsigned long long)pk2(v[j].x * rstd * gs[0] + sh[0], v[j].y * rstd * gs[1] + sh[1]) | ((unsigned long long)pk2(v[j].z * rstd * gs[2] + sh[2], v[j].w * rstd * gs[3] + sh[3]) << 32); }
    }
}

#define MFMA_BEGIN() do { asm volatile("s_waitcnt lgkmcnt(0)" ::: "memory"); __builtin_amdgcn_sched_barrier(0); } while (0)
#define MFMA_END() do { __builtin_amdgcn_sched_barrier(0); asm volatile("s_nop 15\n\ts_nop 15\n\ts_nop 15\n\ts_nop 15" ::: "memory"); __builtin_amdgcn_sched_barrier(0); } while (0)
#define MFMA_END2() do { __builtin_amdgcn_sched_barrier(0); asm volatile("s_nop 15\n\ts_nop 15" ::: "memory"); __builtin_amdgcn_sched_barrier(0); } while (0)
#define LDS_BARRIER() do { asm volatile("s_waitcnt lgkmcnt(0)" ::: "memory"); __builtin_amdgcn_s_barrier(); asm volatile("" ::: "memory"); } while (0)
constexpr int PT = 272;
__device__ __forceinline__ void wave_scan128(float a0, float a1, int lane, float& i0, float& i1, float& tot) {
    float p = a0 + a1;
#pragma unroll
    for (int o = 1; o < 64; o <<= 1) { const float t = __shfl_up(p, o); if (lane >= o) p += t; }
    i1 = p; i0 = p - a1; tot = __shfl(p, 63);
}
__device__ __forceinline__ void raw_load(unsigned (&r)[12], const bf16* P, int b, int c, int col, int tid) {
    const int pp = tid & 31, sr = tid >> 5;
#pragma unroll
    for (int i = 0; i < 12; ++i) { const int s = c * CHUNK + 8 * sr - 2 + i; r[i] = (s >= 0 && s < SEQ) ? *(const GAS unsigned*)(P + (size_t)(b * SEQ + s) * PW + col + 2 * pp) : 0u; }
}
__device__ __forceinline__ void conv8(const unsigned (&r)[12], const LAS float* cw, int nch, int chl, float (&o0)[8], float (&o1)[8]) {
    float w0[5], w1[5];
#pragma unroll
    for (int i = 0; i < 5; ++i) { const f32x2 w = *(const LAS f32x2*)(cw + i * nch + chl); w0[i] = w.x; w1[i] = w.y; }
    const f32x2 bb = *(const LAS f32x2*)(cw + 5 * nch + chl);
#pragma unroll
    for (int j = 0; j < 8; ++j) { float a = bb.x, d = bb.y;
#pragma unroll
        for (int i = 0; i < 5; ++i) { a += w0[i] * bflo(r[j + i]); d += w1[i] * bfhi(r[j + i]); }
        o0[j] = siluf_(a); o1[j] = siluf_(d); }
}
__device__ __forceinline__ void store_T(LAS unsigned char* dst, int ch, int s0, const float (&o0)[8], const float (&o1)[8], const LAS float* sc) {
    float k[8];
    if (sc) { const f32x4 a = *(const LAS f32x4*)(sc + s0), d = *(const LAS f32x4*)(sc + s0 + 4); k[0] = a.x; k[1] = a.y; k[2] = a.z; k[3] = a.w; k[4] = d.x; k[5] = d.y; k[6] = d.z; k[7] = d.w; }
    else {
#pragma unroll
        for (int j = 0; j < 8; ++j) k[j] = 1.f; }
    v4u w0, w1;
    w0.x = pk2(o0[0] * k[0], o0[1] * k[1]); w0.y = pk2(o0[2] * k[2], o0[3] * k[3]); w0.z = pk2(o0[4] * k[4], o0[5] * k[5]); w0.w = pk2(o0[6] * k[6], o0[7] * k[7]);
    w1.x = pk2(o1[0] * k[0], o1[1] * k[1]); w1.y = pk2(o1[2] * k[2], o1[3] * k[3]); w1.z = pk2(o1[4] * k[4], o1[5] * k[5]); w1.w = pk2(o1[6] * k[6], o1[7] * k[7]);
    *(LAS v4u*)(dst + ch * PT + s0 * 2) = w0; *(LAS v4u*)(dst + (ch + 1) * PT + s0 * 2) = w1;
}
__device__ __forceinline__ void head_vec(Frame& F, int b, int c, int h, int d, float& dt0, float& dt1, float& ac0, float& ac1, float& ex0, float& ex1, float& tot) {
    const float* DTR = WSP(float, WS_DT); const float bias = d ? FIN(12)[h] : FIN(11)[h]; const float A = -expf(d ? FIN(14)[h] : FIN(13)[h]);
    const size_t row = (size_t)(b * SEQ + c * CHUNK + 2 * F.lane);
    dt0 = softplusf_(DTR[row * 64 + d * 24 + h] + bias); dt1 = softplusf_(DTR[(row + 1) * 64 + d * 24 + h] + bias);
    const float a0 = A * dt0, a1 = A * dt1; float i0, i1;
    wave_scan128(a0, a1, F.lane, i0, i1, tot);
    ex0 = i0 - a0; ex1 = i1 - a1;
    if (d == 0) { ac0 = i0; ac1 = i1; } else { ac0 = tot - ex0; ac1 = tot - ex1; }
}

__device__ __forceinline__ void phase_states(Frame& F) {
    LAS unsigned char* BT = F.lds;
    LAS unsigned char* XTB = F.lds + 34816;
    LAS float* CWA = (LAS float*)(F.lds + 104448);
    LAS float* WSF = (LAS float*)(F.lds + 116736);
    LAS float* WSB = WSF + 768;
    const bf16* P = WSP(bf16, WS_PROJ); unsigned char* STL = WSP(unsigned char, WS_STL); float* CD = WSP(float, WS_CD);
    const int fr = F.lane & 15, fq = F.lane >> 4, pp = F.tid & 31, sr = F.tid >> 5;
    int gtab = -1;
    for (int u = F.bx; u < NB * NCHUNK * NG; u += F.G) {
        const int g = u & 3, c = (u >> 2) & 63, b = u >> 8;
        LDS_BARRIER();
        if (g != gtab) { gtab = g;
            for (int i = F.tid; i < 6 * 512; i += NTHR) { const int t = i >> 9, ch = i & 511; const int xc = ch < 384 ? g * 384 + ch : 1536 + g * 128 + (ch - 384);
                CWA[i] = t < 5 ? FIN(9)[t * 2560 + xc] : FIN(10)[xc]; } }
        if (F.wave < HPG) { const int h = g * HPG + F.wave;
#pragma unroll
            for (int d = 0; d < 2; ++d) { float dt0, dt1, ac0, ac1, ex0, ex1, tot; head_vec(F, b, c, h, d, dt0, dt1, ac0, ac1, ex0, ex1, tot);
                LAS float* W = (d ? WSB : WSF) + F.wave * 128 + 2 * F.lane;
                if (d == 0) { W[0] = dt0 * __expf(tot - ac0); W[1] = dt1 * __expf(tot - ac1); } else { W[0] = dt0 * __expf(ex0); W[1] = dt1 * __expf(ex1); }
                if (F.lane == 0) CD[((size_t)(b * NCHUNK + c) * HEADS + h) * 2 + d] = __expf(tot); } }
        unsigned rc[12], rn[12];
        raw_load(rc, P, b, c, PC_B + g * 128, F.tid);
        LDS_BARRIER();
#pragma unroll 1
        for (int pc = 0; pc < 8; ++pc) {
            if (pc < 7) { const int col = (pc + 1 < 2) ? PC_B + g * 128 + 64 : PC_X + (g * HPG + (pc + 1 - 2)) * 64; raw_load(rn, P, b, c, col, F.tid); }
            float o0[8], o1[8];
            if (pc < 2) { conv8(rc, CWA, 512, 384 + pc * 64 + 2 * pp, o0, o1); store_T(BT + pc * 64 * PT, 2 * pp, 8 * sr, o0, o1, nullptr);
                bf16* bg = WSP(bf16, WS_BG) + ((size_t)((b * NCHUNK + c) * NG + g) * 128 + 8 * sr) * 128 + pc * 64 + 2 * pp;
#pragma unroll
                for (int j = 0; j < 8; ++j) *(GAS unsigned*)(bg + j * 128) = pk2(o0[j], o1[j]); }
            else { const int hh = pc - 2; conv8(rc, CWA, 512, hh * 64 + 2 * pp, o0, o1);
                LAS unsigned char* xf = XTB + ((hh & 1) * 2) * 17408; store_T(xf, 2 * pp, 8 * sr, o0, o1, WSF + hh * 128); store_T(xf + 17408, 2 * pp, 8 * sr, o0, o1, WSB + hh * 128);
                bf16* xg = WSP(bf16, WS_XTG) + ((size_t)((b * NCHUNK + c) * HEADS + g * HPG + hh) * 64 + 2 * pp) * 128 + 8 * sr;
                v4u w0, w1; w0.x = pk2(o0[0], o0[1]); w0.y = pk2(o0[2], o0[3]); w0.z = pk2(o0[4], o0[5]); w0.w = pk2(o0[6], o0[7]); w1.x = pk2(o1[0], o1[1]); w1.y = pk2(o1[2], o1[3]); w1.z = pk2(o1[4], o1[5]); w1.w = pk2(o1[6], o1[7]);
                *(GAS v4u*)xg = w0; *(GAS v4u*)(xg + 128) = w1; }
            LDS_BARRIER();
            if (pc >= 2) { const int hh = pc - 2, h = g * HPG + hh; const LAS unsigned char* xf = XTB + ((hh & 1) * 2) * 17408;
                const int ptile = F.wave & 3, nt0 = 4 * (F.wave >> 2);
                f32x4 af[4], ab[4];
#pragma unroll
                for (int j = 0; j < 4; ++j) { af[j] = (f32x4){0.f, 0.f, 0.f, 0.f}; ab[j] = (f32x4){0.f, 0.f, 0.f, 0.f}; }
#pragma unroll
                for (int half = 0; half < 2; ++half) { bf16x8 qf[2], qb[2], pf[2][4];
#pragma unroll
                    for (int k2 = 0; k2 < 2; ++k2) { const int kk = 2 * half + k2; qf[k2] = ldfrag(xf, PT, 16 * ptile + fr, 32 * kk + 8 * fq); qb[k2] = ldfrag(xf + 17408, PT, 16 * ptile + fr, 32 * kk + 8 * fq);
#pragma unroll
                        for (int j = 0; j < 4; ++j) pf[k2][j] = ldfrag(BT, PT, 16 * (nt0 + j) + fr, 32 * kk + 8 * fq); }
                    MFMA_BEGIN();
#pragma unroll
                    for (int k2 = 0; k2 < 2; ++k2)
#pragma unroll
                        for (int j = 0; j < 4; ++j) { af[j] = __builtin_amdgcn_mfma_f32_16x16x32_bf16(pf[k2][j], qf[k2], af[j], 0, 0, 0); ab[j] = __builtin_amdgcn_mfma_f32_16x16x32_bf16(pf[k2][j], qb[k2], ab[j], 0, 0, 0); }
                    MFMA_END(); }
                unsigned char* so = STL + ((size_t)((b * NCHUNK + c) * HEADS + h) * 2) * 8192 + (16 * ptile + fr) * 128;
                const float sf = STL_SCALE / softplusf_(FIN(11)[h]), sb = STL_SCALE / softplusf_(FIN(12)[h]);
#pragma unroll
                for (int j = 0; j < 4; ++j) { const f32x4 vf = af[j] * sf, vb = ab[j] * sb;
                    int w = __builtin_amdgcn_cvt_pk_fp8_f32(fminf(fmaxf(vf[0], -440.f), 440.f), fminf(fmaxf(vf[1], -440.f), 440.f), 0, false); w = __builtin_amdgcn_cvt_pk_fp8_f32(fminf(fmaxf(vf[2], -440.f), 440.f), fminf(fmaxf(vf[3], -440.f), 440.f), w, true);
                    *(GAS int*)(so + 16 * (nt0 + j) + 4 * fq) = w;
                    w = __builtin_amdgcn_cvt_pk_fp8_f32(fminf(fmaxf(vb[0], -440.f), 440.f), fminf(fmaxf(vb[1], -440.f), 440.f), 0, false); w = __builtin_amdgcn_cvt_pk_fp8_f32(fminf(fmaxf(vb[2], -440.f), 440.f), fminf(fmaxf(vb[3], -440.f), 440.f), w, true);
                    *(GAS int*)(so + 8192 + 16 * (nt0 + j) + 4 * fq) = w; }
            }
#pragma unroll
            for (int i = 0; i < 12; ++i) rc[i] = rn[i];
        }
    }
}

__device__ __forceinline__ void phase_scan(Frame& F) {
    unsigned char* ST = WSP(unsigned char, WS_ST); const unsigned char* STL = WSP(unsigned char, WS_STL); const float* CD = WSP(float, WS_CD);
    const int gt = F.bx * NTHR + F.tid, NGT = F.G * NTHR;
    for (int e = gt; e < NB * HEADS * 2 * 512; e += NGT) {
        const int q16 = e & 511, d = (e >> 9) & 1, bh = e >> 10, h = bh % HEADS, b = bh / HEADS;
        const float inv = STP_SCALE / STL_SCALE;
        float prev[16];
#pragma unroll
        for (int j = 0; j < 16; ++j) prev[j] = 0.f;
        for (int c0 = 0; c0 < NCHUNK; c0 += 4) {
            v4u st[4]; float dec[4];
#pragma unroll
            for (int i = 0; i < 4; ++i) { const int c = d ? (NCHUNK - 1 - (c0 + i)) : (c0 + i); const size_t si = ((size_t)((b * NCHUNK + c) * HEADS + h) * 2 + d);
                st[i] = *(const GAS v4u*)(STL + si * 8192 + q16 * 16); dec[i] = CD[si]; }
#pragma unroll
            for (int i = 0; i < 4; ++i) { const int c = d ? (NCHUNK - 1 - (c0 + i)) : (c0 + i); const size_t si = ((size_t)((b * NCHUNK + c) * HEADS + h) * 2 + d);
                const int wv[4] = { (int)st[i].x, (int)st[i].y, (int)st[i].z, (int)st[i].w }; v4u o;
                unsigned ow[4];
#pragma unroll
                for (int q = 0; q < 4; ++q) { int w = __builtin_amdgcn_cvt_pk_fp8_f32(fminf(fmaxf(prev[4 * q], -440.f), 440.f), fminf(fmaxf(prev[4 * q + 1], -440.f), 440.f), 0, false);
                    w = __builtin_amdgcn_cvt_pk_fp8_f32(fminf(fmaxf(prev[4 * q + 2], -440.f), 440.f), fminf(fmaxf(prev[4 * q + 3], -440.f), 440.f), w, true); ow[q] = (unsigned)w;
                    prev[4 * q] = prev[4 * q] * dec[i] + inv * __builtin_amdgcn_cvt_f32_fp8(wv[q], 0); prev[4 * q + 1] = prev[4 * q + 1] * dec[i] + inv * __builtin_amdgcn_cvt_f32_fp8(wv[q], 1);
                    prev[4 * q + 2] = prev[4 * q + 2] * dec[i] + inv * __builtin_amdgcn_cvt_f32_fp8(wv[q], 2); prev[4 * q + 3] = prev[4 * q + 3] * dec[i] + inv * __builtin_amdgcn_cvt_f32_fp8(wv[q], 3); }
                o.x = ow[0]; o.y = ow[1]; o.z = ow[2]; o.w = ow[3]; *(GAS v4u*)(ST + si * 8192 + q16 * 16) = o; }
        }
    }
}

__device__ __forceinline__ void phase_ssd_out(Frame& F) {
    LAS unsigned char* CS = F.lds;
    LAS unsigned char* BS = F.lds + 34816;
    LAS unsigned char* XT = F.lds + 69632;
    LAS unsigned char* PVB = F.lds + 87040;
    LAS float* CWX = (LAS float*)(F.lds + 121856);
    LAS float* DTF = (LAS float*)(F.lds + 131072);
    LAS float* DTB = DTF + 768; LAS float* ACF = DTB + 768; LAS float* ACB = ACF + 768; LAS float* CFF = ACB + 768; LAS float* CFB = CFF + 768;
    LAS float* CWBC = (LAS float*)PVB;
    const unsigned char* ST = WSP(unsigned char, WS_ST); const bf16* P = WSP(bf16, WS_PROJ); bf16* YN = WSP(bf16, WS_YN);
    const int fr = F.lane & 15, fq = F.lane >> 4, w = F.wave, pp = F.tid & 31, sr = F.tid >> 5;
    LAS unsigned char* LB = BS + w * 16 * PT;
    LAS unsigned char* XB = F.lds + 149504 + w * 1280;
    int gtab = -1;
    for (int u = F.bx; u < NB * NCHUNK * NG; u += F.G) {
        const int g = u & 3, c = (u >> 2) & 63, b = u >> 8;
        unsigned rbc[2][12];
#pragma unroll
        for (int pc = 0; pc < 2; ++pc) raw_load(rbc[pc], P, b, c, PC_C + g * 128 + pc * 64, F.tid);
        v4u bgl[4];
        { const bf16* bg = WSP(bf16, WS_BG) + (size_t)((b * NCHUNK + c) * NG + g) * 16384;
#pragma unroll
          for (int q = 0; q < 4; ++q) bgl[q] = *(const GAS v4u*)(bg + (size_t)(F.tid + 512 * q) * 8); }
        LDS_BARRIER();
        for (int i = F.tid; i < 6 * 128; i += NTHR) { const int t = i >> 7, ch = i & 127; const int xc = 2048 + g * 128 + ch; CWBC[i] = t < 5 ? FIN(9)[t * 2560 + xc] : FIN(10)[xc]; }
        if (w < HPG) { const int h = g * HPG + w;
#pragma unroll
            for (int d = 0; d < 2; ++d) { float dt0, dt1, ac0, ac1, ex0, ex1, tot; head_vec(F, b, c, h, d, dt0, dt1, ac0, ac1, ex0, ex1, tot);
                const float ref = d ? __shfl(ac0, F.lane & ~7) : __shfl(ac1, (F.lane & ~7) + 7);
                LAS float* D_ = (d ? DTB : DTF) + w * 128 + 2 * F.lane; LAS float* A_ = (d ? ACB : ACF) + w * 128 + 2 * F.lane; LAS float* C_ = (d ? CFB : CFF) + w * 128 + 2 * F.lane;
                D_[0] = dt0; D_[1] = dt1; A_[0] = ac0; A_[1] = ac1; C_[0] = dt0 * __expf(ref - ac0); C_[1] = dt1 * __expf(ref - ac1); } }
        LDS_BARRIER();
        {
#pragma unroll
            for (int pc = 0; pc < 2; ++pc) {
                float o0[8], o1[8]; conv8(rbc[pc], CWBC, 128, pc * 64 + 2 * pp, o0, o1);
                LAS unsigned char* dst = CS + (pc * 64 + 2 * pp) * 2;
#pragma unroll
                for (int j = 0; j < 8; ++j) *(LAS unsigned*)(dst + (8 * sr + j) * PT) = pk2(o0[j], o1[j]); }
#pragma unroll
            for (int q = 0; q < 4; ++q) { const int ci = F.tid + 512 * q; *(LAS v4u*)(BS + (ci >> 4) * PT + (ci & 15) * 16) = bgl[q]; } }
        v4u xg0, xg1;
        { const bf16* xg = WSP(bf16, WS_XTG) + (size_t)((b * NCHUNK + c) * HEADS + g * HPG) * 8192; xg0 = *(const GAS v4u*)(xg + (size_t)F.tid * 8); xg1 = *(const GAS v4u*)(xg + 4096 + (size_t)F.tid * 8); }
        LDS_BARRIER();
        f32x4 cb[8];
#pragma unroll
        for (int t = 0; t < 8; ++t) cb[t] = (f32x4){0.f, 0.f, 0.f, 0.f};
#pragma unroll
        for (int kk = 0; kk < 4; ++kk) { const bf16x8 q = ldfrag(CS, PT, 16 * w + fr, 32 * kk + 8 * fq); bf16x8 pf[8];
#pragma unroll
            for (int t = 0; t < 8; ++t) pf[t] = ldfrag(BS, PT, 16 * t + fr, 32 * kk + 8 * fq);
            MFMA_BEGIN();
#pragma unroll
            for (int t = 0; t < 8; ++t) cb[t] = __builtin_amdgcn_mfma_f32_16x16x32_bf16(pf[t], q, cb[t], 0, 0, 0);
            MFMA_END(); }
        LDS_BARRIER();
        const int l = 16 * w + fr;
        float ssq = 0.f;
        v4u pv0, pv1; { const unsigned char* src = ST + ((size_t)((b * NCHUNK + c) * HEADS + g * HPG) * 2) * 8192 + F.tid * 16; pv0 = *(const GAS v4u*)src; pv1 = *(const GAS v4u*)(src + 8192); }
#pragma unroll 1
        for (int hh = 0; hh < HPG; ++hh) { const int h = g * HPG + hh;
            { const int r0 = F.tid >> 4, part = F.tid & 15; *(LAS v4u*)(XT + r0 * PT + part * 16) = xg0; *(LAS v4u*)(XT + (r0 + 32) * PT + part * 16) = xg1; }
            if (hh + 1 < HPG) { const bf16* xg = WSP(bf16, WS_XTG) + (size_t)((b * NCHUNK + c) * HEADS + h + 1) * 8192; xg0 = *(const GAS v4u*)(xg + (size_t)F.tid * 8); xg1 = *(const GAS v4u*)(xg + 4096 + (size_t)F.tid * 8); }
            f32x4 Y[4];
#pragma unroll
            for (int pt = 0; pt < 4; ++pt) Y[pt] = (f32x4){0.f, 0.f, 0.f, 0.f};
            const float dsk = FIN(15)[h];
            v2u zw[4]; { const bf16* zrow = P + (size_t)(b * SEQ + c * CHUNK + l) * PW + PC_Z + h * 64;
#pragma unroll
                for (int pt = 0; pt < 4; ++pt) zw[pt] = *(const GAS v2u*)(zrow + 16 * pt + 4 * fq); }
            {
                const int kd = w >> 1;
#pragma unroll
                for (int d = 0; d < 2; ++d) {
                    const LAS float* AC = (d ? ACB : ACF) + hh * 128; const LAS float* DT_ = (d ? DTB : DTF) + hh * 128; const LAS float* CF = (d ? CFB : CFF) + hh * 128;
                    const float al = AC[l];
#pragma unroll
                    for (int t = 0; t < 8; ++t) {
                        if (d ? ((t >> 1) < kd) : ((t >> 1) > kd)) continue;
                        float o[4];
                        if (t == w) { const f32x4 as = *(const LAS f32x4*)(AC + 16 * t + 4 * fq), ds = *(const LAS f32x4*)(DT_ + 16 * t + 4 * fq);
#pragma unroll
                            for (int r = 0; r < 4; ++r) { const int s = 16 * t + 4 * fq + r; const bool keep = d ? (s >= l) : (s <= l);
                                float v = cb[t][r] * __expf(al - as[r]) * ds[r]; v = keep ? v : 0.f; if (d == 0 && s == l) v += dsk; o[r] = v; } }
                        else if (d ? (t > w) : (t < w)) { const float rr = __expf(al - AC[d ? 16 * t : 16 * t + 15]); const f32x4 cf = *(const LAS f32x4*)(CF + 16 * t + 4 * fq);
#pragma unroll
                            for (int r = 0; r < 4; ++r) o[r] = cb[t][r] * rr * cf[r]; }
                        else { o[0] = 0.f; o[1] = 0.f; o[2] = 0.f; o[3] = 0.f; }
                        v2u pw; pw.x = pk2(o[0], o[1]); pw.y = pk2(o[2], o[3]);
                        if (d && (t >> 1) == kd) *(LAS v2u*)(XB + fr * 80 + ((t & 1) * 16 + 4 * fq) * 2) = pw;
                        else *(LAS v2u*)(LB + fr * PT + (16 * t + 4 * fq) * 2) = pw; }
                    { LAS unsigned char* PV = PVB + d * 17408; const v4u pvx = d ? pv1 : pv0;
                      const int r0 = F.tid >> 3, part = F.tid & 7; const float ps = softplusf_(d ? FIN(12)[h] : FIN(11)[h]) * (1.f / STP_SCALE);
                      const int wv[4] = { (int)pvx.x, (int)pvx.y, (int)pvx.z, (int)pvx.w }; unsigned o[8];
#pragma unroll
                      for (int q = 0; q < 4; ++q) { o[2 * q] = pk2(ps * __builtin_amdgcn_cvt_f32_fp8(wv[q], 0), ps * __builtin_amdgcn_cvt_f32_fp8(wv[q], 1)); o[2 * q + 1] = pk2(ps * __builtin_amdgcn_cvt_f32_fp8(wv[q], 2), ps * __builtin_amdgcn_cvt_f32_fp8(wv[q], 3)); }
                      *(LAS v4u*)(PV + r0 * PT + part * 32) = (v4u){o[0], o[1], o[2], o[3]}; *(LAS v4u*)(PV + r0 * PT + part * 32 + 16) = (v4u){o[4], o[5], o[6], o[7]}; }
                }
                if (hh + 1 < HPG) { const unsigned char* src = ST + ((size_t)((b * NCHUNK + c) * HEADS + h + 1) * 2) * 8192 + F.tid * 16; pv0 = *(const GAS v4u*)src; pv1 = *(const GAS v4u*)(src + 8192); }
                LDS_BARRIER();
                f32x4 Zf[4], Zb[4];
#pragma unroll
                for (int pt = 0; pt < 4; ++pt) { Zf[pt] = (f32x4){0.f, 0.f, 0.f, 0.f}; Zb[pt] = (f32x4){0.f, 0.f, 0.f, 0.f}; }
#pragma unroll
                for (int kk = 0; kk < 4; ++kk) { const bool yf = kk <= kd, yb = kk >= kd;
                    bf16x8 xp[4], lf, lb2;
#pragma unroll
                    for (int pt = 0; pt < 4; ++pt) xp[pt] = ldfrag(XT, PT, 16 * pt + fr, 32 * kk + 8 * fq);
                    lf = ldfrag(LB, PT, fr, 32 * kk + 8 * fq);
                    lb2 = (kk == kd) ? *(const LAS bf16x8*)(XB + fr * 80 + 16 * fq) : lf;
                    MFMA_BEGIN();
                    if (yf || kk > kd) {
#pragma unroll
                        for (int pt = 0; pt < 4; ++pt) Y[pt] = __builtin_amdgcn_mfma_f32_16x16x32_bf16(xp[pt], lf, Y[pt], 0, 0, 0); }
                    if (yb && kk == kd) {
#pragma unroll
                        for (int pt = 0; pt < 4; ++pt) Y[pt] = __builtin_amdgcn_mfma_f32_16x16x32_bf16(xp[pt], lb2, Y[pt], 0, 0, 0); }
                    MFMA_END2(); }
#pragma unroll
                for (int kk = 0; kk < 4; ++kk) { const bf16x8 cq = ldfrag(CS, PT, 16 * w + fr, 32 * kk + 8 * fq); bf16x8 pf_[4], pb_[4];
#pragma unroll
                    for (int pt = 0; pt < 4; ++pt) { pf_[pt] = ldfrag(PVB, PT, 16 * pt + fr, 32 * kk + 8 * fq); pb_[pt] = ldfrag(PVB + 17408, PT, 16 * pt + fr, 32 * kk + 8 * fq); }
                    MFMA_BEGIN();
#pragma unroll
                    for (int pt = 0; pt < 4; ++pt) { Zf[pt] = __builtin_amdgcn_mfma_f32_16x16x32_bf16(pf_[pt], cq, Zf[pt], 0, 0, 0); Zb[pt] = __builtin_amdgcn_mfma_f32_16x16x32_bf16(pb_[pt], cq, Zb[pt], 0, 0, 0); }
                    MFMA_END(); }
                const float elf = __expf(ACF[hh * 128 + l]), elb = __expf(ACB[hh * 128 + l]);
#pragma unroll
                for (int pt = 0; pt < 4; ++pt) Y[pt] = Y[pt] + Zf[pt] * elf + Zb[pt] * elb;
            }
            bf16* yrow0 = YN + (size_t)(b * SEQ + c * CHUNK + l) * INNER + g * 384 + hh * 64;
#pragma unroll
            for (int pt = 0; pt < 4; ++pt) {
                const float v0 = Y[pt][0] * siluf_(bflo(zw[pt].x)), v1 = Y[pt][1] * siluf_(bfhi(zw[pt].x)), v2 = Y[pt][2] * siluf_(bflo(zw[pt].y)), v3 = Y[pt][3] * siluf_(bfhi(zw[pt].y));
                ssq += (v0 * v0 + v1 * v1) + (v2 * v2 + v3 * v3); v2u o; o.x = pk2(v0, v1); o.y = pk2(v2, v3); *(GAS v2u*)(yrow0 + 16 * pt + 4 * fq) = o; }
            LDS_BARRIER();
        }
        ssq += __shfl_xor(ssq, 16); ssq += __shfl_xor(ssq, 32);
        const float rstd = 1.f / sqrtf(ssq * (1.f / 384.f) + RMS_EPS);
        VM_WAIT();
        bf16* yrow = YN + (size_t)(b * SEQ + c * CHUNK + l) * INNER + g * 384;
        for (int hh = 0; hh < HPG; ++hh)
#pragma unroll
            for (int pt = 0; pt < 4; ++pt) { const v2u vv = *(const GAS v2u*)(yrow + hh * 64 + 16 * pt + 4 * fq); v2u o; o.x = pk2(bflo(vv.x) * rstd, bfhi(vv.x) * rstd); o.y = pk2(bflo(vv.y) * rstd, bfhi(vv.y) * rstd);
                *(GAS v2u*)(yrow + hh * 64 + 16 * pt + 4 * fq) = o; }
    }
}

__device__ __forceinline__ void zt_put(LAS unsigned char* ZT, int pb, int ch0, int kidx, v4u v, bool odd) {
    const unsigned w[4] = { v.x, v.y, v.z, v.w };
#pragma unroll
    for (int m = 0; m < 4; ++m) { const unsigned send = odd ? (w[m] & 0xffffu) : (w[m] >> 16); const unsigned recv = (unsigned)__shfl_xor((int)send, 1);
        const unsigned val = odd ? (recv | (w[m] & 0xffff0000u)) : ((w[m] & 0xffffu) | (recv << 16));
        const int off = odd ? (ch0 + 2 * m + 1) * pb + (kidx - 1) * 2 : (ch0 + 2 * m) * pb + kidx * 2;
        *(LAS unsigned*)(ZT + off) = val; }
}
__device__ __forceinline__ void phase_dft1(Frame& F) {
    LAS unsigned char* WM = F.lds;
    LAS unsigned char* ZT = F.lds + 34816;
    const bf16* P = WSP(bf16, WS_PROJ); bf16* GB = WSP(bf16, WS_GB); const f32x2* TW = WSP(f32x2, WS_TW);
    LDS_BARRIER();
    for (int q = F.tid; q < 128 * 16; q += NTHR) { const int r = q >> 4, part = q & 15; *(LAS v4u*)(WM + r * PT + part * 16) = *(const GAS v4u*)(WSP(bf16, WS_WM1) + r * 128 + part * 8); }
    const int fr = F.lane & 15, fq = F.lane >> 4;
    for (int u = F.bx; u < NB * 128 * 2; u += F.G) {
        const int jh = u & 1, s2 = (u >> 1) & 127, b = u >> 8;
        LDS_BARRIER();
        { const int s1 = F.lane; const bf16* row = P + (size_t)(b * SEQ + 128 * s1 + s2) * PW; v4u vv[8];
#pragma unroll
          for (int q = 0; q < 8; ++q) { const int cc = F.wave * 8 + q; const int im = cc >= 32, chunk = cc & 31;
              vv[q] = *(const GAS v4u*)(row + (im ? PC_FI : PC_FR) + jh * 256 + chunk * 8); }
#pragma unroll
          for (int q = 0; q < 8; ++q) { const int cc = F.wave * 8 + q; const int im = cc >= 32, chunk = cc & 31; zt_put(ZT, PT, chunk * 8, im * 64 + s1, vv[q], s1 & 1); } }
        LDS_BARRIER();
        const int mi = F.wave & 3, jq = F.wave >> 2;
        f32x4 acc[2][8];
#pragma unroll
        for (int a = 0; a < 2; ++a)
#pragma unroll
            for (int j = 0; j < 8; ++j) acc[a][j] = (f32x4){0.f, 0.f, 0.f, 0.f};
#pragma unroll
        for (int kk = 0; kk < 4; ++kk) { const bf16x8 q0 = ldfrag(WM, PT, 16 * mi + fr, 32 * kk + 8 * fq), q1 = ldfrag(WM, PT, 64 + 16 * mi + fr, 32 * kk + 8 * fq); bf16x8 pf[8];
#pragma unroll
            for (int j = 0; j < 8; ++j) pf[j] = ldfrag(ZT, PT, 128 * jq + 16 * j + fr, 32 * kk + 8 * fq);
            MFMA_BEGIN();
#pragma unroll
            for (int j = 0; j < 8; ++j) { acc[0][j] = __builtin_amdgcn_mfma_f32_16x16x32_bf16(pf[j], q0, acc[0][j], 0, 0, 0); acc[1][j] = __builtin_amdgcn_mfma_f32_16x16x32_bf16(pf[j], q1, acc[1][j], 0, 0, 0); }
            MFMA_END(); }
        const int k1 = 16 * mi + fr;
        const f32x2 tw = TW[(s2 * k1) & 8191];
        bf16* orow = GB + ((size_t)(b * 128 + s2) * 64 + k1) * 1024 + jh * 256 + 128 * jq + 4 * fq;
#pragma unroll
        for (int j = 0; j < 8; ++j) { float gr[4], gi[4];
#pragma unroll
            for (int r = 0; r < 4; ++r) { const float a = acc[0][j][r], bq = acc[1][j][r]; gr[r] = a * tw.x + bq * tw.y; gi[r] = bq * tw.x - a * tw.y; }
            v2u o; o.x = pk2(gr[0], gr[1]); o.y = pk2(gr[2], gr[3]); *(GAS v2u*)(orow + 16 * j) = o;
            o.x = pk2(gi[0], gi[1]); o.y = pk2(gi[2], gi[3]); *(GAS v2u*)(orow + 512 + 16 * j) = o; }
    }
}
constexpr int PT2 = 528;
__device__ __forceinline__ void phase_dft2(Frame& F) {
    LAS unsigned char* WM = F.lds;
    LAS unsigned char* ZT = F.lds + 67584;
    const bf16* GB = WSP(bf16, WS_GB); bf16* FO = WSP(bf16, WS_FO);
    LDS_BARRIER();
    for (int q = F.tid; q < 128 * 32; q += NTHR) { const int r = q >> 5, part = q & 31; *(LAS v4u*)(WM + r * PT2 + part * 16) = *(const GAS v4u*)(WSP(bf16, WS_WM2) + r * 256 + part * 8); }
    const int fr = F.lane & 15, fq = F.lane >> 4, w = F.wave;
    for (int u = F.bx; u < NB * 64 * 4; u += F.G) {
        const int jb = u & 3, k1 = (u >> 2) & 63, b = u >> 8;
        LDS_BARRIER();
        { const int s2 = 64 * (w & 1) + F.lane; const bf16* row = GB + ((size_t)(b * 128 + s2) * 64 + k1) * 1024; v4u vv[8];
#pragma unroll
          for (int q = 0; q < 8; ++q) { const int cc = (w >> 1) + 4 * q; const int im = cc >= 16, chunk = cc & 15;
              vv[q] = *(const GAS v4u*)(row + im * 512 + jb * 128 + chunk * 8); }
#pragma unroll
          for (int q = 0; q < 8; ++q) { const int cc = (w >> 1) + 4 * q; const int im = cc >= 16, chunk = cc & 15; zt_put(ZT, PT2, chunk * 8, im * 128 + s2, vv[q], s2 & 1); } }
        LDS_BARRIER();
        f32x4 acc[8];
#pragma unroll
        for (int j = 0; j < 8; ++j) acc[j] = (f32x4){0.f, 0.f, 0.f, 0.f};
#pragma unroll
        for (int kk = 0; kk < 8; ++kk) { const bf16x8 q = ldfrag(WM, PT2, 16 * w + fr, 32 * kk + 8 * fq); bf16x8 pf[8];
#pragma unroll
            for (int j = 0; j < 8; ++j) pf[j] = ldfrag(ZT, PT2, 16 * j + fr, 32 * kk + 8 * fq);
            MFMA_BEGIN();
#pragma unroll
            for (int j = 0; j < 8; ++j) acc[j] = __builtin_amdgcn_mfma_f32_16x16x32_bf16(pf[j], q, acc[j], 0, 0, 0);
            MFMA_END(); }
        const int k2 = 16 * w + fr; bf16* orow = FO + (size_t)(b * SEQ + k1 + 64 * k2) * 512 + jb * 128 + 4 * fq;
#pragma unroll
        for (int j = 0; j < 8; ++j) { v2u o; o.x = pk2(acc[j][0], acc[j][1]); o.y = pk2(acc[j][2], acc[j][3]); *(GAS v2u*)(orow + 16 * j) = o; }
    }
}

__device__ __forceinline__ void phase_norm2(Frame& F) {
    LAS float* GM = (LAS float*)(F.lds); LAS float* GS = GM + 4096; LAS float* SH = GS + 4096;
    const float* mod = WSP(float, WS_MOD);
    __syncthreads();
    for (int i = F.tid; i < 4096; i += NTHR) { const int b = i >> 10, col = i & 1023; GM[i] = mod[b * 6144 + 2048 + col] * FIN(5)[col]; GS[i] = FIN(6)[col] * (1.f + mod[b * 6144 + 4096 + col]); SH[i] = mod[b * 6144 + 3072 + col]; }
    __syncthreads();
    const int gw = F.bx * NWAVES + F.wave, NGW = F.G * NWAVES; const float* x = FIN(0); bf16* H = WSP(bf16, WS_H); const bf16* MX = WSP(bf16, WS_MIXED);
    v2u nmw[4]; f32x4 nxv[4];
    if (gw < T) { const GAS v2u* mr = (const GAS v2u*)(MX + (size_t)gw * D) + F.lane; const GAS f32x4* xr = (const GAS f32x4*)(x + (size_t)gw * D) + F.lane;
#pragma unroll
        for (int j = 0; j < 4; ++j) { nmw[j] = mr[64 * j]; nxv[j] = xr[64 * j]; } }
    for (int m = gw; m < T; m += NGW) { const int b = m / SEQ;
        f32x4 v[4], xv[4]; float ss = 0.f;
#pragma unroll
        for (int j = 0; j < 4; ++j) { const v2u mw = nmw[j]; xv[j] = nxv[j]; v[j] = (f32x4){bflo(mw.x), bfhi(mw.x), bflo(mw.y), bfhi(mw.y)}; }
        if (m + NGW < T) { const GAS v2u* mr = (const GAS v2u*)(MX + (size_t)(m + NGW) * D) + F.lane; const GAS f32x4* xr = (const GAS f32x4*)(x + (size_t)(m + NGW) * D) + F.lane;
#pragma unroll
            for (int j = 0; j < 4; ++j) { nmw[j] = mr[64 * j]; nxv[j] = xr[64 * j]; } }
#pragma unroll
        for (int j = 0; j < 4; ++j) ss += (v[j].x * v[j].x + v[j].y * v[j].y) + (v[j].z * v[j].z + v[j].w * v[j].w);
        const float rstd = 1.f / sqrtf(wave_sum(ss) * (1.f / D) + RMS_EPS); float s2 = 0.f;
        GAS f32x4* o4 = (GAS f32x4*)(F.out + (size_t)m * D) + F.lane;
#pragma unroll
        for (int j = 0; j < 4; ++j) { const LAS float* gm = GM + b * 1024 + 4 * F.lane + 256 * j;
            v[j].x = xv[j].x + gm[0] * v[j].x * rstd; v[j].y = xv[j].y + gm[1] * v[j].y * rstd; v[j].z = xv[j].z + gm[2] * v[j].z * rstd; v[j].w = xv[j].w + gm[3] * v[j].w * rstd;
            o4[64 * j] = v[j]; s2 += (v[j].x * v[j].x + v[j].y * v[j].y) + (v[j].z * v[j].z + v[j].w * v[j].w); }
        const float rstd2 = 1.f / sqrtf(wave_sum(s2) * (1.f / D) + RMS_EPS);
        GAS unsigned long long* o8 = (GAS unsigned long long*)(H + (size_t)m * D) + F.lane;
#pragma unroll
        for (int j = 0; j < 4; ++j) { const int col = 4 * F.lane + 256 * j; const LAS float* gs = GS + b * 1024 + col; const LAS float* sh = SH + b * 1024 + col;
            o8[64 * j] = (unsigned long long)pk2(v[j].x * rstd2 * gs[0] + sh[0], v[j].y * rstd2 * gs[1] + sh[1]) | ((unsigned long long)pk2(v[j].z * rstd2 * gs[2] + sh[2], v[j].w * rstd2 * gs[3] + sh[3]) << 32); }
    }
}

#define DPP_MAX_STEP(ctrl, rmask) do { const float ov = __builtin_bit_cast(float, __builtin_amdgcn_update_dpp(__builtin_bit_cast(int, bv), __builtin_bit_cast(int, bv), ctrl, rmask, 0xf, false)); \
        const int oi = __builtin_amdgcn_update_dpp(bi, bi, ctrl, rmask, 0xf, false); const bool tk = ov > bv || (ov == bv && oi < bi); bv = tk ? ov : bv; bi = tk ? oi : bi; } while (0)
__device__ __forceinline__ void wave_argmax(float& bv, int& bi) {
    DPP_MAX_STEP(0x111, 0xf); DPP_MAX_STEP(0x112, 0xf); DPP_MAX_STEP(0x114, 0xf); DPP_MAX_STEP(0x118, 0xf);
    DPP_MAX_STEP(0x142, 0xa); DPP_MAX_STEP(0x143, 0xc);
    bv = __builtin_bit_cast(float, __builtin_amdgcn_readlane(__builtin_bit_cast(int, bv), 63)); bi = __builtin_amdgcn_readlane(bi, 63);
}
__device__ __forceinline__ void phase_route(Frame& F) {
    LAS int* hist = (LAS int*)(F.lds);
    const float* LOG = WSP(float, WS_LOG); const float* rb = FIN(21); int* TOPI = WSP(int, WS_TOPI); float* TOPW = WSP(float, WS_TOPW); int* BCNT = WSP(int, WS_BCNT);
    const int lane = F.lane;
    for (int vb = F.bx; vb < 256; vb += F.G) {
        __syncthreads();
        if (F.tid < 256) hist[F.tid] = 0;
        __syncthreads();
        for (int ti = F.wave * 4; ti < 128; ti += NWAVES * 4) {
            float sc[4][4], cand[4][4], wsum[4], mysc[4]; int myidx[4];
#pragma unroll
            for (int q = 0; q < 4; ++q) { const int t = vb * 128 + ti + q;
                const f32x4 lg = *(const GAS f32x4*)(LOG + (size_t)t * 256 + 4 * lane); const f32x4 bb = *(const GAS f32x4*)(rb + 4 * lane);
                float bs[4];
#pragma unroll
                for (int j = 0; j < 4; ++j) { sc[q][j] = 1.f / (1.f + expf(-lg[j])); bs[j] = sc[q][j] + bb[j]; }
                float m1 = fmaxf(fmaxf(bs[0], bs[1]), fmaxf(bs[2], bs[3])), m2;
                { float a_ = fmaxf(bs[0], bs[1]), a2 = fminf(bs[0], bs[1]), c_ = fmaxf(bs[2], bs[3]), c2 = fminf(bs[2], bs[3]); m2 = fmaxf(fminf(a_, c_), fmaxf(a2, c2)); }
#define TOP2_STEP(ctrl) do { const float o1 = __builtin_bit_cast(float, __builtin_amdgcn_update_dpp(0, __builtin_bit_cast(int, m1), ctrl, 0xf, 0xf, false)), o2 = __builtin_bit_cast(float, __builtin_amdgcn_update_dpp(0, __builtin_bit_cast(int, m2), ctrl, 0xf, 0xf, false)); \
                    const float n1 = fmaxf(m1, o1), n2 = fmaxf(fminf(m1, o1), fmaxf(m2, o2)); m1 = n1; m2 = n2; } while (0)
                TOP2_STEP(0xb1); TOP2_STEP(0x4e); TOP2_STEP(0x141);
#undef TOP2_STEP
                const float gs = m1 + m2; const int mygrp = lane >> 3; int rank = 0;
#pragma unroll
                for (int j = 0; j < 8; ++j) { const float og = __builtin_bit_cast(float, __builtin_amdgcn_readlane(__builtin_bit_cast(int, gs), 8 * j)); rank += (og > gs || (og == gs && j < mygrp)) ? 1 : 0; }
                const bool gsel = rank < 4;
#pragma unroll
                for (int j = 0; j < 4; ++j) cand[q][j] = gsel ? bs[j] : -INFINITY;
                wsum[q] = 0.f; mysc[q] = 0.f; myidx[q] = 0; }
            for (int k = 0; k < TOPK; ++k) {
#pragma unroll
                for (int q = 0; q < 4; ++q) {
                    float bv = cand[q][0]; int bi = 4 * lane;
#pragma unroll
                    for (int j = 1; j < 4; ++j) if (cand[q][j] > bv) { bv = cand[q][j]; bi = 4 * lane + j; }
                    wave_argmax(bv, bi);
                    const int own = bi >> 2, sub = bi & 3;
                    const float s_own = sub == 0 ? sc[q][0] : (sub == 1 ? sc[q][1] : (sub == 2 ? sc[q][2] : sc[q][3]));
                    const float ssel = __builtin_bit_cast(float, __builtin_amdgcn_readlane(__builtin_bit_cast(int, s_own), own));
                    if (lane == own) {
#pragma unroll
                        for (int j = 0; j < 4; ++j) if (j == sub) cand[q][j] = -INFINITY; }
                    wsum[q] += ssel; if (lane == k) { myidx[q] = bi; mysc[q] = ssel; } }
            }
#pragma unroll
            for (int q = 0; q < 4; ++q) { const int t = vb * 128 + ti + q;
                if (lane < TOPK) { TOPI[t * TOPK + lane] = myidx[q]; TOPW[t * TOPK + lane] = mysc[q] / wsum[q] * 2.5f; atomicAdd((int*)&hist[myidx[q]], 1); } }
        }
        __syncthreads();
        if (F.tid < 256) BCNT[vb * 256 + F.tid] = hist[F.tid];
    }
}

__device__ __forceinline__ void phase_lists(Frame& F) {
    LAS int* tot = (LAS int*)(F.lds);
    LAS int* base = tot + 256;
    LAS int* pre = base + 260;
    LAS int* cur = pre + 256;
    LAS int* part = cur + 256;
    const int* BCNT = WSP(int, WS_BCNT); const int* TOPI = WSP(int, WS_TOPI); int* TOKPOS = WSP(int, WS_TOKPOS); int* ROWTOK = WSP(int, WS_ROWTOK); int* TILEE = WSP(int, WS_TILEE);
    typedef int i32x4 __attribute__((ext_vector_type(4)));
    const int e4 = (F.tid & 63) * 4, rg = F.tid >> 6;
    for (int vb = F.bx; vb < 256; vb += F.G) {
        __syncthreads();
        { i32x4 st = (i32x4){0, 0, 0, 0}, sp = (i32x4){0, 0, 0, 0};
#pragma unroll 8
          for (int i = 0; i < 32; ++i) { const int v = rg + 8 * i; const i32x4 c4 = *(const GAS i32x4*)(BCNT + v * 256 + e4); st += c4; if (v < vb) sp += c4; }
          *(LAS i32x4*)(part + rg * 256 + e4) = st; *(LAS i32x4*)(part + 2048 + rg * 256 + e4) = sp; }
        __syncthreads();
        if (F.tid < 256) { int s = 0, q = 0;
#pragma unroll
            for (int r = 0; r < 8; ++r) { s += part[r * 256 + F.tid]; q += part[2048 + r * 256 + F.tid]; }
            tot[F.tid] = s; pre[F.tid] = q; cur[F.tid] = 0; }
        __syncthreads();
        if (F.tid < 256) { const int pad = (tot[F.tid] + 255) & ~255; int v = pad;
#pragma unroll
            for (int o = 1; o < 64; o <<= 1) { const int t_ = __shfl_up(v, o); if (F.lane >= o) v += t_; }
            part[F.tid] = v - pad; if (F.lane == 63) part[256 + F.wave] = v; }
        __syncthreads();
        if (F.tid < 256) { int off = T; for (int w_ = 0; w_ < F.wave; ++w_) off += part[256 + w_]; base[F.tid] = off + part[F.tid]; if (F.tid == 255) base[256] = off + part[255] + ((tot[255] + 255) & ~255); }
        __syncthreads();
        if (vb == 0) {
            int* TILEV = WSP(int, WS_TILEV);
            if (F.tid < 256) { const int e = F.tid; int left = tot[e]; for (int t = base[e] >> 8; t < (base[e + 1] >> 8); ++t) { TILEE[t] = e; TILEV[t] = left < 256 ? left : 256; left -= 256; } }
            for (int t = F.tid; t < T / 256; t += NTHR) { TILEE[t] = NE; TILEV[t] = 256; }
            if (F.tid == 0) { F.ctl[CW_NTILES] = (unsigned)(base[256] >> 8); F.ctl[CW_BASESH] = 0u; }
        }
        for (int r = base[vb] + tot[vb] + F.tid; r < base[vb + 1]; r += NTHR) ROWTOK[r] = 0;
        for (int i = F.tid; i < 128 * TOPK; i += NTHR) { const int t = vb * 128 + (i >> 3); const int e = TOPI[t * TOPK + (i & 7)]; const int pos = base[e] + pre[e] + atomicAdd((int*)&cur[e], 1);
            ROWTOK[pos] = t; TOKPOS[t * TOPK + (i & 7)] = pos; }
    }
}

__device__ __forceinline__ void phase_final(Frame& F) {
    LAS float* GF = (LAS float*)(F.lds);
    const float* mod = WSP(float, WS_MOD);
    __syncthreads();
    for (int i = F.tid; i < 4096; i += NTHR) { const int b = i >> 10, col = i & 1023; GF[i] = mod[b * 6144 + 5120 + col] * FIN(7)[col]; }
    __syncthreads();
    const int gw = F.bx * NWAVES + F.wave, NGW = F.G * NWAVES; const unsigned char* YB = WSP(unsigned char, WS_YB); const int* TOKPOS = WSP(int, WS_TOKPOS); const float* TOPW = WSP(float, WS_TOPW);
    const int basesh = (int)__hip_atomic_load(F.ctl + CW_BASESH, RLX_AGENT);
    int npos[TOPK + 1]; float nwk[TOPK + 1]; v2u ny0[TOPK + 1], ny1[TOPK + 1];
#define FIN_LOAD_PW(mm) do { _Pragma("unroll") for (int k = 0; k < TOPK; ++k) { npos[k] = TOKPOS[(mm) * TOPK + k]; nwk[k] = TOPW[(mm) * TOPK + k] * (1.f / YB_SCALE); } npos[TOPK] = basesh + (mm); nwk[TOPK] = 1.f / YB_SCALE; } while (0)
#define FIN_LOAD_ROWS(pos_, y0_, y1_) do { _Pragma("unroll") for (int k = 0; k < TOPK + 1; ++k) { const GAS v2u* yr = (const GAS v2u*)(YB + (size_t)(pos_)[k] * 1024) + F.lane; (y0_)[k] = yr[0]; (y1_)[k] = yr[64]; } } while (0)
    float cwk[TOPK + 1];
    if (gw < T) { FIN_LOAD_PW(gw); FIN_LOAD_ROWS(npos, ny0, ny1);
#pragma unroll
        for (int k = 0; k < TOPK + 1; ++k) cwk[k] = nwk[k];
        if (gw + NGW < T) FIN_LOAD_PW(gw + NGW); }
    for (int m = gw; m < T; m += NGW) { const int b = m / SEQ;
        float a[16]; v2u y0[TOPK + 1], y1[TOPK + 1]; float wk_[TOPK + 1];
#pragma unroll
        for (int k = 0; k < TOPK + 1; ++k) { y0[k] = ny0[k]; y1[k] = ny1[k]; wk_[k] = cwk[k]; }
        if (m + NGW < T) { FIN_LOAD_ROWS(npos, ny0, ny1);
#pragma unroll
            for (int k = 0; k < TOPK + 1; ++k) cwk[k] = nwk[k];
            if (m + 2 * NGW < T) FIN_LOAD_PW(m + 2 * NGW); }
#pragma unroll
        for (int j = 0; j < 16; ++j) a[j] = 0.f;
#pragma unroll
        for (int k = 0; k < TOPK + 1; ++k) { const float wk = wk_[k];
            a[0] += wk * __builtin_amdgcn_cvt_f32_fp8((int)y0[k].x, 0); a[1] += wk * __builtin_amdgcn_cvt_f32_fp8((int)y0[k].x, 1); a[2] += wk * __builtin_amdgcn_cvt_f32_fp8((int)y0[k].x, 2); a[3] += wk * __builtin_amdgcn_cvt_f32_fp8((int)y0[k].x, 3);
            a[4] += wk * __builtin_amdgcn_cvt_f32_fp8((int)y0[k].y, 0); a[5] += wk * __builtin_amdgcn_cvt_f32_fp8((int)y0[k].y, 1); a[6] += wk * __builtin_amdgcn_cvt_f32_fp8((int)y0[k].y, 2); a[7] += wk * __builtin_amdgcn_cvt_f32_fp8((int)y0[k].y, 3);
            a[8] += wk * __builtin_amdgcn_cvt_f32_fp8((int)y1[k].x, 0); a[9] += wk * __builtin_amdgcn_cvt_f32_fp8((int)y1[k].x, 1); a[10] += wk * __builtin_amdgcn_cvt_f32_fp8((int)y1[k].x, 2); a[11] += wk * __builtin_amdgcn_cvt_f32_fp8((int)y1[k].x, 3);
            a[12] += wk * __builtin_amdgcn_cvt_f32_fp8((int)y1[k].y, 0); a[13] += wk * __builtin_amdgcn_cvt_f32_fp8((int)y1[k].y, 1); a[14] += wk * __builtin_amdgcn_cvt_f32_fp8((int)y1[k].y, 2); a[15] += wk * __builtin_amdgcn_cvt_f32_fp8((int)y1[k].y, 3); }
        float ss = 0.f;
#pragma unroll
        for (int j = 0; j < 16; ++j) ss += a[j] * a[j];
        const float rstd = 1.f / sqrtf(wave_sum(ss) * (1.f / D) + RMS_EPS);
        float* orow = F.out + (size_t)m * D;
#pragma unroll
        for (int hlf = 0; hlf < 2; ++hlf) { const int col = hlf * 512 + 8 * F.lane; const LAS float* gf = GF + b * 1024 + col;
            f32x4 x0 = *(GAS f32x4*)(orow + col), x1 = *(GAS f32x4*)(orow + col + 4);
            x0.x += gf[0] * a[8 * hlf + 0] * rstd; x0.y += gf[1] * a[8 * hlf + 1] * rstd; x0.z += gf[2] * a[8 * hlf + 2] * rstd; x0.w += gf[3] * a[8 * hlf + 3] * rstd;
            x1.x += gf[4] * a[8 * hlf + 4] * rstd; x1.y += gf[5] * a[8 * hlf + 5] * rstd; x1.z += gf[6] * a[8 * hlf + 6] * rstd; x1.w += gf[7] * a[8 * hlf + 7] * rstd;
            *(GAS f32x4*)(orow + col) = x0; *(GAS f32x4*)(orow + col + 4) = x1; }
    }
}
constexpr int NPH = 18;
struct Args { const float* in[26]; float* out; unsigned char* ws; };
template <int LO, int HI>
__global__ void __launch_bounds__(NTHR, 2) fwd(Args args) {
    extern __shared__ __attribute__((aligned(16))) unsigned char lds[];
    Frame F;
    F.lds = (LAS unsigned char*)lds; F.ws = args.ws; F.ctl = (gu32*)(args.ws + WS_CTL);
    F.tid = threadIdx.x; F.lane = F.tid & 63; F.wave = __builtin_amdgcn_readfirstlane(F.tid >> 6); F.G = gridDim.x; F.bx = blockIdx.x;
    F.out = args.out;
    volatile LAS unsigned* MISC = (volatile LAS unsigned*)(F.lds + MISC_OFF);
    if (F.tid < 64) MISC[F.tid] = 0u;
#if KSTART_INV
    if (F.tid == 0) { __builtin_amdgcn_fence(__ATOMIC_ACQUIRE, "agent"); asm volatile("s_waitcnt vmcnt(0)" ::: "memory"); }
#endif
    __syncthreads();
    XcdBarrier bar; bar.bar = (unsigned*)(F.ctl + CW_BAR); bar.x = 0; bar.st = nullptr;
    if constexpr (HI - LO > 1) bar = xcd_barrier_post((unsigned*)(F.ctl + CW_BAR), MISC + 8);
#define IN(k) (LO <= (k) && (k) < HI)
#define FRESH() do { int _t = threadIdx.x; asm volatile("" : "+v"(_t)); F.tid = _t; F.lane = _t & 63; F.wave = __builtin_amdgcn_readfirstlane(_t >> 6); \
        unsigned long long _w = (unsigned long long)args.ws; asm volatile("" : "+s"(_w)); F.ws = (unsigned char*)_w; F.ctl = (gu32*)(F.ws + WS_CTL); \
        unsigned long long _o = (unsigned long long)args.out; asm volatile("" : "+s"(_o)); F.out = (float*)_o; } while (0)
#if TIMING
#define TSTAMP(k) do { if (blockIdx.x == 0 && threadIdx.x == 0) ((unsigned long long*)(args.ws + WS_CTL))[256 + (k)] = __builtin_amdgcn_s_memrealtime(); } while (0)
#else
#define TSTAMP(k) do {} while (0)
#endif
#define SEAM(k) do { if constexpr (IN(k) && IN((k) + 1)) xcd_barrier(bar); TSTAMP(k); } while (0)
    TSTAMP(18);
    if constexpr (IN(0)) { FRESH(); phase_prologue(F); } SEAM(0);
    if constexpr (IN(1)) { FRESH(); phase_norm1(F); } SEAM(1);
    if constexpr (IN(2)) { FRESH();
        __syncthreads();
        pg8::Gemm g{WSP(bf16, WS_H), WSP(bf16, WS_WINT), T, NPROJ, D, nullptr}; pg8::StaticOrder S; S.init(T, NPROJ, F.G, F.bx);
        pg8::EpiProj E{WSP(bf16, WS_PROJ), PW, WSP(float, WS_DT)};
        pg8::gemm_phase<pg8::EpiProj, pg8::StaticOrder, true, false>(F.lds, g, S, E);
    } SEAM(2);
    if constexpr (IN(3)) { FRESH(); phase_states(F); } TSTAMP(3);
    if constexpr (IN(4)) { FRESH(); phase_dft1(F); } SEAM(4);
    if constexpr (IN(5)) { FRESH(); phase_scan(F); } TSTAMP(5);
    if constexpr (IN(6)) { FRESH(); phase_dft2(F); } SEAM(6);
    if constexpr (IN(7)) { FRESH(); phase_ssd_out(F); } SEAM(7);
    if constexpr (IN(8)) { FRESH();
        __syncthreads();
        pg8::Gemm g{WSP(bf16, WS_YN), WSP(bf16, WS_WBST), T, D, INNER, nullptr}; pg8::StaticOrder S; S.init(T, D, F.G, F.bx);
        pg8::EpiGate<false> E{WSP(bf16, WS_MIX), D, WSP(bf16, WS_PROJ), PW, PC_GS};
        pg8::gemm_phase<pg8::EpiGate<false>, pg8::StaticOrder, true, false>(F.lds, g, S, E);
    } TSTAMP(8);
    if constexpr (IN(9)) { FRESH();
        __syncthreads();
        pg8::Gemm g{WSP(bf16, WS_FO), WSP(bf16, WS_WBFT), T, D, 512, nullptr}; pg8::StaticOrder S; S.init(T, D, F.G, F.bx);
        pg8::EpiGate<true> E{WSP(bf16, WS_MIX), D, WSP(bf16, WS_PROJ), PW, PC_GF};
        pg8::gemm_phase<pg8::EpiGate<true>, pg8::StaticOrder, true, false>(F.lds, g, S, E);
    } SEAM(9);
    if constexpr (IN(10)) { FRESH();
        __syncthreads();
        pg8::Gemm g{WSP(bf16, WS_MIX), WSP(bf16, WS_WOUTT), T, D, D, nullptr}; pg8::StaticOrder S; S.init(T, D, F.G, F.bx);
        pg8::EpiBf16<4> E{WSP(bf16, WS_MIXED), D};
        pg8::gemm_phase<pg8::EpiBf16<4>, pg8::StaticOrder, true, false>(F.lds, g, S, E);
    } SEAM(10);
    if constexpr (IN(11)) { FRESH(); phase_norm2(F); } SEAM(11);
    if constexpr (IN(12)) { FRESH();
        __syncthreads();
        const int nrb = (T / 256 < F.G) ? T / 256 : F.G;
        if (F.bx < nrb || F.G - nrb < 8) {
            pg8::Gemm g{WSP(bf16, WS_H), WSP(bf16, WS_WRT), T, NE, D, nullptr}; pg8::StaticOrder S; S.init(T, NE, F.G, F.bx);
            pg8::EpiF32 E{WSP(float, WS_LOG), NE};
            pg8::gemm_phase<pg8::EpiF32, pg8::StaticOrder, true, false>(F.lds, g, S, E);
        }
        if (F.bx >= nrb || F.G - nrb < 8) {
            const bool all = F.G - nrb < 8;
            pg8::Gemm g{WSP(bf16, WS_H), WSP(bf16, WS_W13T), T, NEX * 512, D, nullptr}; pg8::SharedOrder S{T / 256, NE, all ? 0 : nrb, all ? F.G : F.G - nrb, F.bx};
            pg8::EpiSwiglu E{WSP(bf16, WS_HB), EH};
            pg8::gemm_phase<pg8::EpiSwiglu, pg8::SharedOrder, true, false>(F.lds, g, S, E);
        }
    } SEAM(12);
    if constexpr (IN(13)) { FRESH(); phase_route(F); } SEAM(13);
    if constexpr (IN(14)) { FRESH(); phase_lists(F); } SEAM(14);
    if constexpr (IN(15)) { FRESH();
        __syncthreads();
        const int ntiles = (int)__hip_atomic_load(F.ctl + CW_NTILES, RLX_AGENT);
        LAS int* te = (LAS int*)(F.lds + 131072); for (int i = F.tid; i < MAXTILES; i += NTHR) te[i] = (i < ntiles) ? WSP(int, WS_TILEE)[i] : 0;
        __syncthreads();
        pg8::Gemm g{WSP(bf16, WS_H), WSP(bf16, WS_W13T), ROWS_ALL, NEX * 512, D, WSP(int, WS_ROWTOK)}; pg8::GroupedOrder<2> S{te, ntiles, F.G, F.bx, T / 256};
        pg8::EpiSwiglu E{WSP(bf16, WS_HB), EH};
        pg8::gemm_phase<pg8::EpiSwiglu, pg8::GroupedOrder<2>, true, true>(F.lds, g, S, E);
    } SEAM(15);
    if constexpr (IN(16)) { FRESH();
        __syncthreads();
        const int ntiles = (int)__hip_atomic_load(F.ctl + CW_NTILES, RLX_AGENT);
        LAS int* te = (LAS int*)(F.lds + 131072); LAS int* tv = te + MAXTILES;
        for (int i = F.tid; i < MAXTILES; i += NTHR) { te[i] = (i < ntiles) ? WSP(int, WS_TILEE)[i] : 0; tv[i] = (i < ntiles) ? WSP(int, WS_TILEV)[i] : 0; }
        __syncthreads();
        pg8::Gemm g{WSP(bf16, WS_HB), WSP(bf16, WS_W2T), ROWS_ALL, NEX * 1024, EH, nullptr}; pg8::GroupedOrder<4> S{te, ntiles, F.G, F.bx, 0};
        pg8::EpiFp8<4> E{WSP(unsigned char, WS_YB), D, tv, YB_SCALE};
        pg8::gemm_phase<pg8::EpiFp8<4>, pg8::GroupedOrder<4>, true, false>(F.lds, g, S, E);
    } SEAM(16);
    if constexpr (IN(17)) { FRESH(); phase_final(F); }
#if TIMING
    if constexpr (HI - LO > 1) { xcd_barrier(bar); TSTAMP(17);
        if (blockIdx.x == 0) { __syncthreads(); const unsigned long long* TS = (const unsigned long long*)(args.ws + WS_CTL) + 256;
            const float ta = (float)(TS[TA_HI] - (TA_LO > 0 ? TS[TA_LO - 1] : TS[18])) * 0.01f, tb = (float)(TS[TB_HI] - (TB_LO > 0 ? TS[TB_LO - 1] : TS[18])) * 0.01f;
            VM_WAIT(); __syncthreads();
            for (int i = threadIdx.x; i < (1 << 20); i += NTHR) args.out[(size_t)1024 * 1024 + i] += tb * 0.01f;
            if (threadIdx.x == 0) args.out[7] = ta; } }
#endif
#undef IN
#undef SEAM
}
#if DEV_CHECKS
struct CArgs { const float* in[26]; float* out; unsigned char* ws; };
#define CW(T_, off) ((T_*)(a.ws + (off)))
__device__ __forceinline__ unsigned hsh(unsigned x) { x ^= x >> 16; x *= 0x7feb352du; x ^= x >> 15; x *= 0x846ca68bu; x ^= x >> 16; return x; }
__device__ __forceinline__ void chk_acc(unsigned char* ws, int k, float num, float den) {
    num = wave_sum(num); den = wave_sum(den);
    if ((threadIdx.x & 63) == 0) { float* e = (float*)(ws + WS_CTL) + CW_ERR + 2 * k; atomicAdd(e, num); atomicAdd(e + 1, den); }
}
__device__ __forceinline__ float bfr(float f) { return __uint_as_float(f2bf(f) << 16); }
__device__ float c_convsilu(const CArgs& a, int b, int s, int ch) {
    const bf16* P = CW(bf16, WS_PROJ); float o = a.in[10][ch];
    for (int i = 0; i < 5; ++i) { const int ss = s + i - 2; if (ss >= 0 && ss < SEQ) o += a.in[9][i * 2560 + ch] * bf2f(P[(size_t)(b * SEQ + ss) * PW + PC_X + ch]); }
    return siluf_(o);
}
__device__ float c_prev(const CArgs& a, size_t si, int idx, int h, int d) {
    const size_t ei = si * 8192 + idx; const int wv = CW(int, WS_ST)[ei >> 2]; const int bs = ei & 3;
    return (bs == 0 ? __builtin_amdgcn_cvt_f32_fp8(wv, 0) : bs == 1 ? __builtin_amdgcn_cvt_f32_fp8(wv, 1) : bs == 2 ? __builtin_amdgcn_cvt_f32_fp8(wv, 2) : __builtin_amdgcn_cvt_f32_fp8(wv, 3)) * softplusf_(d ? a.in[12][h] : a.in[11][h]) * (1.f / STP_SCALE);
}
__device__ float c_dt(const CArgs& a, int b, int s, int h, int d) { return softplusf_(CW(float, WS_DT)[(size_t)(b * SEQ + s) * 64 + d * 24 + h] + (d ? a.in[12][h] : a.in[11][h])); }
__device__ float c_a(const CArgs& a, int b, int s, int h, int d) { return -expf(d ? a.in[14][h] : a.in[13][h]) * c_dt(a, b, s, h, d); }

__global__ void chk0(CArgs a) {
    const unsigned sid = blockIdx.x * blockDim.x + threadIdx.x; const unsigned r = hsh(sid * 3u + 1u), r2 = hsh(sid * 3u + 2u);
    float num = 0.f, den = 0.f;
    { const int b = r & 3, col = (r >> 2) % 6144; float s = a.in[3][col]; for (int k = 0; k < 1024; ++k) s += siluf_(a.in[1][b * 1024 + k]) * a.in[2][(size_t)k * 6144 + col];
      const float f = CW(float, WS_MOD)[b * 6144 + col]; num += (f - s) * (f - s); den += s * s; }
    { const int d = r2 % NPROJ, k = (r2 >> 13) & 1023; float e;
      if (d < 4096) e = a.in[8][(size_t)k * INW + d];
      else if (d < 5120) { const int im = d >= PC_FI, q = (d - 4096) & 511, g = q >> 7, j = q & 127; float s = 0.f;
          for (int c = 0; c < 128; ++c) { float sn, cs; sincospif((float)((c * j) & 127) / 64.f, &sn, &cs); s += a.in[8][(size_t)k * INW + SRC_F + g * 128 + c] * (im ? -sn : cs); } e = s * 0.08838834764831845f; }
      else if (d < 7168) e = a.in[8][(size_t)k * INW + SRC_G + d - 5120];
      else e = (d - 7168 < 48) ? a.in[8][(size_t)k * INW + SRC_DT + d - 7168] : 0.f;
      const float f = bf2f(CW(bf16, WS_WINT)[(size_t)d * 1024 + k]); num += (f - e) * (f - e); den += e * e + 1e-6f; }
    { const int n = r & 1023, k = (r >> 10) % 1536; const float e = a.in[17][(size_t)k * 1024 + n] * a.in[16][k], f = bf2f(CW(bf16, WS_WBST)[(size_t)n * 1536 + k]); num += (f - e) * (f - e); den += e * e; }
    { const int n = r2 & 1023, k = (r2 >> 10) & 511; const float e = a.in[18][(size_t)k * 1024 + n], f = bf2f(CW(bf16, WS_WBFT)[(size_t)n * 512 + k]); num += (f - e) * (f - e); den += e * e; }
    { const int n = r & 1023, k = (r >> 10) & 1023; const float e = a.in[19][(size_t)k * 1024 + n], f = bf2f(CW(bf16, WS_WOUTT)[(size_t)n * 1024 + k]); num += (f - e) * (f - e); den += e * e; }
    { const int n = r2 & 255, k = (r2 >> 8) & 1023; const float e = a.in[20][(size_t)k * 256 + n], f = bf2f(CW(bf16, WS_WRT)[(size_t)n * 1024 + k]); num += (f - e) * (f - e); den += e * e; }
    { const int e_ = hsh(sid + 77u) % NEX, rho = r & 511, k = (r >> 9) & 1023; const int pn = rho >> 8, bj = (rho >> 7) & 1, jj = rho & 127, sc = bj * 256 + pn * 128 + jj;
      const float e = (e_ < NE) ? a.in[22][((size_t)e_ * 1024 + k) * 512 + sc] : a.in[24][(size_t)k * 512 + sc]; const float f = bf2f(CW(bf16, WS_W13T)[((size_t)e_ * 512 + rho) * 1024 + k]); num += (f - e) * (f - e); den += e * e; }
    { const int e_ = hsh(sid + 99u) % NEX, n = r2 & 1023, k = (r2 >> 10) & 255;
      const float e = (e_ < NE) ? a.in[23][((size_t)e_ * 256 + k) * 1024 + n] : a.in[25][(size_t)k * 1024 + n]; const float f = bf2f(CW(bf16, WS_W2T)[((size_t)e_ * 1024 + n) * 256 + k]); num += (f - e) * (f - e); den += e * e; }
    chk_acc(a.ws, 0, num, den);
}
__global__ void chk1(CArgs a) {
    const unsigned sid = blockIdx.x * blockDim.x + threadIdx.x; if (sid >= 4096) return; const unsigned r = hsh(sid + 11u);
    const int m = r % T, b = m / SEQ; const float* x = a.in[0] + (size_t)m * D; float ss = 0.f; for (int k = 0; k < D; ++k) ss += x[k] * x[k];
    const float rstd = 1.f / sqrtf(ss / D + RMS_EPS); const float* mod = CW(float, WS_MOD) + b * 6144; float num = 0.f, den = 0.f;
    for (int q = 0; q < 8; ++q) { const int col = (r >> 15) * 8 % 1024 + q; const float e = x[col] * rstd * a.in[4][col] * (1.f + mod[1024 + col]) + mod[col]; const float f = bf2f(CW(bf16, WS_H)[(size_t)m * D + col]); num += (f - e) * (f - e); den += e * e; }
    chk_acc(a.ws, 1, num, den);
}
__device__ float c_dot_bf(const bf16* A, const bf16* B, int K) { float s = 0.f; for (int k = 0; k < K; ++k) s += bf2f(A[k]) * bf2f(B[k]); return s; }
__global__ void chk2(CArgs a) {
    const unsigned sid = blockIdx.x * blockDim.x + threadIdx.x; const unsigned r = hsh(sid + 21u);
    const int m = r % T; int col = (r >> 15) % (PW + 48); float num = 0.f, den = 0.f;
    const float e = c_dot_bf(CW(bf16, WS_H) + (size_t)m * D, CW(bf16, WS_WINT) + (size_t)col * D, D); float f, ee = e;
    if (col < PW) { if (col >= PC_GS) ee = 1.f / (1.f + expf(-e)); f = bf2f(CW(bf16, WS_PROJ)[(size_t)m * PW + col]); } else f = CW(float, WS_DT)[(size_t)m * 64 + col - PW];
    num = (f - ee) * (f - ee); den = ee * ee; chk_acc(a.ws, 2, num, den);
}
__global__ void chk3(CArgs a) {
    const unsigned sid = blockIdx.x * blockDim.x + threadIdx.x; if (sid >= 8192) return; const unsigned r = hsh(sid + 31u);
    const int b = r & 3, c = (r >> 2) & 63, h = (r >> 8) % 24, d = (r >> 13) & 1, p = (r >> 14) & 63, n = (r >> 20) & 127, g = h / HPG;
    float tot = 0.f; for (int s = 0; s < 128; ++s) tot += c_a(a, b, c * 128 + s, h, d);
    float st = 0.f, run = 0.f;
    if (d == 0) { for (int s = 0; s < 128; ++s) { run += c_a(a, b, c * 128 + s, h, 0); st += c_convsilu(a, b, c * 128 + s, h * 64 + p) * c_dt(a, b, c * 128 + s, h, 0) * expf(tot - run) * c_convsilu(a, b, c * 128 + s, 1536 + g * 128 + n); } }
    else { for (int s = 127; s >= 0; --s) { run += c_a(a, b, c * 128 + s, h, 1); st += c_convsilu(a, b, c * 128 + s, h * 64 + p) * c_dt(a, b, c * 128 + s, h, 1) * expf(tot - run) * c_convsilu(a, b, c * 128 + s, 1536 + g * 128 + n); } }
    const size_t si = ((size_t)((b * NCHUNK + c) * HEADS + h) * 2 + d); const size_t ei = si * 8192 + p * 128 + n; const int wv = CW(int, WS_STL)[ei >> 2]; const int bs = ei & 3;
    const float f = (bs == 0 ? __builtin_amdgcn_cvt_f32_fp8(wv, 0) : bs == 1 ? __builtin_amdgcn_cvt_f32_fp8(wv, 1) : bs == 2 ? __builtin_amdgcn_cvt_f32_fp8(wv, 2) : __builtin_amdgcn_cvt_f32_fp8(wv, 3)) * softplusf_(d ? a.in[12][h] : a.in[11][h]) * (1.f / STL_SCALE);
    float num = (f - st) * (f - st), den = st * st; const float cd = CW(float, WS_CD)[si], ce = expf(tot); num += (cd - ce) * (cd - ce); den += ce * ce;
    chk_acc(a.ws, 3, num, den);
}
__global__ void chk4(CArgs a) {
    const unsigned sid = blockIdx.x * blockDim.x + threadIdx.x; const unsigned r = hsh(sid + 41u);
    const int b = r & 3, s2 = (r >> 2) & 127, k1 = (r >> 9) & 63, j = (r >> 15) & 511; const bf16* P = CW(bf16, WS_PROJ);
    float gr = 0.f, gi = 0.f;
    for (int s1 = 0; s1 < 64; ++s1) { const size_t row = (size_t)(b * SEQ + 128 * s1 + s2) * PW; const float zr = bf2f(P[row + PC_FR + j]), zi = bf2f(P[row + PC_FI + j]);
        float sn, cs; sincospif((float)((s1 * k1) & 63) / 32.f, &sn, &cs); gr += zr * cs + zi * sn; gi += zi * cs - zr * sn; }
    float sn, cs; sincospif((float)((s2 * k1) & 8191) / 4096.f, &sn, &cs); const float er = (gr * cs + gi * sn) * 0.125f, ei = (gi * cs - gr * sn) * 0.125f;
    const bf16* G = CW(bf16, WS_GB) + ((size_t)(b * 128 + s2) * 64 + k1) * 1024; const float fr_ = bf2f(G[j]), fi = bf2f(G[512 + j]);
    chk_acc(a.ws, 4, (fr_ - er) * (fr_ - er) + (fi - ei) * (fi - ei), er * er + ei * ei);
}
__global__ void chk5(CArgs a) {
    const unsigned sid = blockIdx.x * blockDim.x + threadIdx.x; if (sid >= 8192) return; const unsigned r = hsh(sid + 51u);
    const int b = r & 3, c = (r >> 2) & 63, h = (r >> 8) % 24, d = (r >> 13) & 1, p = (r >> 14) & 63, n = (r >> 20) & 127, g = h / HPG;
    const int cn = d ? c - 1 : c + 1; float num = 0.f, den = 0.f;
    const size_t si = ((size_t)((b * NCHUNK + c) * HEADS + h) * 2 + d);
    if ((d == 0 && c == 0) || (d == 1 && c == 63)) { const float f = c_prev(a, si, p * 128 + n, h, d); num += f * f; }
    if (cn >= 0 && cn < 64) {
        float tot = 0.f; for (int s = 0; s < 128; ++s) tot += c_a(a, b, c * 128 + s, h, d);
        float st = 0.f, run = 0.f;
        for (int q = 0; q < 128; ++q) { const int s = d ? 127 - q : q; run += c_a(a, b, c * 128 + s, h, d); st += c_convsilu(a, b, c * 128 + s, h * 64 + p) * c_dt(a, b, c * 128 + s, h, d) * expf(tot - run) * c_convsilu(a, b, c * 128 + s, 1536 + g * 128 + n); }
        const size_t sn_ = ((size_t)((b * NCHUNK + cn) * HEADS + h) * 2 + d);
        const float e = c_prev(a, si, p * 128 + n, h, d) * expf(tot) + st, f = c_prev(a, sn_, p * 128 + n, h, d); num += (f - e) * (f - e); den += e * e + st * st; }
    chk_acc(a.ws, 5, num, den);
}
__global__ void chk6(CArgs a) {
    const unsigned sid = blockIdx.x * blockDim.x + threadIdx.x; const unsigned r = hsh(sid + 61u);
    const int b = r & 3, k = (r >> 2) & 8191, j = (r >> 15) & 511, k1 = k & 63, k2 = k >> 6; float num = 0.f, den = 0.f;
    { float s = 0.f; for (int s2 = 0; s2 < 128; ++s2) { const bf16* G = CW(bf16, WS_GB) + ((size_t)(b * 128 + s2) * 64 + k1) * 1024; float sn, cs; sincospif((float)((s2 * k2) & 127) / 64.f, &sn, &cs); s += bf2f(G[j]) * cs + bf2f(G[512 + j]) * sn; }
      s *= 0.08838834764831845f; const float f = bf2f(CW(bf16, WS_FO)[(size_t)(b * SEQ + k) * 512 + j]); num += (f - s) * (f - s); den += s * s; }
    if (sid < 512) { const bf16* P = CW(bf16, WS_PROJ); double s = 0.0; for (int t = 0; t < SEQ; ++t) { const size_t row = (size_t)(b * SEQ + t) * PW; float sn, cs; sincospif((float)(((long)k * t) & 8191) / 4096.f, &sn, &cs); s += bf2f(P[row + PC_FR + j]) * cs + bf2f(P[row + PC_FI + j]) * sn; }
      const float e = (float)s * 0.125f * 0.08838834764831845f; const float f = bf2f(CW(bf16, WS_FO)[(size_t)(b * SEQ + k) * 512 + j]); num += 16.f * (f - e) * (f - e); den += 16.f * e * e; }
    chk_acc(a.ws, 6, num, den);
}
__global__ void chk7(CArgs a) {
    __shared__ float Cl[128], CBs[2][128], red[384]; __shared__ float acf[6][128], acb[6][128];
    const unsigned r = hsh(blockIdx.x + 71u); const int b = r & 3, c = (r >> 2) & 63, l = (r >> 8) & 127, g = (r >> 15) & 3, tid = threadIdx.x;
    if (tid < 128) Cl[tid] = c_convsilu(a, b, c * 128 + l, 2048 + g * 128 + tid);
    if (tid < 12) { const int d = tid / 6, hh = tid % 6, h = g * HPG + hh; float run = 0.f;
        if (!d) for (int s = 0; s < 128; ++s) { run += c_a(a, b, c * 128 + s, h, 0); acf[hh][s] = run; } else for (int s = 127; s >= 0; --s) { run += c_a(a, b, c * 128 + s, h, 1); acb[hh][s] = run; } }
    __syncthreads();
    if (tid < 128) { float s = 0.f; for (int n = 0; n < 128; ++n) s += Cl[n] * c_convsilu(a, b, c * 128 + tid, 1536 + g * 128 + n); CBs[0][tid] = s; }
    __syncthreads();
    const int hh = tid / 64, p = tid % 64, h = g * HPG + hh; float y = 0.f;
    for (int s = 0; s < 128; ++s) { const float x = c_convsilu(a, b, c * 128 + s, h * 64 + p); float wgt = 0.f;
        if (s <= l) wgt += expf(acf[hh][l] - acf[hh][s]) * c_dt(a, b, c * 128 + s, h, 0);
        if (s >= l) wgt += expf(acb[hh][l] - acb[hh][s]) * c_dt(a, b, c * 128 + s, h, 1);
        y += CBs[0][s] * wgt * x; if (s == l) y += a.in[15][h] * x; }
    for (int d = 0; d < 2; ++d) { const size_t si_ = ((size_t)((b * NCHUNK + c) * HEADS + h) * 2 + d); float s = 0.f; for (int n = 0; n < 128; ++n) s += Cl[n] * c_prev(a, si_, p * 128 + n, h, d);
        y += s * expf(d ? acb[hh][l] : acf[hh][l]); }
    const size_t trow = (size_t)(b * SEQ + c * 128 + l);
    const float v = y * siluf_(bf2f(CW(bf16, WS_PROJ)[trow * PW + PC_Z + h * 64 + p])); red[tid] = v * v; __syncthreads();
    if (tid == 0) { float s = 0.f; for (int i = 0; i < 384; ++i) s += red[i]; red[0] = s; } __syncthreads();
    const float e = v / sqrtf(red[0] / 384.f + RMS_EPS), f = bf2f(CW(bf16, WS_YN)[trow * INNER + g * 384 + tid]);
    float num = (f - e) * (f - e), den = e * e; num = wave_sum(num); den = wave_sum(den);
    if ((tid & 63) == 0) { float* ew = (float*)(a.ws + WS_CTL) + CW_ERR + 2 * 7; atomicAdd(ew, num); atomicAdd(ew + 1, den); }
}
__global__ void chk9(CArgs a) {
    const unsigned sid = blockIdx.x * blockDim.x + threadIdx.x; const unsigned r = hsh(sid + 91u); const int m = r % T, col = (r >> 15) & 1023;
    const float y1 = c_dot_bf(CW(bf16, WS_YN) + (size_t)m * INNER, CW(bf16, WS_WBST) + (size_t)col * INNER, INNER), y2 = c_dot_bf(CW(bf16, WS_FO) + (size_t)m * 512, CW(bf16, WS_WBFT) + (size_t)col * 512, 512);
    const bf16* P = CW(bf16, WS_PROJ) + (size_t)m * PW; const float e = bfr(bf2f(P[PC_GS + col]) * y1) + bf2f(P[PC_GF + col]) * y2, f = bf2f(CW(bf16, WS_MIX)[(size_t)m * D + col]);
    chk_acc(a.ws, 9, (f - e) * (f - e), e * e);
}
__global__ void chk10(CArgs a) {
    const unsigned sid = blockIdx.x * blockDim.x + threadIdx.x; const unsigned r = hsh(sid + 101u); const int m = r % T, col = (r >> 15) & 1023;
    const float e = c_dot_bf(CW(bf16, WS_MIX) + (size_t)m * D, CW(bf16, WS_WOUTT) + (size_t)col * D, D), f = bf2f(CW(bf16, WS_MIXED)[(size_t)m * D + col]);
    chk_acc(a.ws, 10, (f - e) * (f - e), e * e);
}
__global__ void chk11(CArgs a) {
    const unsigned sid = blockIdx.x * blockDim.x + threadIdx.x; if (sid >= 4096) return; const unsigned r = hsh(sid + 111u);
    const int m = r % T, b = m / SEQ; const bf16* mx = CW(bf16, WS_MIXED) + (size_t)m * D; const float* mod = CW(float, WS_MOD) + b * 6144; const float* x = a.in[0] + (size_t)m * D;
    float ss = 0.f; for (int k = 0; k < D; ++k) ss += bf2f(mx[k]) * bf2f(mx[k]); const float rstd = 1.f / sqrtf(ss / D + RMS_EPS);
    float s2 = 0.f; for (int k = 0; k < D; ++k) { const float v = x[k] + mod[2048 + k] * (bf2f(mx[k]) * rstd * a.in[5][k]); s2 += v * v; } const float rstd2 = 1.f / sqrtf(s2 / D + RMS_EPS);
    float num = 0.f, den = 0.f;
    for (int q = 0; q < 8; ++q) { const int col = ((r >> 15) * 8 + q) & 1023; const float x1 = x[col] + mod[2048 + col] * (bf2f(mx[col]) * rstd * a.in[5][col]);
        const float f1 = a.out[(size_t)m * D + col]; num += (f1 - x1) * (f1 - x1); den += x1 * x1;
        const float e2 = x1 * rstd2 * a.in[6][col] * (1.f + mod[4096 + col]) + mod[3072 + col], f2 = bf2f(CW(bf16, WS_H)[(size_t)m * D + col]); num += (f2 - e2) * (f2 - e2); den += e2 * e2; }
    chk_acc(a.ws, 11, num, den);
}
__global__ void chk12(CArgs a) {
    const unsigned sid = blockIdx.x * blockDim.x + threadIdx.x; const unsigned r = hsh(sid + 121u); const int m = r % T, col = (r >> 15) & 255;
    const float e = c_dot_bf(CW(bf16, WS_H) + (size_t)m * D, CW(bf16, WS_WRT) + (size_t)col * D, D), f = CW(float, WS_LOG)[(size_t)m * NE + col];
    chk_acc(a.ws, 12, (f - e) * (f - e), e * e);
}
__global__ void chk13(CArgs a) {
    const unsigned sid = blockIdx.x * blockDim.x + threadIdx.x; if (sid >= 8192) return; const int t = hsh(sid + 131u) % T; const float* lg = CW(float, WS_LOG) + (size_t)t * NE;
    float gsc[8]; for (int g = 0; g < 8; ++g) { float m1 = -INFINITY, m2 = -INFINITY; for (int j = 0; j < 32; ++j) { const float v = 1.f / (1.f + expf(-lg[g * 32 + j])) + a.in[21][g * 32 + j]; if (v > m1) { m2 = m1; m1 = v; } else if (v > m2) m2 = v; } gsc[g] = m1 + m2; }
    unsigned gm = 0; for (int g = 0; g < 8; ++g) { int rank = 0; for (int j = 0; j < 8; ++j) rank += (gsc[j] > gsc[g] || (gsc[j] == gsc[g] && j < g)); if (rank < 4) gm |= 1u << g; }
    int idx[8]; float sc[8]; unsigned long long taken[4] = {0, 0, 0, 0}; float wsum = 0.f;
    for (int k = 0; k < 8; ++k) { float bv = -INFINITY; int bi = -1; for (int e = 0; e < 256; ++e) { if (!((gm >> (e >> 5)) & 1u) || ((taken[e >> 6] >> (e & 63)) & 1ull)) continue; const float v = 1.f / (1.f + expf(-lg[e])) + a.in[21][e]; if (v > bv) { bv = v; bi = e; } }
        idx[k] = bi; sc[k] = 1.f / (1.f + expf(-lg[bi])); wsum += sc[k]; taken[bi >> 6] |= 1ull << (bi & 63); }
    float num = 0.f, den = 8.f;
    for (int k = 0; k < 8; ++k) { if (CW(int, WS_TOPI)[t * 8 + k] != idx[k]) num += 1.f; const float e = sc[k] / wsum * 2.5f, f = CW(float, WS_TOPW)[t * 8 + k]; if (fabsf(e - f) > 1e-4f) num += 1.f; }
    chk_acc(a.ws, 13, num, den);
}
__global__ void chk14(CArgs a) {
    const unsigned sid = blockIdx.x * blockDim.x + threadIdx.x; const unsigned* ctl = (const unsigned*)(a.ws + WS_CTL); const int ntiles = (int)ctl[CW_NTILES], basesh = (int)ctl[CW_BASESH];
    float num = 0.f, den = 1.f;
    { const int t = sid % T, k = (sid / T) & 7; const int pos = CW(int, WS_TOKPOS)[t * 8 + k]; if (pos < T || pos >= ntiles * 256) num += 1.f; else { if (CW(int, WS_ROWTOK)[pos] != t) num += 1.f; if (CW(int, WS_TILEE)[pos >> 8] != CW(int, WS_TOPI)[t * 8 + k]) num += 1.f; } }
    for (int r = T + sid; r < ntiles * 256; r += gridDim.x * blockDim.x) { const int tk = CW(int, WS_ROWTOK)[r]; if (tk < 0 || tk >= T) num += 1.f; }
    if (sid == 0) { if (ntiles > MAXTILES || ntiles < T / 256 + 1024 || basesh != 0) num += 100.f; for (int t = 0; t < T / 256; ++t) if (CW(int, WS_TILEE)[t] != NE) num += 1.f; }
    chk_acc(a.ws, 14, num, den);
}
__global__ void chk15(CArgs a) {
    const unsigned sid = blockIdx.x * blockDim.x + threadIdx.x; const unsigned r = hsh(sid + 151u); const unsigned* ctl = (const unsigned*)(a.ws + WS_CTL); const int ntiles = (int)ctl[CW_NTILES];
    const int row = r % (ntiles * 256), j = (r >> 20) & 255, e_ = CW(int, WS_TILEE)[row >> 8], tok = row < T ? row : CW(int, WS_ROWTOK)[row];
    const float* w = (e_ < NE) ? a.in[22] + (size_t)e_ * 1024 * 512 : a.in[24]; const bf16* h = CW(bf16, WS_H) + (size_t)tok * D; float s1 = 0.f, s2 = 0.f;
    for (int k = 0; k < D; ++k) { const float hv = bf2f(h[k]); s1 += hv * bfr(w[(size_t)k * 512 + j]); s2 += hv * bfr(w[(size_t)k * 512 + 256 + j]); }
    const float e = siluf_(s1) * s2, f = bf2f(CW(bf16, WS_HB)[(size_t)row * EH + j]); chk_acc(a.ws, 15, (f - e) * (f - e), e * e);
}
__global__ void chk16(CArgs a) {
    const unsigned sid = blockIdx.x * blockDim.x + threadIdx.x; const unsigned r = hsh(sid + 161u); const unsigned* ctl = (const unsigned*)(a.ws + WS_CTL); const int ntiles = (int)ctl[CW_NTILES];
    const int row = r % (ntiles * 256), col = (r >> 20) & 1023, e_ = CW(int, WS_TILEE)[row >> 8];
    const float* w = (e_ < NE) ? a.in[23] + (size_t)e_ * 256 * 1024 : a.in[25]; const bf16* h = CW(bf16, WS_HB) + (size_t)row * EH; float s = 0.f;
    for (int k = 0; k < EH; ++k) s += bf2f(h[k]) * bfr(w[(size_t)k * 1024 + col]);
    const int nv = CW(int, WS_TILEV)[row >> 8]; if ((row & 255) >= nv) { chk_acc(a.ws, 16, 0.f, 0.f); return; }
    const unsigned wv = CW(unsigned, WS_YB)[((size_t)row * D + col) >> 2]; const int bs = col & 3;
    const float f = (bs == 0 ? __builtin_amdgcn_cvt_f32_fp8((int)wv, 0) : bs == 1 ? __builtin_amdgcn_cvt_f32_fp8((int)wv, 1) : bs == 2 ? __builtin_amdgcn_cvt_f32_fp8((int)wv, 2) : __builtin_amdgcn_cvt_f32_fp8((int)wv, 3)) * (1.f / YB_SCALE);
    chk_acc(a.ws, 16, (f - s) * (f - s), s * s);
}
__global__ void chk_verdict(CArgs a) {
    const float* e = (const float*)(a.ws + WS_CTL) + CW_ERR; const unsigned* ctl = (const unsigned*)(a.ws + WS_CTL); int bad = -1;
    for (int k = 0; k < 17; ++k) { const float num = e[2 * k], den = e[2 * k + 1]; if (k == 8) continue; const float tol = (k == 16 || k == 3 || k == 5) ? 1e-2f : 2e-3f; if (!(num <= tol * den) || !(den > 0.f)) { bad = k; break; } }
    if (ctl[CW_BAR + XB_TMO]) bad = 27;
    if (bad < 0) return; const float al = 3.f + bad;
    for (size_t i = (size_t)blockIdx.x * blockDim.x + threadIdx.x; i < (size_t)T * D; i += (size_t)gridDim.x * blockDim.x) a.out[i] = al * a.in[0][i];
}
#endif
#if EMIT_AFTER >= 0
__global__ void emit_k(CArgs a, int k) {
    const unsigned* ctl = (const unsigned*)(a.ws + WS_CTL);
    for (size_t i = (size_t)blockIdx.x * blockDim.x + threadIdx.x; i < (size_t)T * D; i += (size_t)gridDim.x * blockDim.x) {
        const int t = (int)(i >> 10), c = (int)(i & 1023); float v = 0.f;
        if (k == 1) v = bf2f(CW(bf16, WS_H)[i]) + CW(float, WS_MOD)[(t & 3) * 6144 + c] + bf2f(CW(bf16, WS_WINT)[(size_t)(t % NPROJ) * 1024 + c]) + bf2f(CW(bf16, WS_W13T)[(size_t)t * 4009 * 1024 % ((size_t)NEX * 512 * 1024) + c]);
        if (k == 2) { for (int q = 0; q < 7; ++q) v += bf2f(CW(bf16, WS_PROJ)[(size_t)t * PW + q * 1024 + c]); if ((c & 63) < 48) v += CW(float, WS_DT)[(size_t)t * 64 + (c & 63)]; }
        if (k == 20) v = bf2f(CW(bf16, WS_PROJ)[(size_t)t * PW + PC_FR + c]);
        if (k == 21) v = bf2f(CW(bf16, WS_WINT)[(size_t)(PC_FR + (t & 1023)) * 1024 + c]) + bf2f(CW(bf16, WS_WM1)[(i & 16383)]) + CW(f32x2, WS_TW)[i & 8191].x + CW(f32x2, WS_TW)[i & 8191].y;
        if (k == 3) { v = bf2f(CW(bf16, WS_ST)[i]) + bf2f(CW(bf16, WS_ST)[i + (size_t)T * D]) + bf2f(CW(bf16, WS_ST)[i + 2 * (size_t)T * D]); }
        if (k == 5) { v = bf2f(CW(bf16, WS_ST)[i]) + bf2f(CW(bf16, WS_ST)[i + (size_t)T * D]) + bf2f(CW(bf16, WS_ST)[i + 2 * (size_t)T * D]); }
        if (k == 4) v = a.in[0][i] + 1000.f * (bf2f(CW(bf16, WS_GB)[i]) - bf2f(CW(bf16, WS_MIX)[i]));
        if (k == 6) v = bf2f(CW(bf16, WS_GB)[i]) + bf2f(CW(bf16, WS_FO)[(size_t)t * 512 + (c & 511)]);
        if (k == 7) v = bf2f(CW(bf16, WS_YN)[(size_t)t * INNER + c]) + bf2f(CW(bf16, WS_YN)[(size_t)t * INNER + 512 + c]);
        if (k == 9) v = bf2f(CW(bf16, WS_MIX)[i]);
        if (k == 10) v = bf2f(CW(bf16, WS_MIXED)[i]);
        if (k == 12) v = CW(float, WS_LOG)[(size_t)t * 256 + (c & 255)] + bf2f(CW(bf16, WS_H)[i]) + a.out[i];
        if (k == 13) v = (float)CW(int, WS_TOPI)[t * 8 + (c & 7)] + CW(float, WS_TOPW)[t * 8 + (c & 7)];
        if (k == 15) { for (int q = 0; q < 8; ++q) v += bf2f(CW(bf16, WS_HB)[(size_t)CW(int, WS_TOKPOS)[t * 8 + q] * EH + (c & 255)]); v += bf2f(CW(bf16, WS_HB)[(size_t)(ctl[CW_BASESH] + t) * EH + (c & 255)]); }
        if (k == 16) { for (int q = 0; q < 8; ++q) v += CW(float, WS_TOPW)[t * 8 + q] * bf2f(CW(bf16, WS_YB)[(size_t)CW(int, WS_TOKPOS)[t * 8 + q] * D + c]); v += bf2f(CW(bf16, WS_YB)[(size_t)(ctl[CW_BASESH] + t) * D + c]); }
        a.out[i] = v;
    }
}
#endif
template <int K> static void launch_phase(const Args& a, int grid, hipStream_t stream) {
    static bool attr = false;
    if (!attr) { (void)hipFuncSetAttribute((const void*)fwd<K, K + 1>, hipFuncAttributeMaxDynamicSharedMemorySize, LDS_BYTES); attr = true; }
    hipLaunchKernelGGL((fwd<K, K + 1>), dim3(grid), dim3(NTHR), LDS_BYTES, stream, a);
}
extern "C" void kernel_launch(void* const* d_in, const int* in_sizes, int n_in, void* d_out, int out_size, void* d_ws, size_t ws_size, hipStream_t stream) {
    static int grid = 0;
    if (grid == 0) {
        if (n_in != 26 || out_size != T * D || ws_size < WS_END) { fprintf(stderr, "kernel_launch: unexpected shapes (n_in %d, out %d, ws %zu < %zu)\n", n_in, out_size, ws_size, (size_t)WS_END); grid = -1; return; }
        int dev = 0, cus = 0;
        if (hipGetDevice(&dev) != hipSuccess || hipDeviceGetAttribute(&cus, hipDeviceAttributeMultiprocessorCount, dev) != hipSuccess) { grid = -1; return; }
#if !MULTI_LAUNCH
        if (hipFuncSetAttribute((const void*)fwd<0, NPH>, hipFuncAttributeMaxDynamicSharedMemorySize, LDS_BYTES) != hipSuccess) { fprintf(stderr, "kernel_launch: hipFuncSetAttribute failed\n"); grid = -1; return; }
        int per_cu = 0; (void)hipOccupancyMaxActiveBlocksPerMultiprocessor(&per_cu, (const void*)fwd<0, NPH>, NTHR, LDS_BYTES); (void)hipGetLastError();
        if (per_cu < 1) fprintf(stderr, "kernel_launch: note: occupancy query reports %d\n", per_cu);
#endif
        grid = cus;
    }
    if (grid < 0) return;
    (void)hipMemsetAsync((char*)d_ws + WS_CTL, 0, CTL_ZERO_BYTES, stream);
    Args a{};
    for (int i = 0; i < 26; ++i) a.in[i] = (const float*)d_in[i];
    a.out = (float*)d_out; a.ws = (unsigned char*)d_ws;
#if MULTI_LAUNCH
#if DEV_CHECKS
    CArgs ca{}; for (int i = 0; i < 26; ++i) ca.in[i] = a.in[i]; ca.out = a.out; ca.ws = a.ws;
#define CHK(k, g, b) hipLaunchKernelGGL(chk##k, dim3(g), dim3(b), 0, stream, ca)
#else
#define CHK(k, g, b) do {} while (0)
#endif
#if PRE_K >= 0
    { launch_phase<0>(a, grid, stream);
      if (PRE_K >= 1) launch_phase<1>(a, grid, stream);
      if (PRE_K >= 2) launch_phase<2>(a, grid, stream);
      if (PRE_K >= 3) launch_phase<3>(a, grid, stream);
      if (PRE_K >= 4) launch_phase<4>(a, grid, stream);
      if (PRE_K >= 5) launch_phase<5>(a, grid, stream);
      if (PRE_K >= 6) launch_phase<6>(a, grid, stream);
      if (PRE_K >= 7) launch_phase<7>(a, grid, stream);
      if (PRE_K >= 8) launch_phase<8>(a, grid, stream);
      if (PRE_K >= 9) launch_phase<9>(a, grid, stream);
      if (PRE_K >= 10) launch_phase<10>(a, grid, stream);
      if (PRE_K >= 11) launch_phase<11>(a, grid, stream);
      if (PRE_K >= 12) launch_phase<12>(a, grid, stream);
      if (PRE_K >= 13) launch_phase<13>(a, grid, stream);
      if (PRE_K >= 14) launch_phase<14>(a, grid, stream);
      if (PRE_K >= 15) launch_phase<15>(a, grid, stream);
      if (PRE_K >= 16) launch_phase<16>(a, grid, stream); }
#endif
    launch_phase<0>(a, grid, stream); CHK(0, 256, 256);
#if (DUP_MASK >> 0) & 1
    launch_phase<0>(a, grid, stream);
#endif
#if EMIT_AFTER == 0
    { CArgs ce{}; for (int i = 0; i < 26; ++i) ce.in[i] = a.in[i]; ce.out = a.out; ce.ws = a.ws; hipLaunchKernelGGL(emit_k, dim3(2048), dim3(256), 0, stream, ce, 0); return; }
#endif
    launch_phase<1>(a, grid, stream); CHK(1, 16, 256);
#if (DUP_MASK >> 1) & 1
    launch_phase<1>(a, grid, stream);
#endif
#if EMIT_AFTER == 1
    { CArgs ce{}; for (int i = 0; i < 26; ++i) ce.in[i] = a.in[i]; ce.out = a.out; ce.ws = a.ws; hipLaunchKernelGGL(emit_k, dim3(2048), dim3(256), 0, stream, ce, 1); return; }
#endif
    launch_phase<2>(a, grid, stream); CHK(2, 256, 256);
#if (DUP_MASK >> 2) & 1
    launch_phase<2>(a, grid, stream);
#endif
#if EMIT_AFTER == 20 || EMIT_AFTER == 21
    { CArgs ce{}; for (int i = 0; i < 26; ++i) ce.in[i] = a.in[i]; ce.out = a.out; ce.ws = a.ws; hipLaunchKernelGGL(emit_k, dim3(2048), dim3(256), 0, stream, ce, EMIT_AFTER); return; }
#endif
#if EMIT_AFTER == 2
    { CArgs ce{}; for (int i = 0; i < 26; ++i) ce.in[i] = a.in[i]; ce.out = a.out; ce.ws = a.ws; hipLaunchKernelGGL(emit_k, dim3(2048), dim3(256), 0, stream, ce, 2); return; }
#endif
#if EMIT_AFTER != 4
    launch_phase<3>(a, grid, stream); CHK(3, 32, 256);
#if (DUP_MASK >> 3) & 1
    launch_phase<3>(a, grid, stream);
#endif
#endif
#if EMIT_AFTER == 3
    { CArgs ce{}; for (int i = 0; i < 26; ++i) ce.in[i] = a.in[i]; ce.out = a.out; ce.ws = a.ws; hipLaunchKernelGGL(emit_k, dim3(2048), dim3(256), 0, stream, ce, 3); return; }
#endif
    launch_phase<4>(a, grid, stream); CHK(4, 256, 256);
#if (DUP_MASK >> 4) & 1
    launch_phase<4>(a, grid, stream);
#endif
#if EMIT_AFTER == 4
    (void)hipMemcpyAsync((char*)d_ws + WS_MIX, (char*)d_ws + WS_GB, (size_t)T * D * 2, hipMemcpyDeviceToDevice, stream); launch_phase<4>(a, grid, stream);
    { CArgs ce{}; for (int i = 0; i < 26; ++i) ce.in[i] = a.in[i]; ce.out = a.out; ce.ws = a.ws; hipLaunchKernelGGL(emit_k, dim3(2048), dim3(256), 0, stream, ce, 4); return; }
#endif
    launch_phase<5>(a, grid, stream); CHK(5, 32, 256);
#if (DUP_MASK >> 5) & 1
    launch_phase<5>(a, grid, stream);
#endif
#if EMIT_AFTER == 5
    { CArgs ce{}; for (int i = 0; i < 26; ++i) ce.in[i] = a.in[i]; ce.out = a.out; ce.ws = a.ws; hipLaunchKernelGGL(emit_k, dim3(2048), dim3(256), 0, stream, ce, 5); return; }
#endif
    launch_phase<6>(a, grid, stream); CHK(6, 256, 256);
#if (DUP_MASK >> 6) & 1
    launch_phase<6>(a, grid, stream);
#endif
#if EMIT_AFTER == 6
    { CArgs ce{}; for (int i = 0; i < 26; ++i) ce.in[i] = a.in[i]; ce.out = a.out; ce.ws = a.ws; hipLaunchKernelGGL(emit_k, dim3(2048), dim3(256), 0, stream, ce, 6); return; }
#endif
    launch_phase<7>(a, grid, stream); CHK(7, 256, 384);
#if (DUP_MASK >> 7) & 1
    launch_phase<7>(a, grid, stream);
#endif
#if EMIT_AFTER == 7
    { CArgs ce{}; for (int i = 0; i < 26; ++i) ce.in[i] = a.in[i]; ce.out = a.out; ce.ws = a.ws; hipLaunchKernelGGL(emit_k, dim3(2048), dim3(256), 0, stream, ce, 7); return; }
#endif
    launch_phase<8>(a, grid, stream);
#if (DUP_MASK >> 8) & 1
    launch_phase<8>(a, grid, stream);
#endif
#if EMIT_AFTER == 8
    { CArgs ce{}; for (int i = 0; i < 26; ++i) ce.in[i] = a.in[i]; ce.out = a.out; ce.ws = a.ws; hipLaunchKernelGGL(emit_k, dim3(2048), dim3(256), 0, stream, ce, 8); return; }
#endif
    launch_phase<9>(a, grid, stream); CHK(9, 256, 256);
#if (DUP_MASK >> 9) & 1
    launch_phase<9>(a, grid, stream);
#endif
#if EMIT_AFTER == 9
    { CArgs ce{}; for (int i = 0; i < 26; ++i) ce.in[i] = a.in[i]; ce.out = a.out; ce.ws = a.ws; hipLaunchKernelGGL(emit_k, dim3(2048), dim3(256), 0, stream, ce, 9); return; }
#endif
    launch_phase<10>(a, grid, stream); CHK(10, 256, 256);
#if (DUP_MASK >> 10) & 1
    launch_phase<10>(a, grid, stream);
#endif
#if EMIT_AFTER == 10
    { CArgs ce{}; for (int i = 0; i < 26; ++i) ce.in[i] = a.in[i]; ce.out = a.out; ce.ws = a.ws; hipLaunchKernelGGL(emit_k, dim3(2048), dim3(256), 0, stream, ce, 10); return; }
#endif
    launch_phase<11>(a, grid, stream); CHK(11, 16, 256);
#if (DUP_MASK >> 11) & 1
    launch_phase<11>(a, grid, stream);
#endif
#if EMIT_AFTER == 11
    { CArgs ce{}; for (int i = 0; i < 26; ++i) ce.in[i] = a.in[i]; ce.out = a.out; ce.ws = a.ws; hipLaunchKernelGGL(emit_k, dim3(2048), dim3(256), 0, stream, ce, 11); return; }
#endif
    launch_phase<12>(a, grid, stream); CHK(12, 256, 256);
#if (DUP_MASK >> 12) & 1
    launch_phase<12>(a, grid, stream);
#endif
#if EMIT_AFTER == 12
    { CArgs ce{}; for (int i = 0; i < 26; ++i) ce.in[i] = a.in[i]; ce.out = a.out; ce.ws = a.ws; hipLaunchKernelGGL(emit_k, dim3(2048), dim3(256), 0, stream, ce, 12); return; }
#endif
    launch_phase<13>(a, grid, stream); CHK(13, 32, 256);
#if (DUP_MASK >> 13) & 1
    launch_phase<13>(a, grid, stream);
#endif
#if EMIT_AFTER == 13
    { CArgs ce{}; for (int i = 0; i < 26; ++i) ce.in[i] = a.in[i]; ce.out = a.out; ce.ws = a.ws; hipLaunchKernelGGL(emit_k, dim3(2048), dim3(256), 0, stream, ce, 13); return; }
#endif
    launch_phase<14>(a, grid, stream); CHK(14, 1024, 256);
#if (DUP_MASK >> 14) & 1
    launch_phase<14>(a, grid, stream);
#endif
#if EMIT_AFTER == 14
    { CArgs ce{}; for (int i = 0; i < 26; ++i) ce.in[i] = a.in[i]; ce.out = a.out; ce.ws = a.ws; hipLaunchKernelGGL(emit_k, dim3(2048), dim3(256), 0, stream, ce, 14); return; }
#endif
    launch_phase<15>(a, grid, stream); CHK(15, 256, 256);
#if (DUP_MASK >> 15) & 1
    launch_phase<15>(a, grid, stream);
#endif
#if EMIT_AFTER == 15
    { CArgs ce{}; for (int i = 0; i < 26; ++i) ce.in[i] = a.in[i]; ce.out = a.out; ce.ws = a.ws; hipLaunchKernelGGL(emit_k, dim3(2048), dim3(256), 0, stream, ce, 15); return; }
#endif
    launch_phase<16>(a, grid, stream); CHK(16, 256, 256);
#if (DUP_MASK >> 16) & 1
    launch_phase<16>(a, grid, stream);
#endif
#if EMIT_AFTER == 16
    { CArgs ce{}; for (int i = 0; i < 26; ++i) ce.in[i] = a.in[i]; ce.out = a.out; ce.ws = a.ws; hipLaunchKernelGGL(emit_k, dim3(2048), dim3(256), 0, stream, ce, 16); return; }
#endif
    launch_phase<17>(a, grid, stream);
#if (DUP_MASK >> 17) & 1
    launch_phase<17>(a, grid, stream);
#endif
#if EMIT_AFTER == 17
    { CArgs ce{}; for (int i = 0; i < 26; ++i) ce.in[i] = a.in[i]; ce.out = a.out; ce.ws = a.ws; hipLaunchKernelGGL(emit_k, dim3(2048), dim3(256), 0, stream, ce, 17); return; }
#endif
#if DEV_CHECKS
    hipLaunchKernelGGL(chk_verdict, dim3(1024), dim3(256), 0, stream, ca);
#endif
#else
    hipLaunchKernelGGL((fwd<0, NPH>), dim3(grid), dim3(NTHR), LDS_BYTES, stream, a);
#endif
}
```

```cpp
#include <hip/hip_runtime.h>
#include <cstdio>
#include <cstdint>
#include <cmath>
#define MULTI_LAUNCH 0
#define DEV_CHECKS 0
#define EMIT_AFTER -1
#define DFT_DEBUG 0
#define KSTART_INV 0
#define DUP_MASK 0
#define TIMING 0
#define TA_LO 0
#define TA_HI 0
#define TB_LO 0
#define TB_HI 0
#define PRE_K -1
namespace pg8 {
#define PG8_LAS __attribute__((address_space(3)))
typedef unsigned short bf16_t;
typedef short bf16x8 __attribute__((ext_vector_type(8)));
typedef float f32x4 __attribute__((ext_vector_type(4)));
typedef unsigned u32x4 __attribute__((ext_vector_type(4)));
typedef unsigned u32x2 __attribute__((ext_vector_type(2)));
constexpr int BM = 256, BK = 64, HALF = 128, HTB = HALF * BK * 2  , STAGE_BYTES = 8 * HTB, NXCD = 8, WGM = 8;

__host__ __device__ __forceinline__ int lds_byte(int r, int c) { const int st = (r >> 4) * 2 + (c >> 5), rr = r & 15, cc = c & 31, ob = rr * 64 + cc * 2; return st * 1024 + (ob ^ (((ob >> 9) & 1) << 5)); }
__host__ __device__ __forceinline__ void stage_rc(int b, int& R, int& C) { const int st = b / 1024, sb = b % 1024, swz = sb ^ (((sb >> 9) & 1) << 5); R = (st >> 1) * 16 + swz / 64; C = (st & 1) * 32 + (swz % 64) / 2; }
__host__ __device__ __forceinline__ int perm32(int rho) { const int n = rho >> 4, i = rho & 15; return 8 * (i >> 2) + 4 * n + (i & 3); }

struct Unit { int pm, pn; };
struct Gemm { const bf16_t* A; const bf16_t* Bt; int M, N, K; const int* rowtok; };

struct StaticOrder {
    int nM, nN, nwg, G, c;
    __host__ __device__ void init(int M, int N, int G_, int c_) { nM = M / BM; nN = N / BM; nwg = nM * nN; G = G_; c = c_; }
    __host__ __device__ bool next(int i, Unit& u) const {
        const long L = (long)i * G + c; if (L >= nwg) return false;
        int wgid = (int)L; { const int q = nwg / NXCD, r = nwg % NXCD, xcd = wgid % NXCD, off = wgid / NXCD; wgid = (xcd < r ? xcd * (q + 1) : r * (q + 1) + (xcd - r) * q) + off; }
        const int nig = WGM * nN, gid = wgid / nig, fm = gid * WGM, gsz = (nM - fm) < WGM ? (nM - fm) : WGM;
        u.pm = fm + ((wgid % nig) % gsz); u.pn = (wgid % nig) / gsz; return true;
    }
};
template <int NJ> struct GroupedOrder {
    const PG8_LAS int* tile_e; int ntiles, G, c, t0;
    __device__ bool next(int i, Unit& u) const {
        int t, j;
        if ((G & 7) == 0 && ((G >> 3) % NJ) == 0) { const int x = c & 7, slot = c >> 3, tpx = (G >> 3) / NJ; t = (i * 8 + x) * tpx + slot / NJ; j = slot % NJ; }
        else { const int L = i * G + c; t = L / NJ; j = L % NJ; }
        t += t0; if (t >= ntiles) return false;
        u.pm = t; u.pn = __builtin_amdgcn_readfirstlane(tile_e[t]) * NJ + j; return true;
    }
};

struct SharedOrder {
    int nt, e, c0, nb, c;
    __device__ bool next(int i, Unit& u) const { const int L = i * nb + (c - c0); if (c < c0 || L >= nt * 2) return false; u.pm = L >> 1; u.pn = e * 2 + (L & 1); return true; }
};
__device__ __forceinline__ unsigned cvt_pk_bf16(float lo, float hi) { unsigned r; asm volatile("v_cvt_pk_bf16_f32 %0, %1, %2" : "=v"(r) : "v"(lo), "v"(hi)); return r; }
__device__ __forceinline__ float bf_lo(unsigned w) { return __uint_as_float(w << 16); }
__device__ __forceinline__ float bf_hi(unsigned w) { return __uint_as_float(w & 0xffff0000u); }
__device__ __forceinline__ float sigmoidf_(float x) { return __builtin_amdgcn_rcpf(1.f + __expf(-x)); }

struct EpiF32 {
    static constexpr bool PERM = false;
    float* C; int ldc;
    __device__ __forceinline__ void operator()(const f32x4 (&acc)[2][2][4][2], const Unit& u, int wr, int wc, int fr, int fq) const {
        const int row0 = u.pm * BM + wr * 64 + fr, col0 = u.pn * BM + wc * 32 + 4 * fq;
#pragma unroll
        for (int ai = 0; ai < 2; ++ai)
#pragma unroll
            for (int m = 0; m < 4; ++m) { float* rowp = C + (size_t)(row0 + ai * HALF + m * 16) * ldc + col0;
#pragma unroll
                for (int bj = 0; bj < 2; ++bj)
#pragma unroll
                    for (int n = 0; n < 2; ++n) *(f32x4*)(rowp + bj * HALF + n * 16) = acc[ai][bj][m][n]; }
    }
};
template <int NCOLT> struct EpiBf16 {
    static constexpr bool PERM = true;
    bf16_t* O; int ldc;
    __device__ __forceinline__ void operator()(const f32x4 (&acc)[2][2][4][2], const Unit& u, int wr, int wc, int fr, int fq) const {
        const int row0 = u.pm * BM + wr * 64 + fr; const int col0 = (u.pn & (NCOLT - 1)) * BM + wc * 32 + 8 * fq;
#pragma unroll
        for (int ai = 0; ai < 2; ++ai)
#pragma unroll
            for (int m = 0; m < 4; ++m) { bf16_t* rowp = O + (size_t)(row0 + ai * HALF + m * 16) * ldc + col0;
#pragma unroll
                for (int bj = 0; bj < 2; ++bj) { const f32x4 v0 = acc[ai][bj][m][0], v1 = acc[ai][bj][m][1];
                    u32x4 w; w.x = cvt_pk_bf16(v0[0], v0[1]); w.y = cvt_pk_bf16(v0[2], v0[3]); w.z = cvt_pk_bf16(v1[0], v1[1]); w.w = cvt_pk_bf16(v1[2], v1[3]);
                    *(u32x4*)(rowp + bj * HALF) = w; } }
    }
};
template <int NCOLT> struct EpiFp8 {
    static constexpr bool PERM = true;
    unsigned char* O; int ldc; const PG8_LAS int* valid; float scale;
    __device__ __forceinline__ void operator()(const f32x4 (&acc)[2][2][4][2], const Unit& u, int wr, int wc, int fr, int fq) const {
        const int rl0 = wr * 64 + fr, nv = valid[u.pm]; const int col0 = (u.pn & (NCOLT - 1)) * BM + wc * 32 + 8 * fq;
#pragma unroll
        for (int ai = 0; ai < 2; ++ai)
#pragma unroll
            for (int m = 0; m < 4; ++m) { const int rl = rl0 + ai * HALF + m * 16; if (rl < nv) { unsigned char* rowp = O + (size_t)(u.pm * BM + rl) * ldc + col0;
#pragma unroll
                for (int bj = 0; bj < 2; ++bj) { const f32x4 v0 = acc[ai][bj][m][0] * scale, v1 = acc[ai][bj][m][1] * scale;
                    int w0 = __builtin_amdgcn_cvt_pk_fp8_f32(v0[0], v0[1], 0, false); w0 = __builtin_amdgcn_cvt_pk_fp8_f32(v0[2], v0[3], w0, true);
                    int w1 = __builtin_amdgcn_cvt_pk_fp8_f32(v1[0], v1[1], 0, false); w1 = __builtin_amdgcn_cvt_pk_fp8_f32(v1[2], v1[3], w1, true);
                    u32x2 w; w.x = (unsigned)w0; w.y = (unsigned)w1; *(u32x2*)(rowp + bj * HALF) = w; } } }
    }
};
struct EpiProj {
    static constexpr bool PERM = true;
    bf16_t* O; int ldc; float* DT; int sig0, ndat;
    __device__ __forceinline__ void operator()(const f32x4 (&acc)[2][2][4][2], const Unit& u, int wr, int wc, int fr, int fq) const {
        const int row0 = u.pm * BM + wr * 64 + fr;
        if (u.pn < ndat) {
            const int col0 = u.pn * BM + wc * 32 + 8 * fq; const bool sg = u.pn >= sig0;
#pragma unroll
            for (int ai = 0; ai < 2; ++ai)
#pragma unroll
                for (int m = 0; m < 4; ++m) { bf16_t* rowp = O + (size_t)(row0 + ai * HALF + m * 16) * ldc + col0;
#pragma unroll
                    for (int bj = 0; bj < 2; ++bj) { f32x4 v0 = acc[ai][bj][m][0], v1 = acc[ai][bj][m][1];
                        if (sg) {
#pragma unroll
                            for (int j = 0; j < 4; ++j) { v0[j] = sigmoidf_(v0[j]); v1[j] = sigmoidf_(v1[j]); } }
                        u32x4 w; w.x = cvt_pk_bf16(v0[0], v0[1]); w.y = cvt_pk_bf16(v0[2], v0[3]); w.z = cvt_pk_bf16(v1[0], v1[1]); w.w = cvt_pk_bf16(v1[2], v1[3]);
                        *(u32x4*)(rowp + bj * HALF) = w; } }
        } else {
            const int c0 = wc * 32 + 8 * fq;
            if (c0 + 7 < 48) {
#pragma unroll
                for (int ai = 0; ai < 2; ++ai)
#pragma unroll
                    for (int m = 0; m < 4; ++m) { float* rowp = DT + (size_t)(row0 + ai * HALF + m * 16) * 64 + c0;
                        *(f32x4*)(rowp) = acc[ai][0][m][0]; *(f32x4*)(rowp + 4) = acc[ai][0][m][1]; }
            }
        }
    }
};
template <bool ADD> struct EpiGate {
    static constexpr bool PERM = true;
    bf16_t* O; int ldc; const bf16_t* G; int ldg; int gcol0;
    __device__ __forceinline__ void operator()(const f32x4 (&acc)[2][2][4][2], const Unit& u, int wr, int wc, int fr, int fq) const {
        const int row0 = u.pm * BM + wr * 64 + fr; const int col0 = u.pn * BM + wc * 32 + 8 * fq;
#pragma unroll
        for (int ai = 0; ai < 2; ++ai)
#pragma unroll
            for (int m = 0; m < 4; ++m) { const size_t r = (size_t)(row0 + ai * HALF + m * 16); bf16_t* rowp = O + r * ldc + col0; const bf16_t* gp = G + r * ldg + gcol0 + col0;
#pragma unroll
                for (int bj = 0; bj < 2; ++bj) { const f32x4 v0 = acc[ai][bj][m][0], v1 = acc[ai][bj][m][1];
                    const u32x4 gw = *(const u32x4*)(gp + bj * HALF);
                    float o[8] = { v0[0] * bf_lo(gw.x), v0[1] * bf_hi(gw.x), v0[2] * bf_lo(gw.y), v0[3] * bf_hi(gw.y), v1[0] * bf_lo(gw.z), v1[1] * bf_hi(gw.z), v1[2] * bf_lo(gw.w), v1[3] * bf_hi(gw.w) };
                    if (ADD) { const u32x4 pw = *(const u32x4*)(rowp + bj * HALF);
                        o[0] += bf_lo(pw.x); o[1] += bf_hi(pw.x); o[2] += bf_lo(pw.y); o[3] += bf_hi(pw.y); o[4] += bf_lo(pw.z); o[5] += bf_hi(pw.z); o[6] += bf_lo(pw.w); o[7] += bf_hi(pw.w); }
                    u32x4 w; w.x = cvt_pk_bf16(o[0], o[1]); w.y = cvt_pk_bf16(o[2], o[3]); w.z = cvt_pk_bf16(o[4], o[5]); w.w = cvt_pk_bf16(o[6], o[7]);
                    *(u32x4*)(rowp + bj * HALF) = w; } }
    }
};
struct EpiSwiglu {
    static constexpr bool PERM = true;
    bf16_t* O; int ldc;
    __device__ __forceinline__ void operator()(const f32x4 (&acc)[2][2][4][2], const Unit& u, int wr, int wc, int fr, int fq) const {
        const int row0 = u.pm * BM + wr * 64 + fr; const int col0 = (u.pn & 1) * HALF + wc * 32 + 8 * fq;
#pragma unroll
        for (int ai = 0; ai < 2; ++ai)
#pragma unroll
            for (int m = 0; m < 4; ++m) { bf16_t* rowp = O + (size_t)(row0 + ai * HALF + m * 16) * ldc + col0;
                float o[8];
#pragma unroll
                for (int n = 0; n < 2; ++n)
#pragma unroll
                    for (int j = 0; j < 4; ++j) { const float a = acc[ai][0][m][n][j], gg = acc[ai][1][m][n][j]; o[4 * n + j] = a * sigmoidf_(a) * gg; }
                u32x4 w; w.x = cvt_pk_bf16(o[0], o[1]); w.y = cvt_pk_bf16(o[2], o[3]); w.z = cvt_pk_bf16(o[4], o[5]); w.w = cvt_pk_bf16(o[6], o[7]);
                *(u32x4*)(rowp) = w; }
    }
};

template <class Epi, class Sched, bool ALIGN_EPI, bool GATHER>
__device__ __forceinline__ void gemm_phase(PG8_LAS unsigned char* lds, const Gemm g, const Sched& S, const Epi& E) {
    int tid_ = threadIdx.x; asm volatile("" : "+v"(tid_));
    const int tid = tid_, wid = __builtin_amdgcn_readfirstlane(tid >> 6), lane = tid & 63, wr = wid >> 2, wc = wid & 3, fr = lane & 15, fq = lane >> 4;
    const int K = g.K, nt = K / BK;
    unsigned voffA[2], voffB[2];
#pragma unroll
    for (int i = 0; i < 2; ++i) { int R, C; stage_rc(tid * 16 + i * 8192, R, C); const int Rb = Epi::PERM ? ((R & ~31) + perm32(R & 31)) : R;
        voffA[i] = (unsigned)(R * K + C) * 2u; voffB[i] = (unsigned)(Rb * K + C) * 2u; }
    const size_t kstep = (size_t)(BK * 2);
    const size_t hstep = (size_t)HALF * K * 2;
    const size_t tstep = 2 * hstep;
    const unsigned rowB = (unsigned)K * 2u;
    const unsigned ldsw = (unsigned)wid * 1024u;
    const int aoff = lds_byte(wr * 64 + fr, fq * 8), boff = lds_byte(wc * 32 + fr, fq * 8);
#define PG8_SA(b, h) (((b) * 2 + (h)) * HTB)
#define PG8_SB(b, h) ((4 + (b) * 2 + (h)) * HTB)
#define PG8_STAGE(bufoff, gbase, voff) do { _Pragma("unroll") for (int _i = 0; _i < 2; ++_i) \
        __builtin_amdgcn_global_load_lds((const unsigned*)((const char*)(gbase) + (voff)[_i]), (PG8_LAS unsigned*)(lds + (bufoff) + ldsw + _i * 8192), 16, 0, 0); } while (0)
#define PG8_STAGE_A(bufoff, ptr_ng, offs, h, kb) do { _Pragma("unroll") for (int _i = 0; _i < 2; ++_i) { const char* _src; \
        if constexpr (GATHER) _src = (const char*)g.A + (size_t)(offs)[h][_i] + (size_t)(kb); else _src = (const char*)(ptr_ng) + voffA[_i]; \
        __builtin_amdgcn_global_load_lds((const unsigned*)_src, (PG8_LAS unsigned*)(lds + (bufoff) + ldsw + _i * 8192), 16, 0, 0); } } while (0)
#define PG8_LDA(dst, b, h) do { _Pragma("unroll") for (int m = 0; m < 4; ++m) _Pragma("unroll") for (int k = 0; k < 2; ++k) dst[m][k] = *(const PG8_LAS bf16x8*)(lds + PG8_SA(b, h) + aoff + m * 2048 + k * 1024); } while (0)
#define PG8_LDB(dst, b, h) do { _Pragma("unroll") for (int n = 0; n < 2; ++n) _Pragma("unroll") for (int k = 0; k < 2; ++k) dst[n][k] = *(const PG8_LAS bf16x8*)(lds + PG8_SB(b, h) + boff + n * 2048 + k * 1024); } while (0)
#define PG8_MMA(ai, bj, At, Bt) do { __builtin_amdgcn_s_setprio(1); _Pragma("unroll") for (int m = 0; m < 4; ++m) _Pragma("unroll") for (int n = 0; n < 2; ++n) _Pragma("unroll") for (int k = 0; k < 2; ++k) \
        acc[ai][bj][m][n] = __builtin_amdgcn_mfma_f32_16x16x32_bf16(Bt[n][k], At[m][k], acc[ai][bj][m][n], 0, 0, 0); __builtin_amdgcn_s_setprio(0); } while (0)
#define PG8_WAIT_V(n) asm volatile("s_waitcnt vmcnt(" #n ")" ::: "memory")
#define PG8_WAIT_L(n) asm volatile("s_waitcnt lgkmcnt(" #n ")" ::: "memory")
#define PG8_BAR __builtin_amdgcn_s_barrier()
#define PG8_SCHED __builtin_amdgcn_sched_barrier(0)
#define PG8_GOFFS(dst, unit) do { _Pragma("unroll") for (int _i = 0; _i < 2; ++_i) { int _R, _C; stage_rc(tid * 16 + _i * 8192, _R, _C); _Pragma("unroll") for (int _h = 0; _h < 2; ++_h) \
        dst[_h][_i] = (unsigned)g.rowtok[(unit).pm * BM + _h * HALF + _R] * rowB + (unsigned)_C * 2u; } } while (0)
    Unit cur, nxt; int ui = 0;
    if (!S.next(0, cur)) return;
    f32x4 acc[2][2][4][2];
#pragma unroll
    for (int a = 0; a < 2; ++a)
#pragma unroll
        for (int b = 0; b < 2; ++b)
#pragma unroll
            for (int m = 0; m < 4; ++m)
#pragma unroll
                for (int n = 0; n < 2; ++n) acc[a][b][m][n] = (f32x4){0.f, 0.f, 0.f, 0.f};
    bf16x8 At[4][2], B0[2][2], B1[2][2];
    unsigned co[2][2] = {{0u, 0u}, {0u, 0u}}, no[2][2] = {{0u, 0u}, {0u, 0u}};
    const char* cA = (const char*)g.A + (GATHER ? (size_t)0 : (size_t)cur.pm * tstep); const char* cB = (const char*)g.Bt + (size_t)cur.pn * tstep;
    if constexpr (GATHER) { PG8_GOFFS(co, cur); }
    PG8_STAGE(PG8_SB(0, 0), cB, voffB); PG8_STAGE(PG8_SB(0, 1), cB + hstep, voffB); PG8_STAGE_A(PG8_SA(0, 0), cA, co, 0, 0); PG8_STAGE_A(PG8_SA(0, 1), cA + hstep, co, 1, 0);
    if (wr == 1) PG8_BAR;
    PG8_WAIT_V(2); PG8_BAR;
    PG8_STAGE(PG8_SB(1, 0), cB + kstep, voffB); PG8_STAGE_A(PG8_SA(1, 0), cA + kstep, co, 0, kstep); PG8_STAGE(PG8_SB(1, 1), cB + hstep + kstep, voffB);
    PG8_WAIT_V(6); PG8_BAR;
    for (;;) {
        const bool has_next = S.next(ui + 1, nxt);
        const char* nA = (has_next && !GATHER) ? (const char*)g.A + (size_t)nxt.pm * tstep : cA; const char* nB = has_next ? (const char*)g.Bt + (size_t)nxt.pn * tstep : cB;
        if constexpr (GATHER) { if (has_next) { PG8_GOFFS(no, nxt); } else {
#pragma unroll
            for (int _h = 0; _h < 2; ++_h)
#pragma unroll
                for (int _i = 0; _i < 2; ++_i) no[_h][_i] = co[_h][_i]; } }
#pragma unroll 1
        for (int t = 0; t < nt; t += 2) {
            const bool last = (t == nt - 2);
            const char* a1 = cA + (size_t)(t + 1) * kstep;
            const char* a2 = last ? nA : cA + (size_t)(t + 2) * kstep; const char* b2 = last ? nB : cB + (size_t)(t + 2) * kstep;
            const char* a3 = a2 + kstep; const char* b3 = b2 + kstep;
            unsigned so[2][2];
#pragma unroll
            for (int _h = 0; _h < 2; ++_h)
#pragma unroll
                for (int _i = 0; _i < 2; ++_i) so[_h][_i] = last ? no[_h][_i] : co[_h][_i];
            const size_t kb1 = (size_t)(t + 1) * kstep, kb2 = last ? (size_t)0 : (size_t)(t + 2) * kstep, kb3 = kb2 + kstep;
            PG8_LDB(B0, 0, 0); PG8_LDB(B1, 0, 1); PG8_SCHED; PG8_LDA(At, 0, 0); PG8_STAGE_A(PG8_SA(1, 1), a1 + hstep, co, 1, kb1);
            PG8_WAIT_V(8); PG8_WAIT_L(0); PG8_BAR; PG8_MMA(0, 0, At, B0); PG8_MMA(0, 1, At, B1); PG8_BAR; PG8_SCHED;
            PG8_LDA(At, 0, 1); PG8_STAGE(PG8_SB(0, 0), b2, voffB); PG8_STAGE(PG8_SB(0, 1), b2 + hstep, voffB); PG8_STAGE_A(PG8_SA(0, 0), a2, so, 0, kb2);
            PG8_WAIT_V(8); PG8_WAIT_L(0); PG8_BAR; PG8_MMA(1, 0, At, B0); PG8_MMA(1, 1, At, B1); PG8_BAR; PG8_SCHED;
            PG8_LDB(B0, 1, 0); PG8_LDB(B1, 1, 1); PG8_SCHED; PG8_LDA(At, 1, 0); PG8_STAGE_A(PG8_SA(0, 1), a2 + hstep, so, 1, kb2);
            PG8_WAIT_V(8); PG8_WAIT_L(0); PG8_BAR; PG8_MMA(0, 0, At, B0); PG8_MMA(0, 1, At, B1); PG8_BAR; PG8_SCHED;
            PG8_LDA(At, 1, 1); PG8_STAGE(PG8_SB(1, 0), b3, voffB); PG8_STAGE(PG8_SB(1, 1), b3 + hstep, voffB); PG8_STAGE_A(PG8_SA(1, 0), a3, so, 0, kb3);
            PG8_WAIT_V(8); PG8_WAIT_L(0); PG8_BAR; PG8_MMA(1, 0, At, B0); PG8_MMA(1, 1, At, B1); PG8_BAR; PG8_SCHED;
        }
        if constexpr (ALIGN_EPI) { if (wr == 0) PG8_BAR; }
        PG8_SCHED; asm volatile("s_nop 15\n\ts_nop 15\n\ts_nop 15\n\ts_nop 15" ::: "memory"); PG8_SCHED;
        E(acc, cur, wr, wc, fr, fq);
        if (!has_next) break;
#pragma unroll
        for (int a = 0; a < 2; ++a)
#pragma unroll
            for (int b = 0; b < 2; ++b)
#pragma unroll
                for (int m = 0; m < 4; ++m)
#pragma unroll
                    for (int n = 0; n < 2; ++n) acc[a][b][m][n] = (f32x4){0.f, 0.f, 0.f, 0.f};
        cur = nxt; cA = nA; cB = nB; ++ui;
#pragma unroll
        for (int _h = 0; _h < 2; ++_h)
#pragma unroll
            for (int _i = 0; _i < 2; ++_i) co[_h][_i] = no[_h][_i];
        if constexpr (ALIGN_EPI) { if (wr == 1) PG8_BAR; }
    }
    PG8_WAIT_V(0);
    if constexpr (!ALIGN_EPI) { if (wr == 0) PG8_BAR; }
    PG8_BAR;
#undef PG8_SA
#undef PG8_SB
#undef PG8_STAGE
#undef PG8_STAGE_A
#undef PG8_LDA
#undef PG8_LDB
#undef PG8_MMA
#undef PG8_WAIT_V
#undef PG8_WAIT_L
#undef PG8_BAR
#undef PG8_SCHED
#undef PG8_GOFFS
}
}
constexpr int NWAVES = 8, NTHR = 512;
constexpr int NB = 4, SEQ = 8192, T = NB * SEQ, D = 1024;
constexpr int HEADS = 24, HD = 64, INNER = 1536, NG = 4, NS = 128, CHUNK = 128, NCHUNK = SEQ / CHUNK, HPG = HEADS / NG;
constexpr int INW = 6704;
constexpr int SRC_DT = 4096, SRC_F = 4144, SRC_G = 4656;
constexpr int NE = 256, TOPK = 8, EH = 256, NEX = NE + 1;
constexpr int PC_Z = 0, PC_X = 1536, PC_B = 3072, PC_C = 3584, PC_U = 4096, PC_GS = 4608, PC_GF = 5632, PW = 6656, NPROJ = 6912;
constexpr float RMS_EPS = 1e-6f;
constexpr int ROWS_R = T * TOPK + NE * 256;
constexpr int ROWS_ALL = ROWS_R + T;
constexpr int MAXTILES = ROWS_ALL / 256;

constexpr size_t MiB = 1u << 20;
constexpr size_t WS_CTL = 0, CTL_ZERO_BYTES = 1 * MiB;
constexpr size_t WS_MOD = 1 * MiB;
constexpr size_t WS_TW = WS_MOD + 128 * 1024;
constexpr size_t WS_WM1 = WS_TW + 64 * 1024;
constexpr size_t WS_WM2 = WS_WM1 + 32 * 1024;
constexpr size_t WS_CD = WS_WM2 + 64 * 1024;
constexpr size_t WS_DM = WS_CD + 64 * 1024;
constexpr size_t WS_BCNT = 2 * MiB;
constexpr size_t WS_TILEE = WS_BCNT + 256 * 1024;
constexpr size_t WS_TILEV = WS_TILEE + 8 * 1024;
constexpr float YB_SCALE = 8.f;
constexpr size_t WS_WINT = 4 * MiB;
constexpr size_t WS_WBST = 19 * MiB;
constexpr size_t WS_WBFT = 22 * MiB;
constexpr size_t WS_WOUTT = 23 * MiB;
constexpr size_t WS_WRT = 25 * MiB;
constexpr size_t WS_W13T = 26 * MiB;
constexpr size_t WS_W2T = 283 * MiB;
constexpr size_t WS_H = 412 * MiB;
constexpr size_t WS_PROJ = 476 * MiB;
constexpr size_t WS_DT = 924 * MiB;
constexpr size_t WS_ST = 932 * MiB;
constexpr size_t WS_STL = 1316 * MiB;
constexpr float STP_SCALE = 0.25f;
constexpr float STL_SCALE = 2.f;
constexpr size_t WS_YN = 1124 * MiB;
constexpr size_t WS_GB = 1220 * MiB;
constexpr size_t WS_FO = 1284 * MiB;
constexpr size_t WS_MIX = 1316 * MiB;
constexpr size_t WS_MIXED = 1380 * MiB;
constexpr size_t WS_LOG = 1444 * MiB;
constexpr size_t WS_TOPI = 1476 * MiB, WS_TOPW = 1477 * MiB, WS_TOKPOS = 1478 * MiB, WS_ROWTOK = 1479 * MiB;
constexpr size_t WS_HB = 1481 * MiB;
constexpr size_t WS_YB = 476 * MiB;
constexpr size_t WS_END = 1657 * MiB;
static_assert(WS_YB + (size_t)ROWS_ALL * 1024 * 2 <= WS_YN + (size_t)T * 1536 * 2, "YB overlay must end inside PROJ..YN");
constexpr int CW_ERR = 16;
constexpr int CW_NTILES = 64, CW_BASESH = 65;
constexpr int CW_BAR = 4096;
#define XCD_BAR_WORDS 3456
static_assert((CW_BAR + XCD_BAR_WORDS) * 4 <= (int)CTL_ZERO_BYTES, "ctl");

constexpr int LDS_BYTES = 160 * 1024;
constexpr int MISC_OFF = LDS_BYTES - 256;

#define GAS __attribute__((address_space(1)))
#define LAS __attribute__((address_space(3)))
typedef unsigned short bf16;
typedef unsigned v4u __attribute__((ext_vector_type(4)));
typedef unsigned v2u __attribute__((ext_vector_type(2)));
typedef float f32x4 __attribute__((ext_vector_type(4)));
typedef float f32x2 __attribute__((ext_vector_type(2)));
typedef short bf16x8 __attribute__((ext_vector_type(8)));
typedef GAS unsigned gu32;
#define RLX_AGENT __ATOMIC_RELAXED, __HIP_MEMORY_SCOPE_AGENT
#define LDS_WAIT() asm volatile("s_waitcnt lgkmcnt(0)" ::: "memory")
#define VM_WAIT() asm volatile("s_waitcnt vmcnt(0)" ::: "memory")
__device__ __forceinline__ unsigned f2bf(float f) { unsigned u = __builtin_bit_cast(unsigned, f); return (u + 0x7fffu + ((u >> 16) & 1u)) >> 16; }
__device__ __forceinline__ unsigned pk2(float lo, float hi) { unsigned r; asm volatile("v_cvt_pk_bf16_f32 %0, %1, %2" : "=v"(r) : "v"(lo), "v"(hi)); return r; }
__device__ __forceinline__ float bflo(unsigned w) { return __uint_as_float(w << 16); }
__device__ __forceinline__ float bfhi(unsigned w) { return __uint_as_float(w & 0xffff0000u); }
__device__ __forceinline__ float bf2f(bf16 b) { return __uint_as_float(((unsigned)b) << 16); }
__device__ __forceinline__ float siluf_(float x) { return x * __builtin_amdgcn_rcpf(1.f + __expf(-x)); }
__device__ __forceinline__ float softplusf_(float x) { return x > 20.f ? x : log1pf(expf(x)); }
__device__ __forceinline__ float wave_sum(float v) {
#pragma unroll
    for (int o = 1; o < 64; o <<= 1) v += __shfl_xor(v, o);
    return v;
}

#define XB_TMO      128
#define XB_XCNT(j)  (256  + 64 * (j))
#define XB_XSUB(j)  (1280 + 64 * (j))
#define XB_XGEN(j)  (2304 + 64 * (j))
#define XB_TOP      3328
#define XB_TOPGEN   3392
#define XB_SPIN_CAP (1u << 18)
__device__ __forceinline__ unsigned xb_ld(unsigned* p)              { return __hip_atomic_load(p, __ATOMIC_RELAXED, __HIP_MEMORY_SCOPE_AGENT); }
__device__ __forceinline__ unsigned xb_add(unsigned* p, unsigned v) { return __hip_atomic_fetch_add(p, v, __ATOMIC_RELAXED, __HIP_MEMORY_SCOPE_AGENT); }
__device__ __forceinline__ unsigned xb_xcc_id() { return (unsigned)__builtin_amdgcn_s_getreg((3 << 11) | 20) & 0xFu; }
#define XB_SPIN(cond, bar) do { unsigned _sp = 0; while (cond) { __builtin_amdgcn_s_sleep(1); \
    if ((++_sp & 255u) == 0u) { if (xb_ld(&(bar)[XB_TMO])) break; if (_sp > XB_SPIN_CAP) { atomicAdd(&(bar)[XB_TMO], 1u); break; } } } } while (0)
struct XcdBarrier { unsigned* bar; unsigned x; volatile LAS unsigned* st; };
__device__ __forceinline__ XcdBarrier xcd_barrier_post(unsigned* bar, volatile LAS unsigned* st) {
    XcdBarrier b; b.bar = bar; b.x = xb_xcc_id(); b.st = st;
    if (threadIdx.x == 0) (void)xb_add(&bar[XB_XCNT(b.x)], 1u);
    return b;
}
__device__ __forceinline__ void xcd_barrier_complete(unsigned* bar, unsigned x, unsigned& nloc, unsigned& nx) {
    const unsigned G = gridDim.x * gridDim.y * gridDim.z;
    unsigned sum, cnt, mine, sp = 0u;
    for (;;) {
        sum = 0u; cnt = 0u; mine = 0u;
#pragma unroll
        for (unsigned j = 0; j < 16; ++j) { const unsigned c = xb_ld(&bar[XB_XCNT(j)]); sum += c; cnt += (c > 0u) ? 1u : 0u; mine = (j == x) ? c : mine; }
        if (sum == G) break;
        __builtin_amdgcn_s_sleep(1);
        if ((++sp & 255u) == 0u) { if (xb_ld(&bar[XB_TMO])) break; if (sp > XB_SPIN_CAP) { atomicAdd(&bar[XB_TMO], 1u); break; } }
    }
    nloc = mine > 0u ? mine : 1u; nx = cnt > 0u ? cnt : 1u;
}
__device__ __forceinline__ void xcd_barrier(const XcdBarrier& b) {
    asm volatile("s_waitcnt vmcnt(0)" ::: "memory");
    __syncthreads();
    if (threadIdx.x == 0) {
        unsigned* bar = b.bar;
        __builtin_amdgcn_s_waitcnt(0);
        unsigned nloc = b.st[0], nx = b.st[1];
        if (nloc == 0u) { xcd_barrier_complete(bar, b.x, nloc, nx); b.st[0] = nloc; b.st[1] = nx; }
        const unsigned old = xb_add(&bar[XB_XSUB(b.x)], 1u);
        const unsigned gen = old / nloc;
        if (old + 1u == (gen + 1u) * nloc) {
            __builtin_amdgcn_fence(__ATOMIC_RELEASE, "agent");
            asm volatile("s_waitcnt vmcnt(0)" ::: "memory");
            const unsigned og = xb_add(&bar[XB_TOP], 1u);
            const unsigned tg = og / nx;
            if (og + 1u == (tg + 1u) * nx) xb_add(&bar[XB_TOPGEN], 1u);
            else XB_SPIN(xb_ld(&bar[XB_TOPGEN]) == tg, bar);
            __builtin_amdgcn_fence(__ATOMIC_ACQUIRE, "agent");
            xb_add(&bar[XB_XGEN(b.x)], 1u);
            asm volatile("s_waitcnt vmcnt(0)" ::: "memory");
        } else {
            XB_SPIN(xb_ld(&bar[XB_XGEN(b.x)]) == gen, bar);
            __builtin_amdgcn_fence(__ATOMIC_ACQUIRE, "agent");
            asm volatile("s_waitcnt vmcnt(0)" ::: "memory");
        }
    }
    __syncthreads();
}

struct Frame {
    LAS unsigned char* lds;
    gu32* ctl;
    unsigned char* ws;
    int tid, lane, wave, G, bx;
    float* out;
};
#define FIN(i) (((const float* const __attribute__((address_space(4)))*)__builtin_amdgcn_kernarg_segment_ptr())[i])
#define WSP(T_, off) ((T_*)(F.ws + (off)))

__device__ __forceinline__ bf16x8 ldfrag(const LAS unsigned char* base, int pitchB, int row, int kel) { return *(const LAS bf16x8*)(base + row * pitchB + kel * 2); }
struct TrItem { const float* W; int K, Nsrc, k0, scol0, nvalid; bf16* WT; size_t drow0; const float* kscale; };
__device__ __forceinline__ void tr_load(const TrItem& t, f32x4 (&v)[16], int lane) {
    const int n4 = (lane & 15) * 4, kr = lane >> 4; const bool ok = n4 < t.nvalid;
#pragma unroll
    for (int i = 0; i < 16; ++i) { const int kk = 4 * i + kr; v[i] = ok ? __builtin_nontemporal_load((const GAS f32x4*)(t.W + (size_t)(t.k0 + kk) * t.Nsrc + t.scol0 + n4)) : (f32x4){0.f, 0.f, 0.f, 0.f}; }
}
__device__ __forceinline__ void tr_store(const TrItem& t, const f32x4 (&v)[16], LAS float* scr, int lane) {
    const int n4 = (lane & 15) * 4, kr = lane >> 4;
#pragma unroll
    for (int i = 0; i < 16; ++i) { const int kk = 4 * i + kr; f32x4 x = v[i]; if (t.kscale) x = x * t.kscale[t.k0 + kk]; LAS float* d = scr + kk * 65 + n4; d[0] = x.x; d[1] = x.y; d[2] = x.z; d[3] = x.w; }
    LDS_WAIT(); asm volatile("" ::: "memory");
    const int c = lane & 7;
#pragma unroll
    for (int j = 0; j < 8; ++j) { const int n = (lane >> 3) + 8 * j; const LAS float* s = scr + (8 * c) * 65 + n;
        v4u o; o.x = pk2(s[0 * 65], s[1 * 65]); o.y = pk2(s[2 * 65], s[3 * 65]); o.z = pk2(s[4 * 65], s[5 * 65]); o.w = pk2(s[6 * 65], s[7 * 65]);
        *(GAS v4u*)(t.WT + (t.drow0 + n) * (size_t)t.K + t.k0 + 8 * c) = o; }
    LDS_WAIT(); asm volatile("" ::: "memory");
}

__device__ __forceinline__ void phase_prologue(Frame& F) {
    const float* c_in = FIN(1); const float* w_ada = FIN(2); const float* b_ada = FIN(3);
    const float* w_in = FIN(8);
    for (int it = F.bx; it < 96; it += F.G) {
        __syncthreads();
        {
            LAS float* sc = (LAS float*)(F.lds);
            LAS float* red = (LAS float*)(F.lds + 16384);
            for (int i = F.tid; i < 4096; i += NTHR) sc[i] = siluf_(c_in[i]);
            __syncthreads();
            const int col = it * 64 + F.lane; float a0 = 0.f, a1 = 0.f, a2 = 0.f, a3 = 0.f;
            const int kb = F.wave * 128;
#pragma unroll 8
            for (int k = 0; k < 128; ++k) { const float w = w_ada[(size_t)(kb + k) * 6144 + col]; a0 += sc[kb + k] * w; a1 += sc[1024 + kb + k] * w; a2 += sc[2048 + kb + k] * w; a3 += sc[3072 + kb + k] * w; }
            red[(F.wave * 4 + 0) * 64 + F.lane] = a0; red[(F.wave * 4 + 1) * 64 + F.lane] = a1; red[(F.wave * 4 + 2) * 64 + F.lane] = a2; red[(F.wave * 4 + 3) * 64 + F.lane] = a3;
            __syncthreads();
            if (F.tid < 256) { const int b = F.tid >> 6, l = F.tid & 63; float s = b_ada[it * 64 + l];
#pragma unroll
                for (int w = 0; w < 8; ++w) s += red[(w * 4 + b) * 64 + l];
                WSP(float, WS_MOD)[b * 6144 + it * 64 + l] = s; }
        }
    }
    __syncthreads();
    const int gt = F.bx * NTHR + F.tid, NGT = F.G * NTHR;
    for (int i = gt; i < 8192; i += NGT) { float s_, c_; sincospif((float)i / 4096.f, &s_, &c_); WSP(f32x2, WS_TW)[i] = (f32x2){c_, s_}; }
    for (int i = gt; i < 128 * 128; i += NGT) { const int m = i >> 7, k = i & 127; const int k1 = m & 63, s1 = k & 63; float s_, c_; sincospif((float)((k1 * s1) & 63) / 32.f, &s_, &c_);
        float v; if (m < 64) v = (k < 64) ? c_ : s_; else v = (k < 64) ? -s_ : c_;
        WSP(bf16, WS_WM1)[i] = (bf16)f2bf(v * 0.125f); }
    for (int i = gt; i < 128 * 256; i += NGT) { const int k2 = i >> 8, k = i & 255; const int s2 = k & 127; float s_, c_; sincospif((float)((k2 * s2) & 127) / 64.f, &s_, &c_);
        WSP(bf16, WS_WM2)[i] = (bf16)f2bf(((k < 128) ? c_ : s_) * 0.08838834764831845f); }
    for (int i = gt; i < 256 * 128; i += NGT) { const int rho = i >> 7, c = i & 127, j = rho & 127; float s_, c_; sincospif((float)((c * j) & 127) / 64.f, &s_, &c_);
        WSP(bf16, WS_DM)[i] = (bf16)f2bf((rho < 128 ? c_ : -s_) * 0.08838834764831845f); }
    LAS float* scr = (LAS float*)(F.lds + F.wave * 16896);
    const int gw = F.bx * NWAVES + F.wave, NGW = F.G * NWAVES;
    constexpr int I_IN = (NPROJ / 64) * 16, I_BS = 24 * 16, I_BF = 8 * 16, I_OUT = 16 * 16, I_R = 16 * 4, I_13 = NEX * 128, I_2 = NEX * 64;
    constexpr int NITEMS = I_IN + I_BS + I_BF + I_OUT + I_R + I_13 + I_2;
    auto decode = [&](int it) -> TrItem {
        int r = it;
        if (r < I_IN) { const int kb = r / (NPROJ / 64), db = r % (NPROJ / 64); const int d0 = db * 64; int src, nv = 64;
            if (d0 < PC_U) src = d0; else if (d0 < PC_GS) src = SRC_F + (d0 - PC_U); else if (d0 < PW) src = SRC_G + (d0 - PC_GS); else { src = SRC_DT + (d0 - PW); nv = 48 - (d0 - PW); nv = nv < 0 ? 0 : (nv > 64 ? 64 : nv); }
            return TrItem{w_in, 1024, INW, kb * 64, src, nv, WSP(bf16, WS_WINT), (size_t)d0, nullptr}; } r -= I_IN;
        if (r < I_BS) { const int kb = r / 16, nb = r % 16; return TrItem{FIN(17), 1536, 1024, kb * 64, nb * 64, 64, WSP(bf16, WS_WBST), (size_t)nb * 64, FIN(16)}; } r -= I_BS;
        if (r < I_BF) { const int kb = r / 16, nb = r % 16; return TrItem{FIN(18), 512, 1024, kb * 64, nb * 64, 64, WSP(bf16, WS_WBFT), (size_t)nb * 64, nullptr}; } r -= I_BF;
        if (r < I_OUT) { const int kb = r / 16, nb = r % 16; return TrItem{FIN(19), 1024, 1024, kb * 64, nb * 64, 64, WSP(bf16, WS_WOUTT), (size_t)nb * 64, nullptr}; } r -= I_OUT;
        if (r < I_R) { const int kb = r / 4, nb = r % 4; return TrItem{FIN(20), 1024, 256, kb * 64, nb * 64, 64, WSP(bf16, WS_WRT), (size_t)nb * 64, nullptr}; } r -= I_R;
        if (r < I_13) { const int e = r >> 7, q = r & 127, kb = q >> 3, db = q & 7; const int rho0 = db * 64, pn = rho0 >> 8, bj = (rho0 >> 7) & 1, jj = rho0 & 127;
            const float* src = (e < NE) ? FIN(22) + (size_t)e * 1024 * 512 : FIN(24);
            return TrItem{src, 1024, 512, kb * 64, bj * 256 + pn * 128 + jj, 64, WSP(bf16, WS_W13T), (size_t)e * 512 + rho0, nullptr}; } r -= I_13;
        { const int e = r >> 6, q = r & 63, kb = q >> 4, nb = q & 15;
            const float* src = (e < NE) ? FIN(23) + (size_t)e * 256 * 1024 : FIN(25);
            return TrItem{src, 256, 1024, kb * 64, nb * 64, 64, WSP(bf16, WS_W2T), (size_t)e * 1024 + nb * 64, nullptr}; }
    };
    if (gw < NITEMS) {
        f32x4 va[16], vb[16]; TrItem ta = decode(gw), tb = ta; tr_load(ta, va, F.lane);
        for (int it = gw; it < NITEMS; it += 2 * NGW) {
            const bool hb = it + NGW < NITEMS; if (hb) { tb = decode(it + NGW); tr_load(tb, vb, F.lane); }
            tr_store(ta, va, scr, F.lane);
            const bool ha = it + 2 * NGW < NITEMS; if (ha) { ta = decode(it + 2 * NGW); tr_load(ta, va, F.lane); }
            if (hb) tr_store(tb, vb, scr, F.lane);
        }
    }
}

__device__ __forceinline__ void phase_norm1(Frame& F) {
    LAS float* GS = (LAS float*)(F.lds); LAS float* SH = GS + 4096;
    const float* mod = WSP(float, WS_MOD); const float* g = FIN(4);
    for (int i = F.tid; i < 4096; i += NTHR) { const int b = i >> 10, col = i & 1023; GS[i] = g[col] * (1.f + mod[b * 6144 + 1024 + col]); SH[i] = mod[b * 6144 + col]; }
    __syncthreads();
    const int gw = F.bx * NWAVES + F.wave, NGW = F.G * NWAVES; const float* x = FIN(0); bf16* H = WSP(bf16, WS_H);
    f32x4 nx[4];
    if (gw < T) { const GAS f32x4* xr = (const GAS f32x4*)(x + (size_t)gw * D) + F.lane;
#pragma unroll
        for (int j = 0; j < 4; ++j) nx[j] = xr[64 * j]; }
    for (int m = gw; m < T; m += NGW) { const int b = m / SEQ;
        f32x4 v[4]; float ss = 0.f;
#pragma unroll
        for (int j = 0; j < 4; ++j) v[j] = nx[j];
        if (m + NGW < T) { const GAS f32x4* xr = (const GAS f32x4*)(x + (size_t)(m + NGW) * D) + F.lane;
#pragma unroll
            for (int j = 0; j < 4; ++j) nx[j] = xr[64 * j]; }
#pragma unroll
        for (int j = 0; j < 4; ++j) ss += (v[j].x * v[j].x + v[j].y * v[j].y) + (v[j].z * v[j].z + v[j].w * v[j].w);
        const float rstd = 1.f / sqrtf(wave_sum(ss) * (1.f / D) + RMS_EPS);
        GAS unsigned long long* o8 = (GAS unsigned long long*)(H + (size_t)m * D) + F.lane;
#pragma unroll
        for (int j = 0; j < 4; ++j) { const int col = 4 * F.lane + 256 * j; const LAS float* gs = GS + b * 1024 + col; const LAS float* sh = SH + b * 1024 + col;
            o8[64 * j] = (unsigned long long)pk2(v[j].x * rstd * gs[0] + sh[0], v[j].y * rstd * gs[1] + sh[1]) | ((unsigned long long)pk2(v[j].z * rstd * gs[2] + sh[2], v[j].w * rstd * gs[3] + sh[3]) << 32); }
    }
}

#define MFMA_BEGIN() do { asm volatile("s_waitcnt lgkmcnt(0)" ::: "memory"); __builtin_amdgcn_sched_barrier(0); } while (0)
#define MFMA_END() do { __builtin_amdgcn_sched_barrier(0); asm volatile("s_nop 15\n\ts_nop 15\n\ts_nop 15\n\ts_nop 15" ::: "memory"); __builtin_amdgcn_sched_barrier(0); } while (0)
#define MFMA_END2() do { __builtin_amdgcn_sched_barrier(0); asm volatile("s_nop 15\n\ts_nop 15" ::: "memory"); __builtin_amdgcn_sched_barrier(0); } while (0)
#define LDS_BARRIER() do { asm volatile("s_waitcnt lgkmcnt(0)" ::: "memory"); __builtin_amdgcn_s_barrier(); asm volatile("" ::: "memory"); } while (0)
constexpr int PT = 272;
__device__ __forceinline__ void wave_scan128(float a0, float a1, int lane, float& i0, float& i1, float& tot) {
    float p = a0 + a1;
#pragma unroll
    for (int o = 1; o < 64; o <<= 1) { const float t = __shfl_up(p, o); if (lane >= o) p += t; }
    i1 = p; i0 = p - a1; tot = __shfl(p, 63);
}
__device__ __forceinline__ void raw_load(unsigned (&r)[12], const bf16* P, int b, int c, int col, int tid) {
    const int pp = tid & 31, sr = tid >> 5;
#pragma unroll
    for (int i = 0; i < 12; ++i) { const int s = c * CHUNK + 8 * sr - 2 + i; r[i] = (s >= 0 && s < SEQ) ? *(const GAS unsigned*)(P + (size_t)(b * SEQ + s) * PW + col + 2 * pp) : 0u; }
}
__device__ __forceinline__ void conv8(const unsigned (&r)[12], const LAS float* cw, int nch, int chl, float (&o0)[8], float (&o1)[8]) {
    float w0[5], w1[5];
#pragma unroll
    for (int i = 0; i < 5; ++i) { const f32x2 w = *(const LAS f32x2*)(cw + i * nch + chl); w0[i] = w.x; w1[i] = w.y; }
    const f32x2 bb = *(const LAS f32x2*)(cw + 5 * nch + chl);
#pragma unroll
    for (int j = 0; j < 8; ++j) { float a = bb.x, d = bb.y;
#pragma unroll
        for (int i = 0; i < 5; ++i) { a += w0[i] * bflo(r[j + i]); d += w1[i] * bfhi(r[j + i]); }
        o0[j] = siluf_(a); o1[j] = siluf_(d); }
}
__device__ __forceinline__ void store_T(LAS unsigned char* dst, int ch, int s0, const float (&o0)[8], const float (&o1)[8], const LAS float* sc) {
    float k[8];
    if (sc) { const f32x4 a = *(const LAS f32x4*)(sc + s0), d = *(const LAS f32x4*)(sc + s0 + 4); k[0] = a.x; k[1] = a.y; k[2] = a.z; k[3] = a.w; k[4] = d.x; k[5] = d.y; k[6] = d.z; k[7] = d.w; }
    else {
#pragma unroll
        for (int j = 0; j < 8; ++j) k[j] = 1.f; }
    v4u w0, w1;
    w0.x = pk2(o0[0] * k[0], o0[1] * k[1]); w0.y = pk2(o0[2] * k[2], o0[3] * k[3]); w0.z = pk2(o0[4] * k[4], o0[5] * k[5]); w0.w = pk2(o0[6] * k[6], o0[7] * k[7]);
    w1.x = pk2(o1[0] * k[0], o1[1] * k[1]); w1.y = pk2(o1[2] * k[2], o1[3] * k[3]); w1.z = pk2(o1[4] * k[4], o1[5] * k[5]); w1.w = pk2(o1[6] * k[6], o1[7] * k[7]);
    *(LAS v4u*)(dst + ch * PT + s0 * 2) = w0; *(LAS v4u*)(dst + (ch + 1) * PT + s0 * 2) = w1;
}
__device__ __forceinline__ void head_vec(Frame& F, int b, int c, int h, int d, float& dt0, float& dt1, float& ac0, float& ac1, float& ex0, float& ex1, float& tot) {
    const float* DTR = WSP(float, WS_DT); const float bias = d ? FIN(12)[h] : FIN(11)[h]; const float A = -expf(d ? FIN(14)[h] : FIN(13)[h]);
    const size_t row = (size_t)(b * SEQ + c * CHUNK + 2 * F.lane);
    dt0 = softplusf_(DTR[row * 64 + d * 24 + h] + bias); dt1 = softplusf_(DTR[(row + 1) * 64 + d * 24 + h] + bias);
    const float a0 = A * dt0, a1 = A * dt1; float i0, i1;
    wave_scan128(a0, a1, F.lane, i0, i1, tot);
    ex0 = i0 - a0; ex1 = i1 - a1;
    if (d == 0) { ac0 = i0; ac1 = i1; } else { ac0 = tot - ex0; ac1 = tot - ex1; }
}

__device__ __forceinline__ void phase_states(Frame& F) {
    LAS unsigned char* BT = F.lds;
    LAS unsigned char* XTB = F.lds + 34816;
    LAS float* CWA = (LAS float*)(F.lds + 104448);
    LAS float* WSF = (LAS float*)(F.lds + 116736);
    LAS float* WSB = WSF + 768;
    const bf16* P = WSP(bf16, WS_PROJ); unsigned char* STL = WSP(unsigned char, WS_STL); float* CD = WSP(float, WS_CD);
    const int fr = F.lane & 15, fq = F.lane >> 4, pp = F.tid & 31, sr = F.tid >> 5;
    int gtab = -1;
    for (int u = F.bx; u < NB * NCHUNK * NG; u += F.G) {
        const int g = u & 3, c = (u >> 2) & 63, b = u >> 8;
        LDS_BARRIER();
        if (g != gtab) { gtab = g;
            for (int i = F.tid; i < 6 * 512; i += NTHR) { const int t = i >> 9, ch = i & 511; const int xc = ch < 384 ? g * 384 + ch : 1536 + g * 128 + (ch - 384);
                CWA[i] = t < 5 ? FIN(9)[t * 2560 + xc] : FIN(10)[xc]; } }
        if (F.wave < HPG) { const int h = g * HPG + F.wave;
#pragma unroll
            for (int d = 0; d < 2; ++d) { float dt0, dt1, ac0, ac1, ex0, ex1, tot; head_vec(F, b, c, h, d, dt0, dt1, ac0, ac1, ex0, ex1, tot);
                LAS float* W = (d ? WSB : WSF) + F.wave * 128 + 2 * F.lane;
                if (d == 0) { W[0] = dt0 * __expf(tot - ac0); W[1] = dt1 * __expf(tot - ac1); } else { W[0] = dt0 * __expf(ex0); W[1] = dt1 * __expf(ex1); }
                if (F.lane == 0) CD[((size_t)(b * NCHUNK + c) * HEADS + h) * 2 + d] = __expf(tot); } }
        unsigned rc[12], rn[12];
        raw_load(rc, P, b, c, PC_B + g * 128, F.tid);
        LDS_BARRIER();
#pragma unroll 1
        for (int pc = 0; pc < 8; ++pc) {
            if (pc < 7) { const int col = (pc + 1 < 2) ? PC_B + g * 128 + 64 : PC_X + (g * HPG + (pc + 1 - 2)) * 64; raw_load(rn, P, b, c, col, F.tid); }
            float o0[8], o1[8];
            if (pc < 2) { conv8(rc, CWA, 512, 384 + pc * 64 + 2 * pp, o0, o1); store_T(BT + pc * 64 * PT, 2 * pp, 8 * sr, o0, o1, nullptr); }
            else { const int hh = pc - 2; conv8(rc, CWA, 512, hh * 64 + 2 * pp, o0, o1);
                LAS unsigned char* xf = XTB + ((hh & 1) * 2) * 17408; store_T(xf, 2 * pp, 8 * sr, o0, o1, WSF + hh * 128); store_T(xf + 17408, 2 * pp, 8 * sr, o0, o1, WSB + hh * 128); }
            LDS_BARRIER();
            if (pc >= 2) { const int hh = pc - 2, h = g * HPG + hh; const LAS unsigned char* xf = XTB + ((hh & 1) * 2) * 17408;
                const int ptile = F.wave & 3, nt0 = 4 * (F.wave >> 2);
                f32x4 af[4], ab[4];
#pragma unroll
                for (int j = 0; j < 4; ++j) { af[j] = (f32x4){0.f, 0.f, 0.f, 0.f}; ab[j] = (f32x4){0.f, 0.f, 0.f, 0.f}; }
#pragma unroll
                for (int half = 0; half < 2; ++half) { bf16x8 qf[2], qb[2], pf[2][4];
#pragma unroll
                    for (int k2 = 0; k2 < 2; ++k2) { const int kk = 2 * half + k2; qf[k2] = ldfrag(xf, PT, 16 * ptile + fr, 32 * kk + 8 * fq); qb[k2] = ldfrag(xf + 17408, PT, 16 * ptile + fr, 32 * kk + 8 * fq);
#pragma unroll
                        for (int j = 0; j < 4; ++j) pf[k2][j] = ldfrag(BT, PT, 16 * (nt0 + j) + fr, 32 * kk + 8 * fq); }
                    MFMA_BEGIN();
#pragma unroll
                    for (int k2 = 0; k2 < 2; ++k2)
#pragma unroll
                        for (int j = 0; j < 4; ++j) { af[j] = __builtin_amdgcn_mfma_f32_16x16x32_bf16(pf[k2][j], qf[k2], af[j], 0, 0, 0); ab[j] = __builtin_amdgcn_mfma_f32_16x16x32_bf16(pf[k2][j], qb[k2], ab[j], 0, 0, 0); }
                    MFMA_END(); }
                unsigned char* so = STL + ((size_t)((b * NCHUNK + c) * HEADS + h) * 2) * 8192 + (16 * ptile + fr) * 128;
                const float sf = STL_SCALE / softplusf_(FIN(11)[h]), sb = STL_SCALE / softplusf_(FIN(12)[h]);
#pragma unroll
                for (int j = 0; j < 4; ++j) { const f32x4 vf = af[j] * sf, vb = ab[j] * sb;
                    int w = __builtin_amdgcn_cvt_pk_fp8_f32(fminf(fmaxf(vf[0], -440.f), 440.f), fminf(fmaxf(vf[1], -440.f), 440.f), 0, false); w = __builtin_amdgcn_cvt_pk_fp8_f32(fminf(fmaxf(vf[2], -440.f), 440.f), fminf(fmaxf(vf[3], -440.f), 440.f), w, true);
                    *(GAS int*)(so + 16 * (nt0 + j) + 4 * fq) = w;
                    w = __builtin_amdgcn_cvt_pk_fp8_f32(fminf(fmaxf(vb[0], -440.f), 440.f), fminf(fmaxf(vb[1], -440.f), 440.f), 0, false); w = __builtin_amdgcn_cvt_pk_fp8_f32(fminf(fmaxf(vb[2], -440.f), 440.f), fminf(fmaxf(vb[3], -440.f), 440.f), w, true);
                    *(GAS int*)(so + 8192 + 16 * (nt0 + j) + 4 * fq) = w; }
            }
#pragma unroll
            for (int i = 0; i < 12; ++i) rc[i] = rn[i];
        }
    }
}

__device__ __forceinline__ void phase_scan(Frame& F) {
    unsigned char* ST = WSP(unsigned char, WS_ST); const unsigned char* STL = WSP(unsigned char, WS_STL); const float* CD = WSP(float, WS_CD);
    const int gt = F.bx * NTHR + F.tid, NGT = F.G * NTHR;
    for (int e = gt; e < NB * HEADS * 2 * 512; e += NGT) {
        const int q16 = e & 511, d = (e >> 9) & 1, bh = e >> 10, h = bh % HEADS, b = bh / HEADS;
        const float inv = STP_SCALE / STL_SCALE;
        float prev[16];
#pragma unroll
        for (int j = 0; j < 16; ++j) prev[j] = 0.f;
        for (int c0 = 0; c0 < NCHUNK; c0 += 4) {
            v4u st[4]; float dec[4];
#pragma unroll
            for (int i = 0; i < 4; ++i) { const int c = d ? (NCHUNK - 1 - (c0 + i)) : (c0 + i); const size_t si = ((size_t)((b * NCHUNK + c) * HEADS + h) * 2 + d);
                st[i] = *(const GAS v4u*)(STL + si * 8192 + q16 * 16); dec[i] = CD[si]; }
#pragma unroll
            for (int i = 0; i < 4; ++i) { const int c = d ? (NCHUNK - 1 - (c0 + i)) : (c0 + i); const size_t si = ((size_t)((b * NCHUNK + c) * HEADS + h) * 2 + d);
                const int wv[4] = { (int)st[i].x, (int)st[i].y, (int)st[i].z, (int)st[i].w }; v4u o;
                unsigned ow[4];
#pragma unroll
                for (int q = 0; q < 4; ++q) { int w = __builtin_amdgcn_cvt_pk_fp8_f32(fminf(fmaxf(prev[4 * q], -440.f), 440.f), fminf(fmaxf(prev[4 * q + 1], -440.f), 440.f), 0, false);
                    w = __builtin_amdgcn_cvt_pk_fp8_f32(fminf(fmaxf(prev[4 * q + 2], -440.f), 440.f), fminf(fmaxf(prev[4 * q + 3], -440.f), 440.f), w, true); ow[q] = (unsigned)w;
                    prev[4 * q] = prev[4 * q] * dec[i] + inv * __builtin_amdgcn_cvt_f32_fp8(wv[q], 0); prev[4 * q + 1] = prev[4 * q + 1] * dec[i] + inv * __builtin_amdgcn_cvt_f32_fp8(wv[q], 1);
                    prev[4 * q + 2] = prev[4 * q + 2] * dec[i] + inv * __builtin_amdgcn_cvt_f32_fp8(wv[q], 2); prev[4 * q + 3] = prev[4 * q + 3] * dec[i] + inv * __builtin_amdgcn_cvt_f32_fp8(wv[q], 3); }
                o.x = ow[0]; o.y = ow[1]; o.z = ow[2]; o.w = ow[3]; *(GAS v4u*)(ST + si * 8192 + q16 * 16) = o; }
        }
    }
}

__device__ __forceinline__ void phase_ssd_out(Frame& F) {
    LAS unsigned char* CS = F.lds;
    LAS unsigned char* BS = F.lds + 34816;
    LAS unsigned char* XT = F.lds + 69632;
    LAS unsigned char* PVB = F.lds + 87040;
    LAS float* CWX = (LAS float*)(F.lds + 121856);
    LAS float* DTF = (LAS float*)(F.lds + 131072);
    LAS float* DTB = DTF + 768; LAS float* ACF = DTB + 768; LAS float* ACB = ACF + 768; LAS float* CFF = ACB + 768; LAS float* CFB = CFF + 768;
    LAS float* CWBC = (LAS float*)PVB;
    const unsigned char* ST = WSP(unsigned char, WS_ST); const bf16* P = WSP(bf16, WS_PROJ); bf16* YN = WSP(bf16, WS_YN);
    const int fr = F.lane & 15, fq = F.lane >> 4, w = F.wave, pp = F.tid & 31, sr = F.tid >> 5;
    LAS unsigned char* LB = BS + w * 16 * PT;
    LAS unsigned char* XB = F.lds + 149504 + w * 1280;
    int gtab = -1;
    for (int u = F.bx; u < NB * NCHUNK * NG; u += F.G) {
        const int g = u & 3, c = (u >> 2) & 63, b = u >> 8;
        unsigned rbc[4][12];
#pragma unroll
        for (int pc = 0; pc < 4; ++pc) raw_load(rbc[pc], P, b, c, ((pc >> 1) ? PC_C : PC_B) + g * 128 + (pc & 1) * 64, F.tid);
        LDS_BARRIER();
        if (g != gtab) { gtab = g; for (int i = F.tid; i < 6 * 384; i += NTHR) { const int t = i / 384, ch = i % 384; CWX[i] = t < 5 ? FIN(9)[t * 2560 + g * 384 + ch] : FIN(10)[g * 384 + ch]; } }
        for (int i = F.tid; i < 6 * 256; i += NTHR) { const int t = i >> 8, ch = i & 255; const int xc = 1536 + (ch >> 7) * 512 + g * 128 + (ch & 127); CWBC[i] = t < 5 ? FIN(9)[t * 2560 + xc] : FIN(10)[xc]; }
        if (w < HPG) { const int h = g * HPG + w;
#pragma unroll
            for (int d = 0; d < 2; ++d) { float dt0, dt1, ac0, ac1, ex0, ex1, tot; head_vec(F, b, c, h, d, dt0, dt1, ac0, ac1, ex0, ex1, tot);
                const float ref = d ? __shfl(ac0, F.lane & ~7) : __shfl(ac1, (F.lane & ~7) + 7);
                LAS float* D_ = (d ? DTB : DTF) + w * 128 + 2 * F.lane; LAS float* A_ = (d ? ACB : ACF) + w * 128 + 2 * F.lane; LAS float* C_ = (d ? CFB : CFF) + w * 128 + 2 * F.lane;
                D_[0] = dt0; D_[1] = dt1; A_[0] = ac0; A_[1] = ac1; C_[0] = dt0 * __expf(ref - ac0); C_[1] = dt1 * __expf(ref - ac1); } }
        LDS_BARRIER();
        {
#pragma unroll
            for (int pc = 0; pc < 4; ++pc) { const int isC = pc >> 1, half = pc & 1;
                float o0[8], o1[8]; conv8(rbc[pc], CWBC, 256, isC * 128 + half * 64 + 2 * pp, o0, o1);
                LAS unsigned char* dst = (isC ? CS : BS) + (half * 64 + 2 * pp) * 2;
#pragma unroll
                for (int j = 0; j < 8; ++j) *(LAS unsigned*)(dst + (8 * sr + j) * PT) = pk2(o0[j], o1[j]); } }
        unsigned rx[12];
        raw_load(rx, P, b, c, PC_X + (g * HPG) * 64, F.tid);
        LDS_BARRIER();
        f32x4 cb[8];
#pragma unroll
        for (int t = 0; t < 8; ++t) cb[t] = (f32x4){0.f, 0.f, 0.f, 0.f};
#pragma unroll
        for (int kk = 0; kk < 4; ++kk) { const bf16x8 q = ldfrag(CS, PT, 16 * w + fr, 32 * kk + 8 * fq); bf16x8 pf[8];
#pragma unroll
            for (int t = 0; t < 8; ++t) pf[t] = ldfrag(BS, PT, 16 * t + fr, 32 * kk + 8 * fq);
            MFMA_BEGIN();
#pragma unroll
            for (int t = 0; t < 8; ++t) cb[t] = __builtin_amdgcn_mfma_f32_16x16x32_bf16(pf[t], q, cb[t], 0, 0, 0);
            MFMA_END(); }
        LDS_BARRIER();
        const int l = 16 * w + fr;
        float ssq = 0.f;
        v4u pv0, pv1; { const unsigned char* src = ST + ((size_t)((b * NCHUNK + c) * HEADS + g * HPG) * 2) * 8192 + F.tid * 16; pv0 = *(const GAS v4u*)src; pv1 = *(const GAS v4u*)(src + 8192); }
#pragma unroll 1
        for (int hh = 0; hh < HPG; ++hh) { const int h = g * HPG + hh;
            { float o0[8], o1[8]; conv8(rx, CWX, 384, hh * 64 + 2 * pp, o0, o1); store_T(XT, 2 * pp, 8 * sr, o0, o1, nullptr); }
            if (hh + 1 < HPG) raw_load(rx, P, b, c, PC_X + (h + 1) * 64, F.tid);
            f32x4 Y[4];
#pragma unroll
            for (int pt = 0; pt < 4; ++pt) Y[pt] = (f32x4){0.f, 0.f, 0.f, 0.f};
            const float dsk = FIN(15)[h];
            v2u zw[4]; { const bf16* zrow = P + (size_t)(b * SEQ + c * CHUNK + l) * PW + PC_Z + h * 64;
#pragma unroll
                for (int pt = 0; pt < 4; ++pt) zw[pt] = *(const GAS v2u*)(zrow + 16 * pt + 4 * fq); }
            {
                const int kd = w >> 1;
#pragma unroll
                for (int d = 0; d < 2; ++d) {
                    const LAS float* AC = (d ? ACB : ACF) + hh * 128; const LAS float* DT_ = (d ? DTB : DTF) + hh * 128; const LAS float* CF = (d ? CFB : CFF) + hh * 128;
                    const float al = AC[l];
#pragma unroll
                    for (int t = 0; t < 8; ++t) {
                        if (d ? ((t >> 1) < kd) : ((t >> 1) > kd)) continue;
                        float o[4];
                        if (t == w) { const f32x4 as = *(const LAS f32x4*)(AC + 16 * t + 4 * fq), ds = *(const LAS f32x4*)(DT_ + 16 * t + 4 * fq);
#pragma unroll
                            for (int r = 0; r < 4; ++r) { const int s = 16 * t + 4 * fq + r; const bool keep = d ? (s >= l) : (s <= l);
                                float v = cb[t][r] * __expf(al - as[r]) * ds[r]; v = keep ? v : 0.f; if (d == 0 && s == l) v += dsk; o[r] = v; } }
                        else if (d ? (t > w) : (t < w)) { const float rr = __expf(al - AC[d ? 16 * t : 16 * t + 15]); const f32x4 cf = *(const LAS f32x4*)(CF + 16 * t + 4 * fq);
#pragma unroll
                            for (int r = 0; r < 4; ++r) o[r] = cb[t][r] * rr * cf[r]; }
                        else { o[0] = 0.f; o[1] = 0.f; o[2] = 0.f; o[3] = 0.f; }
                        v2u pw; pw.x = pk2(o[0], o[1]); pw.y = pk2(o[2], o[3]);
                        if (d && (t >> 1) == kd) *(LAS v2u*)(XB + fr * 80 + ((t & 1) * 16 + 4 * fq) * 2) = pw;
                        else *(LAS v2u*)(LB + fr * PT + (16 * t + 4 * fq) * 2) = pw; }
                    { LAS unsigned char* PV = PVB + d * 17408; const v4u pvx = d ? pv1 : pv0;
                      const int r0 = F.tid >> 3, part = F.tid & 7; const float ps = softplusf_(d ? FIN(12)[h] : FIN(11)[h]) * (1.f / STP_SCALE);
                      const int wv[4] = { (int)pvx.x, (int)pvx.y, (int)pvx.z, (int)pvx.w }; unsigned o[8];
#pragma unroll
                      for (int q = 0; q < 4; ++q) { o[2 * q] = pk2(ps * __builtin_amdgcn_cvt_f32_fp8(wv[q], 0), ps * __builtin_amdgcn_cvt_f32_fp8(wv[q], 1)); o[2 * q + 1] = pk2(ps * __builtin_amdgcn_cvt_f32_fp8(wv[q], 2), ps * __builtin_amdgcn_cvt_f32_fp8(wv[q], 3)); }
                      *(LAS v4u*)(PV + r0 * PT + part * 32) = (v4u){o[0], o[1], o[2], o[3]}; *(LAS v4u*)(PV + r0 * PT + part * 32 + 16) = (v4u){o[4], o[5], o[6], o[7]}; }
                }
                if (hh + 1 < HPG) { const unsigned char* src = ST + ((size_t)((b * NCHUNK + c) * HEADS + h + 1) * 2) * 8192 + F.tid * 16; pv0 = *(const GAS v4u*)src; pv1 = *(const GAS v4u*)(src + 8192); }
                LDS_BARRIER();
                f32x4 Zf[4], Zb[4];
#pragma unroll
                for (int pt = 0; pt < 4; ++pt) { Zf[pt] = (f32x4){0.f, 0.f, 0.f, 0.f}; Zb[pt] = (f32x4){0.f, 0.f, 0.f, 0.f}; }
#pragma unroll
                for (int kk = 0; kk < 4; ++kk) { const bool yf = kk <= kd, yb = kk >= kd;
                    bf16x8 xp[4], lf, lb2;
#pragma unroll
                    for (int pt = 0; pt < 4; ++pt) xp[pt] = ldfrag(XT, PT, 16 * pt + fr, 32 * kk + 8 * fq);
                    lf = ldfrag(LB, PT, fr, 32 * kk + 8 * fq);
                    lb2 = (kk == kd) ? *(const LAS bf16x8*)(XB + fr * 80 + 16 * fq) : lf;
                    MFMA_BEGIN();
                    if (yf || kk > kd) {
#pragma unroll
                        for (int pt = 0; pt < 4; ++pt) Y[pt] = __builtin_amdgcn_mfma_f32_16x16x32_bf16(xp[pt], lf, Y[pt], 0, 0, 0); }
                    if (yb && kk == kd) {
#pragma unroll
                        for (int pt = 0; pt < 4; ++pt) Y[pt] = __builtin_amdgcn_mfma_f32_16x16x32_bf16(xp[pt], lb2, Y[pt], 0, 0, 0); }
                    MFMA_END2(); }
#pragma unroll
                for (int kk = 0; kk < 4; ++kk) { const bf16x8 cq = ldfrag(CS, PT, 16 * w + fr, 32 * kk + 8 * fq); bf16x8 pf_[4], pb_[4];
#pragma unroll
                    for (int pt = 0; pt < 4; ++pt) { pf_[pt] = ldfrag(PVB, PT, 16 * pt + fr, 32 * kk + 8 * fq); pb_[pt] = ldfrag(PVB + 17408, PT, 16 * pt + fr, 32 * kk + 8 * fq); }
                    MFMA_BEGIN();
#pragma unroll
                    for (int pt = 0; pt < 4; ++pt) { Zf[pt] = __builtin_amdgcn_mfma_f32_16x16x32_bf16(pf_[pt], cq, Zf[pt], 0, 0, 0); Zb[pt] = __builtin_amdgcn_mfma_f32_16x16x32_bf16(pb_[pt], cq, Zb[pt], 0, 0, 0); }
                    MFMA_END(); }
                const float elf = __expf(ACF[hh * 128 + l]), elb = __expf(ACB[hh * 128 + l]);
#pragma unroll
                for (int pt = 0; pt < 4; ++pt) Y[pt] = Y[pt] + Zf[pt] * elf + Zb[pt] * elb;
            }
            bf16* yrow0 = YN + (size_t)(b * SEQ + c * CHUNK + l) * INNER + g * 384 + hh * 64;
#pragma unroll
            for (int pt = 0; pt < 4; ++pt) {
                const float v0 = Y[pt][0] * siluf_(bflo(zw[pt].x)), v1 = Y[pt][1] * siluf_(bfhi(zw[pt].x)), v2 = Y[pt][2] * siluf_(bflo(zw[pt].y)), v3 = Y[pt][3] * siluf_(bfhi(zw[pt].y));
                ssq += (v0 * v0 + v1 * v1) + (v2 * v2 + v3 * v3); v2u o; o.x = pk2(v0, v1); o.y = pk2(v2, v3); *(GAS v2u*)(yrow0 + 16 * pt + 4 * fq) = o; }
            LDS_BARRIER();
        }
        ssq += __shfl_xor(ssq, 16); ssq += __shfl_xor(ssq, 32);
        const float rstd = 1.f / sqrtf(ssq * (1.f / 384.f) + RMS_EPS);
        VM_WAIT();
        bf16* yrow = YN + (size_t)(b * SEQ + c * CHUNK + l) * INNER + g * 384;
        for (int hh = 0; hh < HPG; ++hh)
#pragma unroll
            for (int pt = 0; pt < 4; ++pt) { const v2u vv = *(const GAS v2u*)(yrow + hh * 64 + 16 * pt + 4 * fq); v2u o; o.x = pk2(bflo(vv.x) * rstd, bfhi(vv.x) * rstd); o.y = pk2(bflo(vv.y) * rstd, bfhi(vv.y) * rstd);
                *(GAS v2u*)(yrow + hh * 64 + 16 * pt + 4 * fq) = o; }
    }
}

__device__ __forceinline__ void zt_put(LAS unsigned char* ZT, int pb, int ch0, int kidx, v4u v, bool odd) {
    const unsigned w[4] = { v.x, v.y, v.z, v.w };
#pragma unroll
    for (int m = 0; m < 4; ++m) { const unsigned send = odd ? (w[m] & 0xffffu) : (w[m] >> 16); const unsigned recv = (unsigned)__shfl_xor((int)send, 1);
        const unsigned val = odd ? (recv | (w[m] & 0xffff0000u)) : ((w[m] & 0xffffu) | (recv << 16));
        const int off = odd ? (ch0 + 2 * m + 1) * pb + (kidx - 1) * 2 : (ch0 + 2 * m) * pb + kidx * 2;
        *(LAS unsigned*)(ZT + off) = val; }
}
__device__ __forceinline__ void phase_dft1(Frame& F) {
    LAS unsigned char* WM = F.lds;
    LAS unsigned char* ZT = F.lds + 34816;
    LAS unsigned char* UT = F.lds + 104448;
    const bf16* P = WSP(bf16, WS_PROJ); bf16* GB = WSP(bf16, WS_GB); const f32x2* TW = WSP(f32x2, WS_TW);
    __syncthreads();
    for (int q = F.tid; q < 128 * 16; q += NTHR) { const int r = q >> 4, part = q & 15; *(LAS v4u*)(WM + r * PT + part * 16) = *(const GAS v4u*)(WSP(bf16, WS_WM1) + r * 128 + part * 8); }
    const int fr = F.lane & 15, fq = F.lane >> 4, w = F.wave;
    bf16x8 dfr[2][4];
#pragma unroll
    for (int i = 0; i < 2; ++i)
#pragma unroll
        for (int kk = 0; kk < 4; ++kk) dfr[i][kk] = *(const GAS bf16x8*)(WSP(bf16, WS_DM) + (size_t)(32 * w + 16 * i + fr) * 128 + 32 * kk + 8 * fq);
    for (int u = F.bx; u < NB * 128 * 2; u += F.G) {
        const int jh = u & 1, s2 = (u >> 1) & 127, b = u >> 8;
        v4u ul[4];
#pragma unroll
        for (int i = 0; i < 4; ++i) { const int q = F.tid + 512 * i, gl = q >> 10, r = (q >> 4) & 63, part = q & 15;
            ul[i] = *(const GAS v4u*)(P + (size_t)(b * SEQ + 128 * r + s2) * PW + PC_U + (2 * jh + gl) * 128 + part * 8); }
        LDS_BARRIER();
#pragma unroll
        for (int i = 0; i < 4; ++i) { const int q = F.tid + 512 * i, gl = q >> 10, r = (q >> 4) & 63, part = q & 15; *(LAS v4u*)(UT + gl * 17408 + r * PT + part * 16) = ul[i]; }
        LDS_BARRIER();
#pragma unroll
        for (int gl = 0; gl < 2; ++gl)
#pragma unroll
            for (int tt = 0; tt < 4; ++tt) { bf16x8 uf[4];
#pragma unroll
                for (int kk = 0; kk < 4; ++kk) uf[kk] = ldfrag(UT + gl * 17408, PT, 16 * tt + fr, 32 * kk + 8 * fq);
                f32x4 za[2] = { (f32x4){0.f, 0.f, 0.f, 0.f}, (f32x4){0.f, 0.f, 0.f, 0.f} };
                MFMA_BEGIN();
#pragma unroll
                for (int kk = 0; kk < 4; ++kk) { za[0] = __builtin_amdgcn_mfma_f32_16x16x32_bf16(uf[kk], dfr[0][kk], za[0], 0, 0, 0); za[1] = __builtin_amdgcn_mfma_f32_16x16x32_bf16(uf[kk], dfr[1][kk], za[1], 0, 0, 0); }
                MFMA_END2();
#pragma unroll
                for (int i = 0; i < 2; ++i) { const int rho = 32 * w + 16 * i + fr; v2u o; o.x = pk2(za[i][0], za[i][1]); o.y = pk2(za[i][2], za[i][3]);
                    *(LAS v2u*)(ZT + (gl * 128 + (rho & 127)) * PT + ((rho >> 7) * 64 + 16 * tt + 4 * fq) * 2) = o; } }
        LDS_BARRIER();
        const int mi = w & 3, jq = w >> 2;
        f32x4 acc[2][8];
#pragma unroll
        for (int a = 0; a < 2; ++a)
#pragma unroll
            for (int j = 0; j < 8; ++j) acc[a][j] = (f32x4){0.f, 0.f, 0.f, 0.f};
#pragma unroll
        for (int kk = 0; kk < 4; ++kk) { const bf16x8 q0 = ldfrag(WM, PT, 16 * mi + fr, 32 * kk + 8 * fq), q1 = ldfrag(WM, PT, 64 + 16 * mi + fr, 32 * kk + 8 * fq); bf16x8 pf[8];
#pragma unroll
            for (int j = 0; j < 8; ++j) pf[j] = ldfrag(ZT, PT, 128 * jq + 16 * j + fr, 32 * kk + 8 * fq);
            MFMA_BEGIN();
#pragma unroll
            for (int j = 0; j < 8; ++j) { acc[0][j] = __builtin_amdgcn_mfma_f32_16x16x32_bf16(pf[j], q0, acc[0][j], 0, 0, 0); acc[1][j] = __builtin_amdgcn_mfma_f32_16x16x32_bf16(pf[j], q1, acc[1][j], 0, 0, 0); }
            MFMA_END(); }
        const int k1 = 16 * mi + fr; const f32x2 tw = TW[(s2 * k1) & 8191];
        bf16* orow = GB + ((size_t)(b * 128 + s2) * 64 + k1) * 1024 + jh * 256 + 128 * jq + 4 * fq;
#pragma unroll
        for (int j = 0; j < 8; ++j) { float gr[4], gi[4];
#pragma unroll
            for (int r = 0; r < 4; ++r) { const float a = acc[0][j][r], bq = acc[1][j][r]; gr[r] = a * tw.x + bq * tw.y; gi[r] = bq * tw.x - a * tw.y; }
            v2u o; o.x = pk2(gr[0], gr[1]); o.y = pk2(gr[2], gr[3]); *(GAS v2u*)(orow + 16 * j) = o;
            o.x = pk2(gi[0], gi[1]); o.y = pk2(gi[2], gi[3]); *(GAS v2u*)(orow + 512 + 16 * j) = o; }
    }
}
constexpr int PT2 = 528;
__device__ __forceinline__ void phase_dft2(Frame& F) {
    LAS unsigned char* WM = F.lds;
    LAS unsigned char* ZT = F.lds + 67584;
    const bf16* GB = WSP(bf16, WS_GB); bf16* FO = WSP(bf16, WS_FO);
    LDS_BARRIER();
    for (int q = F.tid; q < 128 * 32; q += NTHR) { const int r = q >> 5, part = q & 31; *(LAS v4u*)(WM + r * PT2 + part * 16) = *(const GAS v4u*)(WSP(bf16, WS_WM2) + r * 256 + part * 8); }
    const int fr = F.lane & 15, fq = F.lane >> 4, w = F.wave;
    for (int u = F.bx; u < NB * 64 * 4; u += F.G) {
        const int jb = u & 3, k1 = (u >> 2) & 63, b = u >> 8;
        LDS_BARRIER();
        { const int s2 = 64 * (w & 1) + F.lane; const bf16* row = GB + ((size_t)(b * 128 + s2) * 64 + k1) * 1024; v4u vv[8];
#pragma unroll
          for (int q = 0; q < 8; ++q) { const int cc = (w >> 1) + 4 * q; const int im = cc >= 16, chunk = cc & 15;
              vv[q] = *(const GAS v4u*)(row + im * 512 + jb * 128 + chunk * 8); }
#pragma unroll
          for (int q = 0; q < 8; ++q) { const int cc = (w >> 1) + 4 * q; const int im = cc >= 16, chunk = cc & 15; zt_put(ZT, PT2, chunk * 8, im * 128 + s2, vv[q], s2 & 1); } }
        LDS_BARRIER();
        f32x4 acc[8];
#pragma unroll
        for (int j = 0; j < 8; ++j) acc[j] = (f32x4){0.f, 0.f, 0.f, 0.f};
#pragma unroll
        for (int kk = 0; kk < 8; ++kk) { const bf16x8 q = ldfrag(WM, PT2, 16 * w + fr, 32 * kk + 8 * fq); bf16x8 pf[8];
#pragma unroll
            for (int j = 0; j < 8; ++j) pf[j] = ldfrag(ZT, PT2, 16 * j + fr, 32 * kk + 8 * fq);
            MFMA_BEGIN();
#pragma unroll
            for (int j = 0; j < 8; ++j) acc[j] = __builtin_amdgcn_mfma_f32_16x16x32_bf16(pf[j], q, acc[j], 0, 0, 0);
            MFMA_END(); }
        const int k2 = 16 * w + fr; bf16* orow = FO + (size_t)(b * SEQ + k1 + 64 * k2) * 512 + jb * 128 + 4 * fq;
#pragma unroll
        for (int j = 0; j < 8; ++j) { v2u o; o.x = pk2(acc[j][0], acc[j][1]); o.y = pk2(acc[j][2], acc[j][3]); *(GAS v2u*)(orow + 16 * j) = o; }
    }
}

__device__ __forceinline__ void phase_norm2(Frame& F) {
    LAS float* GM = (LAS float*)(F.lds); LAS float* GS = GM + 4096; LAS float* SH = GS + 4096;
    const float* mod = WSP(float, WS_MOD);
    __syncthreads();
    for (int i = F.tid; i < 4096; i += NTHR) { const int b = i >> 10, col = i & 1023; GM[i] = mod[b * 6144 + 2048 + col] * FIN(5)[col]; GS[i] = FIN(6)[col] * (1.f + mod[b * 6144 + 4096 + col]); SH[i] = mod[b * 6144 + 3072 + col]; }
    __syncthreads();
    const int gw = F.bx * NWAVES + F.wave, NGW = F.G * NWAVES; const float* x = FIN(0); bf16* H = WSP(bf16, WS_H); const bf16* MX = WSP(bf16, WS_MIXED);
    v2u nmw[4]; f32x4 nxv[4];
    if (gw < T) { const GAS v2u* mr = (const GAS v2u*)(MX + (size_t)gw * D) + F.lane; const GAS f32x4* xr = (const GAS f32x4*)(x + (size_t)gw * D) + F.lane;
#pragma unroll
        for (int j = 0; j < 4; ++j) { nmw[j] = mr[64 * j]; nxv[j] = xr[64 * j]; } }
    for (int m = gw; m < T; m += NGW) { const int b = m / SEQ;
        f32x4 v[4], xv[4]; float ss = 0.f;
#pragma unroll
        for (int j = 0; j < 4; ++j) { const v2u mw = nmw[j]; xv[j] = nxv[j]; v[j] = (f32x4){bflo(mw.x), bfhi(mw.x), bflo(mw.y), bfhi(mw.y)}; }
        if (m + NGW < T) { const GAS v2u* mr = (const GAS v2u*)(MX + (size_t)(m + NGW) * D) + F.lane; const GAS f32x4* xr = (const GAS f32x4*)(x + (size_t)(m + NGW) * D) + F.lane;
#pragma unroll
            for (int j = 0; j < 4; ++j) { nmw[j] = mr[64 * j]; nxv[j] = xr[64 * j]; } }
#pragma unroll
        for (int j = 0; j < 4; ++j) ss += (v[j].x * v[j].x + v[j].y * v[j].y) + (v[j].z * v[j].z + v[j].w * v[j].w);
        const float rstd = 1.f / sqrtf(wave_sum(ss) * (1.f / D) + RMS_EPS); float s2 = 0.f;
        GAS f32x4* o4 = (GAS f32x4*)(F.out + (size_t)m * D) + F.lane;
#pragma unroll
        for (int j = 0; j < 4; ++j) { const LAS float* gm = GM + b * 1024 + 4 * F.lane + 256 * j;
            v[j].x = xv[j].x + gm[0] * v[j].x * rstd; v[j].y = xv[j].y + gm[1] * v[j].y * rstd; v[j].z = xv[j].z + gm[2] * v[j].z * rstd; v[j].w = xv[j].w + gm[3] * v[j].w * rstd;
            o4[64 * j] = v[j]; s2 += (v[j].x * v[j].x + v[j].y * v[j].y) + (v[j].z * v[j].z + v[j].w * v[j].w); }
        const float rstd2 = 1.f / sqrtf(wave_sum(s2) * (1.f / D) + RMS_EPS);
        GAS unsigned long long* o8 = (GAS unsigned long long*)(H + (size_t)m * D) + F.lane;
#pragma unroll
        for (int j = 0; j < 4; ++j) { const int col = 4 * F.lane + 256 * j; const LAS float* gs = GS + b * 1024 + col; const LAS float* sh = SH + b * 1024 + col;
            o8[64 * j] = (unsigned long long)pk2(v[j].x * rstd2 * gs[0] + sh[0], v[j].y * rstd2 * gs[1] + sh[1]) | ((unsigned long long)pk2(v[j].z * rstd2 * gs[2] + sh[2], v[j].w * rstd2 * gs[3] + sh[3]) << 32); }
    }
}

#define DPP_MAX_STEP(ctrl, rmask) do { const float ov = __builtin_bit_cast(float, __builtin_amdgcn_update_dpp(__builtin_bit_cast(int, bv), __builtin_bit_cast(int, bv), ctrl, rmask, 0xf, false)); \
        const int oi = __builtin_amdgcn_update_dpp(bi, bi, ctrl, rmask, 0xf, false); const bool tk = ov > bv || (ov == bv && oi < bi); bv = tk ? ov : bv; bi = tk ? oi : bi; } while (0)
__device__ __forceinline__ void wave_argmax(float& bv, int& bi) {
    DPP_MAX_STEP(0x111, 0xf); DPP_MAX_STEP(0x112, 0xf); DPP_MAX_STEP(0x114, 0xf); DPP_MAX_STEP(0x118, 0xf);
    DPP_MAX_STEP(0x142, 0xa); DPP_MAX_STEP(0x143, 0xc);
    bv = __builtin_bit_cast(float, __builtin_amdgcn_readlane(__builtin_bit_cast(int, bv), 63)); bi = __builtin_amdgcn_readlane(bi, 63);
}
__device__ __forceinline__ void phase_route(Frame& F) {
    LAS int* hist = (LAS int*)(F.lds);
    const float* LOG = WSP(float, WS_LOG); const float* rb = FIN(21); int* TOPI = WSP(int, WS_TOPI); float* TOPW = WSP(float, WS_TOPW); int* BCNT = WSP(int, WS_BCNT);
    const int lane = F.lane;
    for (int vb = F.bx; vb < 256; vb += F.G) {
        __syncthreads();
        if (F.tid < 256) hist[F.tid] = 0;
        __syncthreads();
        for (int ti = F.wave * 4; ti < 128; ti += NWAVES * 4) {
            float sc[4][4], cand[4][4], wsum[4], mysc[4]; int myidx[4];
#pragma unroll
            for (int q = 0; q < 4; ++q) { const int t = vb * 128 + ti + q;
                const f32x4 lg = *(const GAS f32x4*)(LOG + (size_t)t * 256 + 4 * lane); const f32x4 bb = *(const GAS f32x4*)(rb + 4 * lane);
                float bs[4];
#pragma unroll
                for (int j = 0; j < 4; ++j) { sc[q][j] = 1.f / (1.f + expf(-lg[j])); bs[j] = sc[q][j] + bb[j]; }
                float m1 = fmaxf(fmaxf(bs[0], bs[1]), fmaxf(bs[2], bs[3])), m2;
                { float a_ = fmaxf(bs[0], bs[1]), a2 = fminf(bs[0], bs[1]), c_ = fmaxf(bs[2], bs[3]), c2 = fminf(bs[2], bs[3]); m2 = fmaxf(fminf(a_, c_), fmaxf(a2, c2)); }
#define TOP2_STEP(ctrl) do { const float o1 = __builtin_bit_cast(float, __builtin_amdgcn_update_dpp(0, __builtin_bit_cast(int, m1), ctrl, 0xf, 0xf, false)), o2 = __builtin_bit_cast(float, __builtin_amdgcn_update_dpp(0, __builtin_bit_cast(int, m2), ctrl, 0xf, 0xf, false)); \
                    const float n1 = fmaxf(m1, o1), n2 = fmaxf(fminf(m1, o1), fmaxf(m2, o2)); m1 = n1; m2 = n2; } while (0)
                TOP2_STEP(0xb1); TOP2_STEP(0x4e); TOP2_STEP(0x141);
#undef TOP2_STEP
                const float gs = m1 + m2; const int mygrp = lane >> 3; int rank = 0;
#pragma unroll
                for (int j = 0; j < 8; ++j) { const float og = __builtin_bit_cast(float, __builtin_amdgcn_readlane(__builtin_bit_cast(int, gs), 8 * j)); rank += (og > gs || (og == gs && j < mygrp)) ? 1 : 0; }
                const bool gsel = rank < 4;
#pragma unroll
                for (int j = 0; j < 4; ++j) cand[q][j] = gsel ? bs[j] : -INFINITY;
                wsum[q] = 0.f; mysc[q] = 0.f; myidx[q] = 0; }
            for (int k = 0; k < TOPK; ++k) {
#pragma unroll
                for (int q = 0; q < 4; ++q) {
                    float bv = cand[q][0]; int bi = 4 * lane;
#pragma unroll
                    for (int j = 1; j < 4; ++j) if (cand[q][j] > bv) { bv = cand[q][j]; bi = 4 * lane + j; }
                    wave_argmax(bv, bi);
                    const int own = bi >> 2, sub = bi & 3;
                    const float s_own = sub == 0 ? sc[q][0] : (sub == 1 ? sc[q][1] : (sub == 2 ? sc[q][2] : sc[q][3]));
                    const float ssel = __builtin_bit_cast(float, __builtin_amdgcn_readlane(__builtin_bit_cast(int, s_own), own));
                    if (lane == own) {
#pragma unroll
                        for (int j = 0; j < 4; ++j) if (j == sub) cand[q][j] = -INFINITY; }
                    wsum[q] += ssel; if (lane == k) { myidx[q] = bi; mysc[q] = ssel; } }
            }
#pragma unroll
            for (int q = 0; q < 4; ++q) { const int t = vb * 128 + ti + q;
                if (lane < TOPK) { TOPI[t * TOPK + lane] = myidx[q]; TOPW[t * TOPK + lane] = mysc[q] / wsum[q] * 2.5f; atomicAdd((int*)&hist[myidx[q]], 1); } }
        }
        __syncthreads();
        if (F.tid < 256) BCNT[vb * 256 + F.tid] = hist[F.tid];
    }
}

__device__ __forceinline__ void phase_lists(Frame& F) {
    LAS int* tot = (LAS int*)(F.lds);
    LAS int* base = tot + 256;
    LAS int* pre = base + 260;
    LAS int* cur = pre + 256;
    LAS int* part = cur + 256;
    const int* BCNT = WSP(int, WS_BCNT); const int* TOPI = WSP(int, WS_TOPI); int* TOKPOS = WSP(int, WS_TOKPOS); int* ROWTOK = WSP(int, WS_ROWTOK); int* TILEE = WSP(int, WS_TILEE);
    typedef int i32x4 __attribute__((ext_vector_type(4)));
    const int e4 = (F.tid & 63) * 4, rg = F.tid >> 6;
    for (int vb = F.bx; vb < 256; vb += F.G) {
        __syncthreads();
        { i32x4 st = (i32x4){0, 0, 0, 0}, sp = (i32x4){0, 0, 0, 0};
#pragma unroll 8
          for (int i = 0; i < 32; ++i) { const int v = rg + 8 * i; const i32x4 c4 = *(const GAS i32x4*)(BCNT + v * 256 + e4); st += c4; if (v < vb) sp += c4; }
          *(LAS i32x4*)(part + rg * 256 + e4) = st; *(LAS i32x4*)(part + 2048 + rg * 256 + e4) = sp; }
        __syncthreads();
        if (F.tid < 256) { int s = 0, q = 0;
#pragma unroll
            for (int r = 0; r < 8; ++r) { s += part[r * 256 + F.tid]; q += part[2048 + r * 256 + F.tid]; }
            tot[F.tid] = s; pre[F.tid] = q; cur[F.tid] = 0; }
        __syncthreads();
        if (F.tid < 256) { const int pad = (tot[F.tid] + 255) & ~255; int v = pad;
#pragma unroll
            for (int o = 1; o < 64; o <<= 1) { const int t_ = __shfl_up(v, o); if (F.lane >= o) v += t_; }
            part[F.tid] = v - pad; if (F.lane == 63) part[256 + F.wave] = v; }
        __syncthreads();
        if (F.tid < 256) { int off = T; for (int w_ = 0; w_ < F.wave; ++w_) off += part[256 + w_]; base[F.tid] = off + part[F.tid]; if (F.tid == 255) base[256] = off + part[255] + ((tot[255] + 255) & ~255); }
        __syncthreads();
        if (vb == 0) {
            int* TILEV = WSP(int, WS_TILEV);
            if (F.tid < 256) { const int e = F.tid; int left = tot[e]; for (int t = base[e] >> 8; t < (base[e + 1] >> 8); ++t) { TILEE[t] = e; TILEV[t] = left < 256 ? left : 256; left -= 256; } }
            for (int t = F.tid; t < T / 256; t += NTHR) { TILEE[t] = NE; TILEV[t] = 256; }
            if (F.tid == 0) { F.ctl[CW_NTILES] = (unsigned)(base[256] >> 8); F.ctl[CW_BASESH] = 0u; }
        }
        for (int r = base[vb] + tot[vb] + F.tid; r < base[vb + 1]; r += NTHR) ROWTOK[r] = 0;
        for (int i = F.tid; i < 128 * TOPK; i += NTHR) { const int t = vb * 128 + (i >> 3); const int e = TOPI[t * TOPK + (i & 7)]; const int pos = base[e] + pre[e] + atomicAdd((int*)&cur[e], 1);
            ROWTOK[pos] = t; TOKPOS[t * TOPK + (i & 7)] = pos; }
    }
}

__device__ __forceinline__ void phase_final(Frame& F) {
    LAS float* GF = (LAS float*)(F.lds);
    const float* mod = WSP(float, WS_MOD);
    __syncthreads();
    for (int i = F.tid; i < 4096; i += NTHR) { const int b = i >> 10, col = i & 1023; GF[i] = mod[b * 6144 + 5120 + col] * FIN(7)[col]; }
    __syncthreads();
    const int gw = F.bx * NWAVES + F.wave, NGW = F.G * NWAVES; const unsigned char* YB = WSP(unsigned char, WS_YB); const int* TOKPOS = WSP(int, WS_TOKPOS); const float* TOPW = WSP(float, WS_TOPW);
    const int basesh = (int)__hip_atomic_load(F.ctl + CW_BASESH, RLX_AGENT);
    int npos[TOPK + 1]; float nwk[TOPK + 1]; v2u ny0[TOPK + 1], ny1[TOPK + 1];
#define FIN_LOAD_PW(mm) do { _Pragma("unroll") for (int k = 0; k < TOPK; ++k) { npos[k] = TOKPOS[(mm) * TOPK + k]; nwk[k] = TOPW[(mm) * TOPK + k] * (1.f / YB_SCALE); } npos[TOPK] = basesh + (mm); nwk[TOPK] = 1.f / YB_SCALE; } while (0)
#define FIN_LOAD_ROWS(pos_, y0_, y1_) do { _Pragma("unroll") for (int k = 0; k < TOPK + 1; ++k) { const GAS v2u* yr = (const GAS v2u*)(YB + (size_t)(pos_)[k] * 1024) + F.lane; (y0_)[k] = yr[0]; (y1_)[k] = yr[64]; } } while (0)
    float cwk[TOPK + 1];
    if (gw < T) { FIN_LOAD_PW(gw); FIN_LOAD_ROWS(npos, ny0, ny1);
#pragma unroll
        for (int k = 0; k < TOPK + 1; ++k) cwk[k] = nwk[k];
        if (gw + NGW < T) FIN_LOAD_PW(gw + NGW); }
    for (int m = gw; m < T; m += NGW) { const int b = m / SEQ;
        float a[16]; v2u y0[TOPK + 1], y1[TOPK + 1]; float wk_[TOPK + 1];
#pragma unroll
        for (int k = 0; k < TOPK + 1; ++k) { y0[k] = ny0[k]; y1[k] = ny1[k]; wk_[k] = cwk[k]; }
        if (m + NGW < T) { FIN_LOAD_ROWS(npos, ny0, ny1);
#pragma unroll
            for (int k = 0; k < TOPK + 1; ++k) cwk[k] = nwk[k];
            if (m + 2 * NGW < T) FIN_LOAD_PW(m + 2 * NGW); }
#pragma unroll
        for (int j = 0; j < 16; ++j) a[j] = 0.f;
#pragma unroll
        for (int k = 0; k < TOPK + 1; ++k) { const float wk = wk_[k];
            a[0] += wk * __builtin_amdgcn_cvt_f32_fp8((int)y0[k].x, 0); a[1] += wk * __builtin_amdgcn_cvt_f32_fp8((int)y0[k].x, 1); a[2] += wk * __builtin_amdgcn_cvt_f32_fp8((int)y0[k].x, 2); a[3] += wk * __builtin_amdgcn_cvt_f32_fp8((int)y0[k].x, 3);
            a[4] += wk * __builtin_amdgcn_cvt_f32_fp8((int)y0[k].y, 0); a[5] += wk * __builtin_amdgcn_cvt_f32_fp8((int)y0[k].y, 1); a[6] += wk * __builtin_amdgcn_cvt_f32_fp8((int)y0[k].y, 2); a[7] += wk * __builtin_amdgcn_cvt_f32_fp8((int)y0[k].y, 3);
            a[8] += wk * __builtin_amdgcn_cvt_f32_fp8((int)y1[k].x, 0); a[9] += wk * __builtin_amdgcn_cvt_f32_fp8((int)y1[k].x, 1); a[10] += wk * __builtin_amdgcn_cvt_f32_fp8((int)y1[k].x, 2); a[11] += wk * __builtin_amdgcn_cvt_f32_fp8((int)y1[k].x, 3);
            a[12] += wk * __builtin_amdgcn_cvt_f32_fp8((int)y1[k].y, 0); a[13] += wk * __builtin_amdgcn_cvt_f32_fp8((int)y1[k].y, 1); a[14] += wk * __builtin_amdgcn_cvt_f32_fp8((int)y1[k].y, 2); a[15] += wk * __builtin_amdgcn_cvt_f32_fp8((int)y1[k].y, 3); }
        float ss = 0.f;
#pragma unroll
        for (int j = 0; j < 16; ++j) ss += a[j] * a[j];
        const float rstd = 1.f / sqrtf(wave_sum(ss) * (1.f / D) + RMS_EPS);
        float* orow = F.out + (size_t)m * D;
#pragma unroll
        for (int hlf = 0; hlf < 2; ++hlf) { const int col = hlf * 512 + 8 * F.lane; const LAS float* gf = GF + b * 1024 + col;
            f32x4 x0 = *(GAS f32x4*)(orow + col), x1 = *(GAS f32x4*)(orow + col + 4);
            x0.x += gf[0] * a[8 * hlf + 0] * rstd; x0.y += gf[1] * a[8 * hlf + 1] * rstd; x0.z += gf[2] * a[8 * hlf + 2] * rstd; x0.w += gf[3] * a[8 * hlf + 3] * rstd;
            x1.x += gf[4] * a[8 * hlf + 4] * rstd; x1.y += gf[5] * a[8 * hlf + 5] * rstd; x1.z += gf[6] * a[8 * hlf + 6] * rstd; x1.w += gf[7] * a[8 * hlf + 7] * rstd;
            *(GAS f32x4*)(orow + col) = x0; *(GAS f32x4*)(orow + col + 4) = x1; }
    }
}
constexpr int NPH = 18;
struct Args { const float* in[26]; float* out; unsigned char* ws; };
template <int LO, int HI>
__global__ void __launch_bounds__(NTHR, 2) fwd(Args args) {
    extern __shared__ __attribute__((aligned(16))) unsigned char lds[];
    Frame F;
    F.lds = (LAS unsigned char*)lds; F.ws = args.ws; F.ctl = (gu32*)(args.ws + WS_CTL);
    F.tid = threadIdx.x; F.lane = F.tid & 63; F.wave = __builtin_amdgcn_readfirstlane(F.tid >> 6); F.G = gridDim.x; F.bx = blockIdx.x;
    F.out = args.out;
    volatile LAS unsigned* MISC = (volatile LAS unsigned*)(F.lds + MISC_OFF);
    if (F.tid < 64) MISC[F.tid] = 0u;
#if KSTART_INV
    if (F.tid == 0) { __builtin_amdgcn_fence(__ATOMIC_ACQUIRE, "agent"); asm volatile("s_waitcnt vmcnt(0)" ::: "memory"); }
#endif
    __syncthreads();
    XcdBarrier bar; bar.bar = (unsigned*)(F.ctl + CW_BAR); bar.x = 0; bar.st = nullptr;
    if constexpr (HI - LO > 1) bar = xcd_barrier_post((unsigned*)(F.ctl + CW_BAR), MISC + 8);
#define IN(k) (LO <= (k) && (k) < HI)
#define FRESH() do { int _t = threadIdx.x; asm volatile("" : "+v"(_t)); F.tid = _t; F.lane = _t & 63; F.wave = __builtin_amdgcn_readfirstlane(_t >> 6); \
        unsigned long long _w = (unsigned long long)args.ws; asm volatile("" : "+s"(_w)); F.ws = (unsigned char*)_w; F.ctl = (gu32*)(F.ws + WS_CTL); \
        unsigned long long _o = (unsigned long long)args.out; asm volatile("" : "+s"(_o)); F.out = (float*)_o; } while (0)
#if TIMING
#define TSTAMP(k) do { if (blockIdx.x == 0 && threadIdx.x == 0) ((unsigned long long*)(args.ws + WS_CTL))[256 + (k)] = __builtin_amdgcn_s_memrealtime(); } while (0)
#else
#define TSTAMP(k) do {} while (0)
#endif
#define SEAM(k) do { if constexpr (IN(k) && IN((k) + 1)) xcd_barrier(bar); TSTAMP(k); } while (0)
    TSTAMP(18);
    if constexpr (IN(0)) { FRESH(); phase_prologue(F); } SEAM(0);
    if constexpr (IN(1)) { FRESH(); phase_norm1(F); } SEAM(1);
    if constexpr (IN(2)) { FRESH();
        __syncthreads();
        pg8::Gemm g{WSP(bf16, WS_H), WSP(bf16, WS_WINT), T, NPROJ, D, nullptr}; pg8::StaticOrder S; S.init(T, NPROJ, F.G, F.bx);
        pg8::EpiProj E{WSP(bf16, WS_PROJ), PW, WSP(float, WS_DT), PC_GS / 256, PW / 256};
        pg8::gemm_phase<pg8::EpiProj, pg8::StaticOrder, true, false>(F.lds, g, S, E);
    } SEAM(2);
    if constexpr (IN(3)) { FRESH(); phase_states(F); } TSTAMP(3);
    if constexpr (IN(4)) { FRESH(); phase_dft1(F); } SEAM(4);
    if constexpr (IN(5)) { FRESH(); phase_scan(F); } TSTAMP(5);
    if constexpr (IN(6)) { FRESH(); phase_dft2(F); } SEAM(6);
    if constexpr (IN(7)) { FRESH(); phase_ssd_out(F); } SEAM(7);
    if constexpr (IN(8)) { FRESH();
        __syncthreads();
        pg8::Gemm g{WSP(bf16, WS_YN), WSP(bf16, WS_WBST), T, D, INNER, nullptr}; pg8::StaticOrder S; S.init(T, D, F.G, F.bx);
        pg8::EpiGate<false> E{WSP(bf16, WS_MIX), D, WSP(bf16, WS_PROJ), PW, PC_GS};
        pg8::gemm_phase<pg8::EpiGate<false>, pg8::StaticOrder, true, false>(F.lds, g, S, E);
    } TSTAMP(8);
    if constexpr (IN(9)) { FRESH();
        __syncthreads();
        pg8::Gemm g{WSP(bf16, WS_FO), WSP(bf16, WS_WBFT), T, D, 512, nullptr}; pg8::StaticOrder S; S.init(T, D, F.G, F.bx);
        pg8::EpiGate<true> E{WSP(bf16, WS_MIX), D, WSP(bf16, WS_PROJ), PW, PC_GF};
        pg8::gemm_phase<pg8::EpiGate<true>, pg8::StaticOrder, true, false>(F.lds, g, S, E);
    } SEAM(9);
    if constexpr (IN(10)) { FRESH();
        __syncthreads();
        pg8::Gemm g{WSP(bf16, WS_MIX), WSP(bf16, WS_WOUTT), T, D, D, nullptr}; pg8::StaticOrder S; S.init(T, D, F.G, F.bx);
        pg8::EpiBf16<4> E{WSP(bf16, WS_MIXED), D};
        pg8::gemm_phase<pg8::EpiBf16<4>, pg8::StaticOrder, true, false>(F.lds, g, S, E);
    } SEAM(10);
    if constexpr (IN(11)) { FRESH(); phase_norm2(F); } SEAM(11);
    if constexpr (IN(12)) { FRESH();
        __syncthreads();
        const int nrb = (T / 256 < F.G) ? T / 256 : F.G;
        if (F.bx < nrb || F.G - nrb < 8) {
            pg8::Gemm g{WSP(bf16, WS_H), WSP(bf16, WS_WRT), T, NE, D, nullptr}; pg8::StaticOrder S; S.init(T, NE, F.G, F.bx);
            pg8::EpiF32 E{WSP(float, WS_LOG), NE};
            pg8::gemm_phase<pg8::EpiF32, pg8::StaticOrder, true, false>(F.lds, g, S, E);
        }
        if (F.bx >= nrb || F.G - nrb < 8) {
            const bool all = F.G - nrb < 8;
            pg8::Gemm g{WSP(bf16, WS_H), WSP(bf16, WS_W13T), T, NEX * 512, D, nullptr}; pg8::SharedOrder S{T / 256, NE, all ? 0 : nrb, all ? F.G : F.G - nrb, F.bx};
            pg8::EpiSwiglu E{WSP(bf16, WS_HB), EH};
            pg8::gemm_phase<pg8::EpiSwiglu, pg8::SharedOrder, true, false>(F.lds, g, S, E);
        }
    } SEAM(12);
    if constexpr (IN(13)) { FRESH(); phase_route(F); } SEAM(13);
    if constexpr (IN(14)) { FRESH(); phase_lists(F); } SEAM(14);
    if constexpr (IN(15)) { FRESH();
        __syncthreads();
        const int ntiles = (int)__hip_atomic_load(F.ctl + CW_NTILES, RLX_AGENT);
        LAS int* te = (LAS int*)(F.lds + 131072); for (int i = F.tid; i < MAXTILES; i += NTHR) te[i] = (i < ntiles) ? WSP(int, WS_TILEE)[i] : 0;
        __syncthreads();
        pg8::Gemm g{WSP(bf16, WS_H), WSP(bf16, WS_W13T), ROWS_ALL, NEX * 512, D, WSP(int, WS_ROWTOK)}; pg8::GroupedOrder<2> S{te, ntiles, F.G, F.bx, T / 256};
        pg8::EpiSwiglu E{WSP(bf16, WS_HB), EH};
        pg8::gemm_phase<pg8::EpiSwiglu, pg8::GroupedOrder<2>, true, true>(F.lds, g, S, E);
    } SEAM(15);
    if constexpr (IN(16)) { FRESH();
        __syncthreads();
        const int ntiles = (int)__hip_atomic_load(F.ctl + CW_NTILES, RLX_AGENT);
        LAS int* te = (LAS int*)(F.lds + 131072); LAS int* tv = te + MAXTILES;
        for (int i = F.tid; i < MAXTILES; i += NTHR) { te[i] = (i < ntiles) ? WSP(int, WS_TILEE)[i] : 0; tv[i] = (i < ntiles) ? WSP(int, WS_TILEV)[i] : 0; }
        __syncthreads();
        pg8::Gemm g{WSP(bf16, WS_HB), WSP(bf16, WS_W2T), ROWS_ALL, NEX * 1024, EH, nullptr}; pg8::GroupedOrder<4> S{te, ntiles, F.G, F.bx, 0};
        pg8::EpiFp8<4> E{WSP(unsigned char, WS_YB), D, tv, YB_SCALE};
        pg8::gemm_phase<pg8::EpiFp8<4>, pg8::GroupedOrder<4>, true, false>(F.lds, g, S, E);
    } SEAM(16);
    if constexpr (IN(17)) { FRESH(); phase_final(F); }
#if TIMING
    if constexpr (HI - LO > 1) { xcd_barrier(bar); TSTAMP(17);
        if (blockIdx.x == 0) { __syncthreads(); const unsigned long long* TS = (const unsigned long long*)(args.ws + WS_CTL) + 256;
            const float ta = (float)(TS[TA_HI] - (TA_LO > 0 ? TS[TA_LO - 1] : TS[18])) * 0.01f, tb = (float)(TS[TB_HI] - (TB_LO > 0 ? TS[TB_LO - 1] : TS[18])) * 0.01f;
            VM_WAIT(); __syncthreads();
            for (int i = threadIdx.x; i < (1 << 20); i += NTHR) args.out[(size_t)1024 * 1024 + i] += tb * 0.01f;
            if (threadIdx.x == 0) args.out[7] = ta; } }
#endif
#undef IN
#undef SEAM
}
#if DEV_CHECKS
struct CArgs { const float* in[26]; float* out; unsigned char* ws; };
#define CW(T_, off) ((T_*)(a.ws + (off)))
__device__ __forceinline__ unsigned hsh(unsigned x) { x ^= x >> 16; x *= 0x7feb352du; x ^= x >> 15; x *= 0x846ca68bu; x ^= x >> 16; return x; }
__device__ __forceinline__ void chk_acc(unsigned char* ws, int k, float num, float den) {
    num = wave_sum(num); den = wave_sum(den);
    if ((threadIdx.x & 63) == 0) { float* e = (float*)(ws + WS_CTL) + CW_ERR + 2 * k; atomicAdd(e, num); atomicAdd(e + 1, den); }
}
__device__ __forceinline__ float bfr(float f) { return __uint_as_float(f2bf(f) << 16); }
__device__ float c_convsilu(const CArgs& a, int b, int s, int ch) {
    const bf16* P = CW(bf16, WS_PROJ); float o = a.in[10][ch];
    for (int i = 0; i < 5; ++i) { const int ss = s + i - 2; if (ss >= 0 && ss < SEQ) o += a.in[9][i * 2560 + ch] * bf2f(P[(size_t)(b * SEQ + ss) * PW + PC_X + ch]); }
    return siluf_(o);
}
__device__ float c_prev(const CArgs& a, size_t si, int idx, int h, int d) {
    const size_t ei = si * 8192 + idx; const int wv = CW(int, WS_ST)[ei >> 2]; const int bs = ei & 3;
    return (bs == 0 ? __builtin_amdgcn_cvt_f32_fp8(wv, 0) : bs == 1 ? __builtin_amdgcn_cvt_f32_fp8(wv, 1) : bs == 2 ? __builtin_amdgcn_cvt_f32_fp8(wv, 2) : __builtin_amdgcn_cvt_f32_fp8(wv, 3)) * softplusf_(d ? a.in[12][h] : a.in[11][h]) * (1.f / STP_SCALE);
}
__device__ float c_dt(const CArgs& a, int b, int s, int h, int d) { return softplusf_(CW(float, WS_DT)[(size_t)(b * SEQ + s) * 64 + d * 24 + h] + (d ? a.in[12][h] : a.in[11][h])); }
__device__ float c_a(const CArgs& a, int b, int s, int h, int d) { return -expf(d ? a.in[14][h] : a.in[13][h]) * c_dt(a, b, s, h, d); }

__global__ void chk0(CArgs a) {
    const unsigned sid = blockIdx.x * blockDim.x + threadIdx.x; const unsigned r = hsh(sid * 3u + 1u), r2 = hsh(sid * 3u + 2u);
    float num = 0.f, den = 0.f;
    { const int b = r & 3, col = (r >> 2) % 6144; float s = a.in[3][col]; for (int k = 0; k < 1024; ++k) s += siluf_(a.in[1][b * 1024 + k]) * a.in[2][(size_t)k * 6144 + col];
      const float f = CW(float, WS_MOD)[b * 6144 + col]; num += (f - s) * (f - s); den += s * s; }
    { const int d = r2 % NPROJ, k = (r2 >> 13) & 1023; float e;
      if (d < PC_U) e = a.in[8][(size_t)k * INW + d];
      else if (d < PC_GS) e = a.in[8][(size_t)k * INW + SRC_F + d - PC_U];
      else if (d < PW) e = a.in[8][(size_t)k * INW + SRC_G + d - PC_GS];
      else e = (d - PW < 48) ? a.in[8][(size_t)k * INW + SRC_DT + d - PW] : 0.f;
      const float f = bf2f(CW(bf16, WS_WINT)[(size_t)d * 1024 + k]); num += (f - e) * (f - e); den += e * e + 1e-6f; }
    { const int n = r & 1023, k = (r >> 10) % 1536; const float e = a.in[17][(size_t)k * 1024 + n] * a.in[16][k], f = bf2f(CW(bf16, WS_WBST)[(size_t)n * 1536 + k]); num += (f - e) * (f - e); den += e * e; }
    { const int n = r2 & 1023, k = (r2 >> 10) & 511; const float e = a.in[18][(size_t)k * 1024 + n], f = bf2f(CW(bf16, WS_WBFT)[(size_t)n * 512 + k]); num += (f - e) * (f - e); den += e * e; }
    { const int n = r & 1023, k = (r >> 10) & 1023; const float e = a.in[19][(size_t)k * 1024 + n], f = bf2f(CW(bf16, WS_WOUTT)[(size_t)n * 1024 + k]); num += (f - e) * (f - e); den += e * e; }
    { const int n = r2 & 255, k = (r2 >> 8) & 1023; const float e = a.in[20][(size_t)k * 256 + n], f = bf2f(CW(bf16, WS_WRT)[(size_t)n * 1024 + k]); num += (f - e) * (f - e); den += e * e; }
    { const int e_ = hsh(sid + 77u) % NEX, rho = r & 511, k = (r >> 9) & 1023; const int pn = rho >> 8, bj = (rho >> 7) & 1, jj = rho & 127, sc = bj * 256 + pn * 128 + jj;
      const float e = (e_ < NE) ? a.in[22][((size_t)e_ * 1024 + k) * 512 + sc] : a.in[24][(size_t)k * 512 + sc]; const float f = bf2f(CW(bf16, WS_W13T)[((size_t)e_ * 512 + rho) * 1024 + k]); num += (f - e) * (f - e); den += e * e; }
    { const int e_ = hsh(sid + 99u) % NEX, n = r2 & 1023, k = (r2 >> 10) & 255;
      const float e = (e_ < NE) ? a.in[23][((size_t)e_ * 256 + k) * 1024 + n] : a.in[25][(size_t)k * 1024 + n]; const float f = bf2f(CW(bf16, WS_W2T)[((size_t)e_ * 1024 + n) * 256 + k]); num += (f - e) * (f - e); den += e * e; }
    chk_acc(a.ws, 0, num, den);
}
__global__ void chk1(CArgs a) {
    const unsigned sid = blockIdx.x * blockDim.x + threadIdx.x; if (sid >= 4096) return; const unsigned r = hsh(sid + 11u);
    const int m = r % T, b = m / SEQ; const float* x = a.in[0] + (size_t)m * D; float ss = 0.f; for (int k = 0; k < D; ++k) ss += x[k] * x[k];
    const float rstd = 1.f / sqrtf(ss / D + RMS_EPS); const float* mod = CW(float, WS_MOD) + b * 6144; float num = 0.f, den = 0.f;
    for (int q = 0; q < 8; ++q) { const int col = (r >> 15) * 8 % 1024 + q; const float e = x[col] * rstd * a.in[4][col] * (1.f + mod[1024 + col]) + mod[col]; const float f = bf2f(CW(bf16, WS_H)[(size_t)m * D + col]); num += (f - e) * (f - e); den += e * e; }
    chk_acc(a.ws, 1, num, den);
}
__device__ float c_dot_bf(const bf16* A, const bf16* B, int K) { float s = 0.f; for (int k = 0; k < K; ++k) s += bf2f(A[k]) * bf2f(B[k]); return s; }
__global__ void chk2(CArgs a) {
    const unsigned sid = blockIdx.x * blockDim.x + threadIdx.x; const unsigned r = hsh(sid + 21u);
    const int m = r % T; int col = (r >> 15) % (PW + 48); float num = 0.f, den = 0.f;
    const float e = c_dot_bf(CW(bf16, WS_H) + (size_t)m * D, CW(bf16, WS_WINT) + (size_t)col * D, D); float f, ee = e;
    if (col < PW) { if (col >= PC_GS) ee = 1.f / (1.f + expf(-e)); f = bf2f(CW(bf16, WS_PROJ)[(size_t)m * PW + col]); } else f = CW(float, WS_DT)[(size_t)m * 64 + col - PW];
    num = (f - ee) * (f - ee); den = ee * ee; chk_acc(a.ws, 2, num, den);
}
__global__ void chk3(CArgs a) {
    const unsigned sid = blockIdx.x * blockDim.x + threadIdx.x; if (sid >= 8192) return; const unsigned r = hsh(sid + 31u);
    const int b = r & 3, c = (r >> 2) & 63, h = (r >> 8) % 24, d = (r >> 13) & 1, p = (r >> 14) & 63, n = (r >> 20) & 127, g = h / HPG;
    float tot = 0.f; for (int s = 0; s < 128; ++s) tot += c_a(a, b, c * 128 + s, h, d);
    float st = 0.f, run = 0.f;
    if (d == 0) { for (int s = 0; s < 128; ++s) { run += c_a(a, b, c * 128 + s, h, 0); st += c_convsilu(a, b, c * 128 + s, h * 64 + p) * c_dt(a, b, c * 128 + s, h, 0) * expf(tot - run) * c_convsilu(a, b, c * 128 + s, 1536 + g * 128 + n); } }
    else { for (int s = 127; s >= 0; --s) { run += c_a(a, b, c * 128 + s, h, 1); st += c_convsilu(a, b, c * 128 + s, h * 64 + p) * c_dt(a, b, c * 128 + s, h, 1) * expf(tot - run) * c_convsilu(a, b, c * 128 + s, 1536 + g * 128 + n); } }
    const size_t si = ((size_t)((b * NCHUNK + c) * HEADS + h) * 2 + d); const size_t ei = si * 8192 + p * 128 + n; const int wv = CW(int, WS_STL)[ei >> 2]; const int bs = ei & 3;
    const float f = (bs == 0 ? __builtin_amdgcn_cvt_f32_fp8(wv, 0) : bs == 1 ? __builtin_amdgcn_cvt_f32_fp8(wv, 1) : bs == 2 ? __builtin_amdgcn_cvt_f32_fp8(wv, 2) : __builtin_amdgcn_cvt_f32_fp8(wv, 3)) * softplusf_(d ? a.in[12][h] : a.in[11][h]) * (1.f / STL_SCALE);
    float num = (f - st) * (f - st), den = st * st; const float cd = CW(float, WS_CD)[si], ce = expf(tot); num += (cd - ce) * (cd - ce); den += ce * ce;
    chk_acc(a.ws, 3, num, den);
}
__global__ void chk4(CArgs a) {
    const unsigned sid = blockIdx.x * blockDim.x + threadIdx.x; const unsigned r = hsh(sid + 41u);
    const int b = r & 3, s2 = (r >> 2) & 127, k1 = (r >> 9) & 63, j = (r >> 15) & 511; const bf16* P = CW(bf16, WS_PROJ);
    float gr = 0.f, gi = 0.f;
    const int g_ = j >> 7, jj = j & 127;
    for (int s1 = 0; s1 < 64; ++s1) { const size_t row = (size_t)(b * SEQ + 128 * s1 + s2) * PW; float zr = 0.f, zi = 0.f;
        for (int c_ = 0; c_ < 128; ++c_) { float sn_, cs_; sincospif((float)((c_ * jj) & 127) / 64.f, &sn_, &cs_); const float uv = bf2f(P[row + PC_U + g_ * 128 + c_]); zr += uv * cs_; zi -= uv * sn_; }
        zr = bfr(zr * 0.08838834764831845f); zi = bfr(zi * 0.08838834764831845f);
        float sn, cs; sincospif((float)((s1 * k1) & 63) / 32.f, &sn, &cs); gr += zr * cs + zi * sn; gi += zi * cs - zr * sn; }
    float sn, cs; sincospif((float)((s2 * k1) & 8191) / 4096.f, &sn, &cs); const float er = (gr * cs + gi * sn) * 0.125f, ei = (gi * cs - gr * sn) * 0.125f;
    const bf16* G = CW(bf16, WS_GB) + ((size_t)(b * 128 + s2) * 64 + k1) * 1024; const float fr_ = bf2f(G[j]), fi = bf2f(G[512 + j]);
    chk_acc(a.ws, 4, (fr_ - er) * (fr_ - er) + (fi - ei) * (fi - ei), er * er + ei * ei);
}
__global__ void chk5(CArgs a) {
    const unsigned sid = blockIdx.x * blockDim.x + threadIdx.x; if (sid >= 8192) return; const unsigned r = hsh(sid + 51u);
    const int b = r & 3, c = (r >> 2) & 63, h = (r >> 8) % 24, d = (r >> 13) & 1, p = (r >> 14) & 63, n = (r >> 20) & 127, g = h / HPG;
    const int cn = d ? c - 1 : c + 1; float num = 0.f, den = 0.f;
    const size_t si = ((size_t)((b * NCHUNK + c) * HEADS + h) * 2 + d);
    if ((d == 0 && c == 0) || (d == 1 && c == 63)) { const float f = c_prev(a, si, p * 128 + n, h, d); num += f * f; }
    if (cn >= 0 && cn < 64) {
        float tot = 0.f; for (int s = 0; s < 128; ++s) tot += c_a(a, b, c * 128 + s, h, d);
        float st = 0.f, run = 0.f;
        for (int q = 0; q < 128; ++q) { const int s = d ? 127 - q : q; run += c_a(a, b, c * 128 + s, h, d); st += c_convsilu(a, b, c * 128 + s, h * 64 + p) * c_dt(a, b, c * 128 + s, h, d) * expf(tot - run) * c_convsilu(a, b, c * 128 + s, 1536 + g * 128 + n); }
        const size_t sn_ = ((size_t)((b * NCHUNK + cn) * HEADS + h) * 2 + d);
        const float e = c_prev(a, si, p * 128 + n, h, d) * expf(tot) + st, f = c_prev(a, sn_, p * 128 + n, h, d); num += (f - e) * (f - e); den += e * e + st * st; }
    chk_acc(a.ws, 5, num, den);
}
__global__ void chk6(CArgs a) {
    const unsigned sid = blockIdx.x * blockDim.x + threadIdx.x; const unsigned r = hsh(sid + 61u);
    const int b = r & 3, k = (r >> 2) & 8191, j = (r >> 15) & 511, k1 = k & 63, k2 = k >> 6; float num = 0.f, den = 0.f;
    { float s = 0.f; for (int s2 = 0; s2 < 128; ++s2) { const bf16* G = CW(bf16, WS_GB) + ((size_t)(b * 128 + s2) * 64 + k1) * 1024; float sn, cs; sincospif((float)((s2 * k2) & 127) / 64.f, &sn, &cs); s += bf2f(G[j]) * cs + bf2f(G[512 + j]) * sn; }
      s *= 0.08838834764831845f; const float f = bf2f(CW(bf16, WS_FO)[(size_t)(b * SEQ + k) * 512 + j]); num += (f - s) * (f - s); den += s * s; }
    if (sid < 64) { const bf16* P = CW(bf16, WS_PROJ); const int g_ = j >> 7, jj = j & 127; double s = 0.0;
      for (int t = 0; t < SEQ; ++t) { const size_t row = (size_t)(b * SEQ + t) * PW; for (int c_ = 0; c_ < 128; ++c_) { const long ph = ((long)k * t * 128 + (long)jj * c_ * SEQ) % ((long)SEQ * 128);
          float sn, cs; sincospif((float)((double)ph / ((double)SEQ * 64.0)), &sn, &cs); s += bf2f(P[row + PC_U + g_ * 128 + c_]) * cs; } }
      const float e = (float)(s / 1024.0); const float f = bf2f(CW(bf16, WS_FO)[(size_t)(b * SEQ + k) * 512 + j]); num += 64.f * (f - e) * (f - e); den += 64.f * e * e; }
    chk_acc(a.ws, 6, num, den);
}
__global__ void chk7(CArgs a) {
    __shared__ float Cl[128], CBs[2][128], red[384]; __shared__ float acf[6][128], acb[6][128];
    const unsigned r = hsh(blockIdx.x + 71u); const int b = r & 3, c = (r >> 2) & 63, l = (r >> 8) & 127, g = (r >> 15) & 3, tid = threadIdx.x;
    if (tid < 128) Cl[tid] = c_convsilu(a, b, c * 128 + l, 2048 + g * 128 + tid);
    if (tid < 12) { const int d = tid / 6, hh = tid % 6, h = g * HPG + hh; float run = 0.f;
        if (!d) for (int s = 0; s < 128; ++s) { run += c_a(a, b, c * 128 + s, h, 0); acf[hh][s] = run; } else for (int s = 127; s >= 0; --s) { run += c_a(a, b, c * 128 + s, h, 1); acb[hh][s] = run; } }
    __syncthreads();
    if (tid < 128) { float s = 0.f; for (int n = 0; n < 128; ++n) s += Cl[n] * c_convsilu(a, b, c * 128 + tid, 1536 + g * 128 + n); CBs[0][tid] = s; }
    __syncthreads();
    const int hh = tid / 64, p = tid % 64, h = g * HPG + hh; float y = 0.f;
    for (int s = 0; s < 128; ++s) { const float x = c_convsilu(a, b, c * 128 + s, h * 64 + p); float wgt = 0.f;
        if (s <= l) wgt += expf(acf[hh][l] - acf[hh][s]) * c_dt(a, b, c * 128 + s, h, 0);
        if (s >= l) wgt += expf(acb[hh][l] - acb[hh][s]) * c_dt(a, b, c * 128 + s, h, 1);
        y += CBs[0][s] * wgt * x; if (s == l) y += a.in[15][h] * x; }
    for (int d = 0; d < 2; ++d) { const size_t si_ = ((size_t)((b * NCHUNK + c) * HEADS + h) * 2 + d); float s = 0.f; for (int n = 0; n < 128; ++n) s += Cl[n] * c_prev(a, si_, p * 128 + n, h, d);
        y += s * expf(d ? acb[hh][l] : acf[hh][l]); }
    const size_t trow = (size_t)(b * SEQ + c * 128 + l);
    const float v = y * siluf_(bf2f(CW(bf16, WS_PROJ)[trow * PW + PC_Z + h * 64 + p])); red[tid] = v * v; __syncthreads();
    if (tid == 0) { float s = 0.f; for (int i = 0; i < 384; ++i) s += red[i]; red[0] = s; } __syncthreads();
    const float e = v / sqrtf(red[0] / 384.f + RMS_EPS), f = bf2f(CW(bf16, WS_YN)[trow * INNER + g * 384 + tid]);
    float num = (f - e) * (f - e), den = e * e; num = wave_sum(num); den = wave_sum(den);
    if ((tid & 63) == 0) { float* ew = (float*)(a.ws + WS_CTL) + CW_ERR + 2 * 7; atomicAdd(ew, num); atomicAdd(ew + 1, den); }
}
__global__ void chk9(CArgs a) {
    const unsigned sid = blockIdx.x * blockDim.x + threadIdx.x; const unsigned r = hsh(sid + 91u); const int m = r % T, col = (r >> 15) & 1023;
    const float y1 = c_dot_bf(CW(bf16, WS_YN) + (size_t)m * INNER, CW(bf16, WS_WBST) + (size_t)col * INNER, INNER), y2 = c_dot_bf(CW(bf16, WS_FO) + (size_t)m * 512, CW(bf16, WS_WBFT) + (size_t)col * 512, 512);
    const bf16* P = CW(bf16, WS_PROJ) + (size_t)m * PW; const float e = bfr(bf2f(P[PC_GS + col]) * y1) + bf2f(P[PC_GF + col]) * y2, f = bf2f(CW(bf16, WS_MIX)[(size_t)m * D + col]);
    chk_acc(a.ws, 9, (f - e) * (f - e), e * e);
}
__global__ void chk10(CArgs a) {
    const unsigned sid = blockIdx.x * blockDim.x + threadIdx.x; const unsigned r = hsh(sid + 101u); const int m = r % T, col = (r >> 15) & 1023;
    const float e = c_dot_bf(CW(bf16, WS_MIX) + (size_t)m * D, CW(bf16, WS_WOUTT) + (size_t)col * D, D), f = bf2f(CW(bf16, WS_MIXED)[(size_t)m * D + col]);
    chk_acc(a.ws, 10, (f - e) * (f - e), e * e);
}
__global__ void chk11(CArgs a) {
    const unsigned sid = blockIdx.x * blockDim.x + threadIdx.x; if (sid >= 4096) return; const unsigned r = hsh(sid + 111u);
    const int m = r % T, b = m / SEQ; const bf16* mx = CW(bf16, WS_MIXED) + (size_t)m * D; const float* mod = CW(float, WS_MOD) + b * 6144; const float* x = a.in[0] + (size_t)m * D;
    float ss = 0.f; for (int k = 0; k < D; ++k) ss += bf2f(mx[k]) * bf2f(mx[k]); const float rstd = 1.f / sqrtf(ss / D + RMS_EPS);
    float s2 = 0.f; for (int k = 0; k < D; ++k) { const float v = x[k] + mod[2048 + k] * (bf2f(mx[k]) * rstd * a.in[5][k]); s2 += v * v; } const float rstd2 = 1.f / sqrtf(s2 / D + RMS_EPS);
    float num = 0.f, den = 0.f;
    for (int q = 0; q < 8; ++q) { const int col = ((r >> 15) * 8 + q) & 1023; const float x1 = x[col] + mod[2048 + col] * (bf2f(mx[col]) * rstd * a.in[5][col]);
        const float f1 = a.out[(size_t)m * D + col]; num += (f1 - x1) * (f1 - x1); den += x1 * x1;
        const float e2 = x1 * rstd2 * a.in[6][col] * (1.f + mod[4096 + col]) + mod[3072 + col], f2 = bf2f(CW(bf16, WS_H)[(size_t)m * D + col]); num += (f2 - e2) * (f2 - e2); den += e2 * e2; }
    chk_acc(a.ws, 11, num, den);
}
__global__ void chk12(CArgs a) {
    const unsigned sid = blockIdx.x * blockDim.x + threadIdx.x; const unsigned r = hsh(sid + 121u); const int m = r % T, col = (r >> 15) & 255;
    const float e = c_dot_bf(CW(bf16, WS_H) + (size_t)m * D, CW(bf16, WS_WRT) + (size_t)col * D, D), f = CW(float, WS_LOG)[(size_t)m * NE + col];
    chk_acc(a.ws, 12, (f - e) * (f - e), e * e);
}
__global__ void chk13(CArgs a) {
    const unsigned sid = blockIdx.x * blockDim.x + threadIdx.x; if (sid >= 8192) return; const int t = hsh(sid + 131u) % T; const float* lg = CW(float, WS_LOG) + (size_t)t * NE;
    float gsc[8]; for (int g = 0; g < 8; ++g) { float m1 = -INFINITY, m2 = -INFINITY; for (int j = 0; j < 32; ++j) { const float v = 1.f / (1.f + expf(-lg[g * 32 + j])) + a.in[21][g * 32 + j]; if (v > m1) { m2 = m1; m1 = v; } else if (v > m2) m2 = v; } gsc[g] = m1 + m2; }
    unsigned gm = 0; for (int g = 0; g < 8; ++g) { int rank = 0; for (int j = 0; j < 8; ++j) rank += (gsc[j] > gsc[g] || (gsc[j] == gsc[g] && j < g)); if (rank < 4) gm |= 1u << g; }
    int idx[8]; float sc[8]; unsigned long long taken[4] = {0, 0, 0, 0}; float wsum = 0.f;
    for (int k = 0; k < 8; ++k) { float bv = -INFINITY; int bi = -1; for (int e = 0; e < 256; ++e) { if (!((gm >> (e >> 5)) & 1u) || ((taken[e >> 6] >> (e & 63)) & 1ull)) continue; const float v = 1.f / (1.f + expf(-lg[e])) + a.in[21][e]; if (v > bv) { bv = v; bi = e; } }
        idx[k] = bi; sc[k] = 1.f / (1.f + expf(-lg[bi])); wsum += sc[k]; taken[bi >> 6] |= 1ull << (bi & 63); }
    float num = 0.f, den = 8.f;
    for (int k = 0; k < 8; ++k) { if (CW(int, WS_TOPI)[t * 8 + k] != idx[k]) num += 1.f; const float e = sc[k] / wsum * 2.5f, f = CW(float, WS_TOPW)[t * 8 + k]; if (fabsf(e - f) > 1e-4f) num += 1.f; }
    chk_acc(a.ws, 13, num, den);
}
__global__ void chk14(CArgs a) {
    const unsigned sid = blockIdx.x * blockDim.x + threadIdx.x; const unsigned* ctl = (const unsigned*)(a.ws + WS_CTL); const int ntiles = (int)ctl[CW_NTILES], basesh = (int)ctl[CW_BASESH];
    float num = 0.f, den = 1.f;
    { const int t = sid % T, k = (sid / T) & 7; const int pos = CW(int, WS_TOKPOS)[t * 8 + k]; if (pos < T || pos >= ntiles * 256) num += 1.f; else { if (CW(int, WS_ROWTOK)[pos] != t) num += 1.f; if (CW(int, WS_TILEE)[pos >> 8] != CW(int, WS_TOPI)[t * 8 + k]) num += 1.f; } }
    for (int r = T + sid; r < ntiles * 256; r += gridDim.x * blockDim.x) { const int tk = CW(int, WS_ROWTOK)[r]; if (tk < 0 || tk >= T) num += 1.f; }
    if (sid == 0) { if (ntiles > MAXTILES || ntiles < T / 256 + 1024 || basesh != 0) num += 100.f; for (int t = 0; t < T / 256; ++t) if (CW(int, WS_TILEE)[t] != NE) num += 1.f; }
    chk_acc(a.ws, 14, num, den);
}
__global__ void chk15(CArgs a) {
    const unsigned sid = blockIdx.x * blockDim.x + threadIdx.x; const unsigned r = hsh(sid + 151u); const unsigned* ctl = (const unsigned*)(a.ws + WS_CTL); const int ntiles = (int)ctl[CW_NTILES];
    const int row = r % (ntiles * 256), j = (r >> 20) & 255, e_ = CW(int, WS_TILEE)[row >> 8], tok = row < T ? row : CW(int, WS_ROWTOK)[row];
    const float* w = (e_ < NE) ? a.in[22] + (size_t)e_ * 1024 * 512 : a.in[24]; const bf16* h = CW(bf16, WS_H) + (size_t)tok * D; float s1 = 0.f, s2 = 0.f;
    for (int k = 0; k < D; ++k) { const float hv = bf2f(h[k]); s1 += hv * bfr(w[(size_t)k * 512 + j]); s2 += hv * bfr(w[(size_t)k * 512 + 256 + j]); }
    const float e = siluf_(s1) * s2, f = bf2f(CW(bf16, WS_HB)[(size_t)row * EH + j]); chk_acc(a.ws, 15, (f - e) * (f - e), e * e);
}
__global__ void chk16(CArgs a) {
    const unsigned sid = blockIdx.x * blockDim.x + threadIdx.x; const unsigned r = hsh(sid + 161u); const unsigned* ctl = (const unsigned*)(a.ws + WS_CTL); const int ntiles = (int)ctl[CW_NTILES];
    const int row = r % (ntiles * 256), col = (r >> 20) & 1023, e_ = CW(int, WS_TILEE)[row >> 8];
    const float* w = (e_ < NE) ? a.in[23] + (size_t)e_ * 256 * 1024 : a.in[25]; const bf16* h = CW(bf16, WS_HB) + (size_t)row * EH; float s = 0.f;
    for (int k = 0; k < EH; ++k) s += bf2f(h[k]) * bfr(w[(size_t)k * 1024 + col]);
    const int nv = CW(int, WS_TILEV)[row >> 8]; if ((row & 255) >= nv) { chk_acc(a.ws, 16, 0.f, 0.f); return; }
    const unsigned wv = CW(unsigned, WS_YB)[((size_t)row * D + col) >> 2]; const int bs = col & 3;
    const float f = (bs == 0 ? __builtin_amdgcn_cvt_f32_fp8((int)wv, 0) : bs == 1 ? __builtin_amdgcn_cvt_f32_fp8((int)wv, 1) : bs == 2 ? __builtin_amdgcn_cvt_f32_fp8((int)wv, 2) : __builtin_amdgcn_cvt_f32_fp8((int)wv, 3)) * (1.f / YB_SCALE);
    chk_acc(a.ws, 16, (f - s) * (f - s), s * s);
}
__global__ void chk_verdict(CArgs a) {
    const float* e = (const float*)(a.ws + WS_CTL) + CW_ERR; const unsigned* ctl = (const unsigned*)(a.ws + WS_CTL); int bad = -1;
    for (int k = 0; k < 17; ++k) { const float num = e[2 * k], den = e[2 * k + 1]; if (k == 8) continue; const float tol = (k == 16 || k == 3 || k == 5) ? 1e-2f : 2e-3f; if (!(num <= tol * den) || !(den > 0.f)) { bad = k; break; } }
    if (ctl[CW_BAR + XB_TMO]) bad = 27;
    if (bad < 0) return; const float al = 3.f + bad;
    for (size_t i = (size_t)blockIdx.x * blockDim.x + threadIdx.x; i < (size_t)T * D; i += (size_t)gridDim.x * blockDim.x) a.out[i] = al * a.in[0][i];
}
#endif
#if EMIT_AFTER >= 0
__global__ void emit_k(CArgs a, int k) {
    const unsigned* ctl = (const unsigned*)(a.ws + WS_CTL);
    for (size_t i = (size_t)blockIdx.x * blockDim.x + threadIdx.x; i < (size_t)T * D; i += (size_t)gridDim.x * blockDim.x) {
        const int t = (int)(i >> 10), c = (int)(i & 1023); float v = 0.f;
        if (k == 1) v = bf2f(CW(bf16, WS_H)[i]) + CW(float, WS_MOD)[(t & 3) * 6144 + c] + bf2f(CW(bf16, WS_WINT)[(size_t)(t % NPROJ) * 1024 + c]) + bf2f(CW(bf16, WS_W13T)[(size_t)t * 4009 * 1024 % ((size_t)NEX * 512 * 1024) + c]);
        if (k == 2) { for (int q = 0; q < 6; ++q) v += bf2f(CW(bf16, WS_PROJ)[(size_t)t * PW + q * 1024 + c]); if ((c & 63) < 48) v += CW(float, WS_DT)[(size_t)t * 64 + (c & 63)]; }
        if (k == 20) v = bf2f(CW(bf16, WS_PROJ)[(size_t)t * PW + PC_U + (c & 511)]);
        if (k == 21) v = bf2f(CW(bf16, WS_WINT)[(size_t)(PC_U + (t & 511)) * 1024 + c]) + bf2f(CW(bf16, WS_WM1)[(i & 16383)]) + CW(f32x2, WS_TW)[i & 8191].x + CW(f32x2, WS_TW)[i & 8191].y;
        if (k == 3) { v = bf2f(CW(bf16, WS_ST)[i]) + bf2f(CW(bf16, WS_ST)[i + (size_t)T * D]) + bf2f(CW(bf16, WS_ST)[i + 2 * (size_t)T * D]); }
        if (k == 5) { v = bf2f(CW(bf16, WS_ST)[i]) + bf2f(CW(bf16, WS_ST)[i + (size_t)T * D]) + bf2f(CW(bf16, WS_ST)[i + 2 * (size_t)T * D]); }
        if (k == 4) v = a.in[0][i] + 1000.f * (bf2f(CW(bf16, WS_GB)[i]) - bf2f(CW(bf16, WS_MIX)[i]));
        if (k == 6) v = bf2f(CW(bf16, WS_GB)[i]) + bf2f(CW(bf16, WS_FO)[(size_t)t * 512 + (c & 511)]);
        if (k == 7) v = bf2f(CW(bf16, WS_YN)[(size_t)t * INNER + c]) + bf2f(CW(bf16, WS_YN)[(size_t)t * INNER + 512 + c]);
        if (k == 9) v = bf2f(CW(bf16, WS_MIX)[i]);
        if (k == 10) v = bf2f(CW(bf16, WS_MIXED)[i]);
        if (k == 12) v = CW(float, WS_LOG)[(size_t)t * 256 + (c & 255)] + bf2f(CW(bf16, WS_H)[i]) + a.out[i];
        if (k == 13) v = (float)CW(int, WS_TOPI)[t * 8 + (c & 7)] + CW(float, WS_TOPW)[t * 8 + (c & 7)];
        if (k == 15) { for (int q = 0; q < 8; ++q) v += bf2f(CW(bf16, WS_HB)[(size_t)CW(int, WS_TOKPOS)[t * 8 + q] * EH + (c & 255)]); v += bf2f(CW(bf16, WS_HB)[(size_t)(ctl[CW_BASESH] + t) * EH + (c & 255)]); }
        if (k == 16) { for (int q = 0; q < 8; ++q) v += CW(float, WS_TOPW)[t * 8 + q] * bf2f(CW(bf16, WS_YB)[(size_t)CW(int, WS_TOKPOS)[t * 8 + q] * D + c]); v += bf2f(CW(bf16, WS_YB)[(size_t)(ctl[CW_BASESH] + t) * D + c]); }
        a.out[i] = v;
    }
}
#endif
template <int K> static void launch_phase(const Args& a, int grid, hipStream_t stream) {
    static bool attr = false;
    if (!attr) { (void)hipFuncSetAttribute((const void*)fwd<K, K + 1>, hipFuncAttributeMaxDynamicSharedMemorySize, LDS_BYTES); attr = true; }
    hipLaunchKernelGGL((fwd<K, K + 1>), dim3(grid), dim3(NTHR), LDS_BYTES, stream, a);
}
extern "C" void kernel_launch(void* const* d_in, const int* in_sizes, int n_in, void* d_out, int out_size, void* d_ws, size_t ws_size, hipStream_t stream) {
    static int grid = 0;
    if (grid == 0) {
        if (n_in != 26 || out_size != T * D || ws_size < WS_END) { fprintf(stderr, "kernel_launch: unexpected shapes (n_in %d, out %d, ws %zu < %zu)\n", n_in, out_size, ws_size, (size_t)WS_END); grid = -1; return; }
        int dev = 0, cus = 0;
        if (hipGetDevice(&dev) != hipSuccess || hipDeviceGetAttribute(&cus, hipDeviceAttributeMultiprocessorCount, dev) != hipSuccess) { grid = -1; return; }
#if !MULTI_LAUNCH
        if (hipFuncSetAttribute((const void*)fwd<0, NPH>, hipFuncAttributeMaxDynamicSharedMemorySize, LDS_BYTES) != hipSuccess) { fprintf(stderr, "kernel_launch: hipFuncSetAttribute failed\n"); grid = -1; return; }
        int per_cu = 0; (void)hipOccupancyMaxActiveBlocksPerMultiprocessor(&per_cu, (const void*)fwd<0, NPH>, NTHR, LDS_BYTES); (void)hipGetLastError();
        if (per_cu < 1) fprintf(stderr, "kernel_launch: note: occupancy query reports %d\n", per_cu);
#endif
        grid = cus;
    }
    if (grid < 0) return;
    (void)hipMemsetAsync((char*)d_ws + WS_CTL, 0, CTL_ZERO_BYTES, stream);
    Args a{};
    for (int i = 0; i < 26; ++i) a.in[i] = (const float*)d_in[i];
    a.out = (float*)d_out; a.ws = (unsigned char*)d_ws;
#if MULTI_LAUNCH
#if DEV_CHECKS
    CArgs ca{}; for (int i = 0; i < 26; ++i) ca.in[i] = a.in[i]; ca.out = a.out; ca.ws = a.ws;
#define CHK(k, g, b) hipLaunchKernelGGL(chk##k, dim3(g), dim3(b), 0, stream, ca)
#else
#define CHK(k, g, b) do {} while (0)
#endif
#if PRE_K >= 0
    { launch_phase<0>(a, grid, stream);
      if (PRE_K >= 1) launch_phase<1>(a, grid, stream);
      if (PRE_K >= 2) launch_phase<2>(a, grid, stream);
      if (PRE_K >= 3) launch_phase<3>(a, grid, stream);
      if (PRE_K >= 4) launch_phase<4>(a, grid, stream);
      if (PRE_K >= 5) launch_phase<5>(a, grid, stream);
      if (PRE_K >= 6) launch_phase<6>(a, grid, stream);
      if (PRE_K >= 7) launch_phase<7>(a, grid, stream);
      if (PRE_K >= 8) launch_phase<8>(a, grid, stream);
      if (PRE_K >= 9) launch_phase<9>(a, grid, stream);
      if (PRE_K >= 10) launch_phase<10>(a, grid, stream);
      if (PRE_K >= 11) launch_phase<11>(a, grid, stream);
      if (PRE_K >= 12) launch_phase<12>(a, grid, stream);
      if (PRE_K >= 13) launch_phase<13>(a, grid, stream);
      if (PRE_K >= 14) launch_phase<14>(a, grid, stream);
      if (PRE_K >= 15) launch_phase<15>(a, grid, stream);
      if (PRE_K >= 16) launch_phase<16>(a, grid, stream); }
#endif
    launch_phase<0>(a, grid, stream); CHK(0, 256, 256);
#if (DUP_MASK >> 0) & 1
    launch_phase<0>(a, grid, stream);
#endif
#if EMIT_AFTER == 0
    { CArgs ce{}; for (int i = 0; i < 26; ++i) ce.in[i] = a.in[i]; ce.out = a.out; ce.ws = a.ws; hipLaunchKernelGGL(emit_k, dim3(2048), dim3(256), 0, stream, ce, 0); return; }
#endif
    launch_phase<1>(a, grid, stream); CHK(1, 16, 256);
#if (DUP_MASK >> 1) & 1
    launch_phase<1>(a, grid, stream);
#endif
#if EMIT_AFTER == 1
    { CArgs ce{}; for (int i = 0; i < 26; ++i) ce.in[i] = a.in[i]; ce.out = a.out; ce.ws = a.ws; hipLaunchKernelGGL(emit_k, dim3(2048), dim3(256), 0, stream, ce, 1); return; }
#endif
    launch_phase<2>(a, grid, stream); CHK(2, 256, 256);
#if (DUP_MASK >> 2) & 1
    launch_phase<2>(a, grid, stream);
#endif
#if EMIT_AFTER == 20 || EMIT_AFTER == 21
    { CArgs ce{}; for (int i = 0; i < 26; ++i) ce.in[i] = a.in[i]; ce.out = a.out; ce.ws = a.ws; hipLaunchKernelGGL(emit_k, dim3(2048), dim3(256), 0, stream, ce, EMIT_AFTER); return; }
#endif
#if EMIT_AFTER == 2
    { CArgs ce{}; for (int i = 0; i < 26; ++i) ce.in[i] = a.in[i]; ce.out = a.out; ce.ws = a.ws; hipLaunchKernelGGL(emit_k, dim3(2048), dim3(256), 0, stream, ce, 2); return; }
#endif
#if EMIT_AFTER != 4
    launch_phase<3>(a, grid, stream); CHK(3, 32, 256);
#if (DUP_MASK >> 3) & 1
    launch_phase<3>(a, grid, stream);
#endif
#endif
#if EMIT_AFTER == 3
    { CArgs ce{}; for (int i = 0; i < 26; ++i) ce.in[i] = a.in[i]; ce.out = a.out; ce.ws = a.ws; hipLaunchKernelGGL(emit_k, dim3(2048), dim3(256), 0, stream, ce, 3); return; }
#endif
    launch_phase<4>(a, grid, stream); CHK(4, 256, 256);
#if (DUP_MASK >> 4) & 1
    launch_phase<4>(a, grid, stream);
#endif
#if EMIT_AFTER == 4
    (void)hipMemcpyAsync((char*)d_ws + WS_MIX, (char*)d_ws + WS_GB, (size_t)T * D * 2, hipMemcpyDeviceToDevice, stream); launch_phase<4>(a, grid, stream);
    { CArgs ce{}; for (int i = 0; i < 26; ++i) ce.in[i] = a.in[i]; ce.out = a.out; ce.ws = a.ws; hipLaunchKernelGGL(emit_k, dim3(2048), dim3(256), 0, stream, ce, 4); return; }
#endif
    launch_phase<5>(a, grid, stream); CHK(5, 32, 256);
#if (DUP_MASK >> 5) & 1
    launch_phase<5>(a, grid, stream);
#endif
#if EMIT_AFTER == 5
    { CArgs ce{}; for (int i = 0; i < 26; ++i) ce.in[i] = a.in[i]; ce.out = a.out; ce.ws = a.ws; hipLaunchKernelGGL(emit_k, dim3(2048), dim3(256), 0, stream, ce, 5); return; }
#endif
    launch_phase<6>(a, grid, stream); CHK(6, 256, 256);
#if (DUP_MASK >> 6) & 1
    launch_phase<6>(a, grid, stream);
#endif
#if EMIT_AFTER == 6
    { CArgs ce{}; for (int i = 0; i < 26; ++i) ce.in[i] = a.in[i]; ce.out = a.out; ce.ws = a.ws; hipLaunchKernelGGL(emit_k, dim3(2048), dim3(256), 0, stream, ce, 6); return; }
#endif
    launch_phase<7>(a, grid, stream); CHK(7, 256, 384);
#if (DUP_MASK >> 7) & 1
    launch_phase<7>(a, grid, stream);
#endif
#if EMIT_AFTER == 7
    { CArgs ce{}; for (int i = 0; i < 26; ++i) ce.in[i] = a.in[i]; ce.out = a.out; ce.ws = a.ws; hipLaunchKernelGGL(emit_k, dim3(2048), dim3(256), 0, stream, ce, 7); return; }
#endif
    launch_phase<8>(a, grid, stream);
#if (DUP_MASK >> 8) & 1
    launch_phase<8>(a, grid, stream);
#endif
#if EMIT_AFTER == 8
    { CArgs ce{}; for (int i = 0; i < 26; ++i) ce.in[i] = a.in[i]; ce.out = a.out; ce.ws = a.ws; hipLaunchKernelGGL(emit_k, dim3(2048), dim3(256), 0, stream, ce, 8); return; }
#endif
    launch_phase<9>(a, grid, stream); CHK(9, 256, 256);
#if (DUP_MASK >> 9) & 1
    launch_phase<9>(a, grid, stream);
#endif
#if EMIT_AFTER == 9
    { CArgs ce{}; for (int i = 0; i < 26; ++i) ce.in[i] = a.in[i]; ce.out = a.out; ce.ws = a.ws; hipLaunchKernelGGL(emit_k, dim3(2048), dim3(256), 0, stream, ce, 9); return; }
#endif
    launch_phase<10>(a, grid, stream); CHK(10, 256, 256);
#if (DUP_MASK >> 10) & 1
    launch_phase<10>(a, grid, stream);
#endif
#if EMIT_AFTER == 10
    { CArgs ce{}; for (int i = 0; i < 26; ++i) ce.in[i] = a.in[i]; ce.out = a.out; ce.ws = a.ws; hipLaunchKernelGGL(emit_k, dim3(2048), dim3(256), 0, stream, ce, 10); return; }
#endif
    launch_phase<11>(a, grid, stream); CHK(11, 16, 256);
#if (DUP_MASK >> 11) & 1
    launch_phase<11>(a, grid, stream);
#endif
#if EMIT_AFTER == 11
    { CArgs ce{}; for (int i = 0; i < 26; ++i) ce.in[i] = a.in[i]; ce.out = a.out; ce.ws = a.ws; hipLaunchKernelGGL(emit_k, dim3(2048), dim3(256), 0, stream, ce, 11); return; }
#endif
    launch_phase<12>(a, grid, stream); CHK(12, 256, 256);
#if (DUP_MASK >> 12) & 1
    launch_phase<12>(a, grid, stream);
#endif
#if EMIT_AFTER == 12
    { CArgs ce{}; for (int i = 0; i < 26; ++i) ce.in[i] = a.in[i]; ce.out = a.out; ce.ws = a.ws; hipLaunchKernelGGL(emit_k, dim3(2048), dim3(256), 0, stream, ce, 12); return; }
#endif
    launch_phase<13>(a, grid, stream); CHK(13, 32, 256);
#if (DUP_MASK >> 13) & 1
    launch_phase<13>(a, grid, stream);
#endif
#if EMIT_AFTER == 13
    { CArgs ce{}; for (int i = 0; i < 26; ++i) ce.in[i] = a.in[i]; ce.out = a.out; ce.ws = a.ws; hipLaunchKernelGGL(emit_k, dim3(2048), dim3(256), 0, stream, ce, 13); return; }
#endif
    launch_phase<14>(a, grid, stream); CHK(14, 1024, 256);
#if (DUP_MASK >> 14) & 1
    launch_phase<14>(a, grid, stream);
#endif
#if EMIT_AFTER == 14
    { CArgs ce{}; for (int i = 0; i < 26; ++i) ce.in[i] = a.in[i]; ce.out = a.out; ce.ws = a.ws; hipLaunchKernelGGL(emit_k, dim3(2048), dim3(256), 0, stream, ce, 14); return; }
#endif
    launch_phase<15>(a, grid, stream); CHK(15, 256, 256);
#if (DUP_MASK >> 15) & 1
    launch_phase<15>(a, grid, stream);
#endif
#if EMIT_AFTER == 15
    { CArgs ce{}; for (int i = 0; i < 26; ++i) ce.in[i] = a.in[i]; ce.out = a.out; ce.ws = a.ws; hipLaunchKernelGGL(emit_k, dim3(2048), dim3(256), 0, stream, ce, 15); return; }
#endif
    launch_phase<16>(a, grid, stream); CHK(16, 256, 256);
#if (DUP_MASK >> 16) & 1
    launch_phase<16>(a, grid, stream);
#endif
#if EMIT_AFTER == 16
    { CArgs ce{}; for (int i = 0; i < 26; ++i) ce.in[i] = a.in[i]; ce.out = a.out; ce.ws = a.ws; hipLaunchKernelGGL(emit_k, dim3(2048), dim3(256), 0, stream, ce, 16); return; }
#endif
    launch_phase<17>(a, grid, stream);
#if (DUP_MASK >> 17) & 1
    launch_phase<17>(a, grid, stream);
#endif
#if EMIT_AFTER == 17
    { CArgs ce{}; for (int i = 0; i < 26; ++i) ce.in[i] = a.in[i]; ce.out = a.out; ce.ws = a.ws; hipLaunchKernelGGL(emit_k, dim3(2048), dim3(256), 0, stream, ce, 17); return; }
#endif
#if DEV_CHECKS
    hipLaunchKernelGGL(chk_verdict, dim3(1024), dim3(256), 0, stream, ca);
#endif
#else
    hipLaunchKernelGGL((fwd<0, NPH>), dim3(grid), dim3(NTHR), LDS_BYTES, stream, a);
#endif
}
```

```cpp
#include <hip/hip_runtime.h>
#include <cstdio>
#include <cstdint>
#include <cmath>
#define MULTI_LAUNCH 0
#define DEV_CHECKS 0
#define EMIT_AFTER -1
#define DFT_DEBUG 0
#define KSTART_INV 0
#define DUP_MASK 0
#define TIMING 0
#define TA_LO 0
#define TA_HI 0
#define TB_LO 0
#define TB_HI 0
#define PRE_K -1
namespace pg8 {
#define PG8_LAS __attribute__((address_space(3)))
#define PG8_GAS __attribute__((address_space(1)))
typedef unsigned short bf16_t;
typedef short bf16x8 __attribute__((ext_vector_type(8)));
typedef float f32x4 __attribute__((ext_vector_type(4)));
typedef unsigned u32x4 __attribute__((ext_vector_type(4)));
typedef unsigned u32x2 __attribute__((ext_vector_type(2)));
constexpr int BM = 256, BK = 64, HALF = 128, HTB = HALF * BK * 2  , STAGE_BYTES = 8 * HTB, NXCD = 8, WGM = 4;

__host__ __device__ __forceinline__ int lds_byte(int r, int c) { const int st = (r >> 4) * 2 + (c >> 5), rr = r & 15, cc = c & 31, ob = rr * 64 + cc * 2; return st * 1024 + (ob ^ (((ob >> 9) & 1) << 5)); }
__host__ __device__ __forceinline__ void stage_rc(int b, int& R, int& C) { const int st = b / 1024, sb = b % 1024, swz = sb ^ (((sb >> 9) & 1) << 5); R = (st >> 1) * 16 + swz / 64; C = (st & 1) * 32 + (swz % 64) / 2; }
__host__ __device__ __forceinline__ int perm32(int rho) { const int n = rho >> 4, i = rho & 15; return 8 * (i >> 2) + 4 * n + (i & 3); }

struct Unit { int pm, pn; };
struct Gemm { const bf16_t* A; const bf16_t* Bt; int M, N, K; const int* rowtok; };

struct StaticOrder {
    int nM, nN, nwg, G, c;
    __host__ __device__ void init(int M, int N, int G_, int c_) { nM = M / BM; nN = N / BM; nwg = nM * nN; G = G_; c = c_; }
    __host__ __device__ bool next(int i, Unit& u) const {
        const long L = (long)i * G + c; if (L >= nwg) return false;
        int wgid = (int)L; { const int q = nwg / NXCD, r = nwg % NXCD, xcd = wgid % NXCD, off = wgid / NXCD; wgid = (xcd < r ? xcd * (q + 1) : r * (q + 1) + (xcd - r) * q) + off; }
        const int nig = WGM * nN, gid = wgid / nig, fm = gid * WGM, gsz = (nM - fm) < WGM ? (nM - fm) : WGM;
        u.pm = fm + ((wgid % nig) % gsz); u.pn = (wgid % nig) / gsz; return true;
    }
};
template <int NJ> struct GroupedOrder {
    const PG8_LAS int* tile_e; int ntiles, G, c, t0;
    __device__ bool next(int i, Unit& u) const {
        int t, j;
        if ((G & 7) == 0 && ((G >> 3) % NJ) == 0) { const int x = c & 7, slot = c >> 3, tpx = (G >> 3) / NJ; t = (i * 8 + x) * tpx + slot / NJ; j = slot % NJ; }
        else { const int L = i * G + c; t = L / NJ; j = L % NJ; }
        t += t0; if (t >= ntiles) return false;
        u.pm = t; u.pn = __builtin_amdgcn_readfirstlane(tile_e[t]) * NJ + j; return true;
    }
};

struct SharedOrder {
    int nt, e, c0, nb, c;
    __device__ bool next(int i, Unit& u) const { const int L = i * nb + (c - c0); if (c < c0 || L >= nt * 2) return false; u.pm = L >> 1; u.pn = e * 2 + (L & 1); return true; }
};
__device__ __forceinline__ unsigned cvt_pk_bf16(float lo, float hi) { unsigned r; asm volatile("v_cvt_pk_bf16_f32 %0, %1, %2" : "=v"(r) : "v"(lo), "v"(hi)); return r; }
__device__ __forceinline__ float bf_lo(unsigned w) { return __uint_as_float(w << 16); }
__device__ __forceinline__ float bf_hi(unsigned w) { return __uint_as_float(w & 0xffff0000u); }
__device__ __forceinline__ float sigmoidf_(float x) { return __builtin_amdgcn_rcpf(1.f + __expf(-x)); }

struct EpiF32 {
    static constexpr bool PERM = false;
    float* C; int ldc;
    __device__ __forceinline__ int operator()(const f32x4 (&acc)[2][2][4][2], const Unit& u, int wr, int wc, int fr, int fq) const {
        const int row0 = u.pm * BM + wr * 64 + fr, col0 = u.pn * BM + wc * 32 + 4 * fq;
#pragma unroll
        for (int ai = 0; ai < 2; ++ai)
#pragma unroll
            for (int m = 0; m < 4; ++m) { float* rowp = C + (size_t)(row0 + ai * HALF + m * 16) * ldc + col0;
#pragma unroll
                for (int bj = 0; bj < 2; ++bj)
#pragma unroll
                    for (int n = 0; n < 2; ++n) *(PG8_GAS f32x4*)(rowp + bj * HALF + n * 16) = acc[ai][bj][m][n]; }
        return 32;
    }
};
template <int NCOLT> struct EpiBf16 {
    static constexpr bool PERM = true;
    bf16_t* O; int ldc;
    __device__ __forceinline__ int operator()(const f32x4 (&acc)[2][2][4][2], const Unit& u, int wr, int wc, int fr, int fq) const {
        const int row0 = u.pm * BM + wr * 64 + fr; const int col0 = (u.pn & (NCOLT - 1)) * BM + wc * 32 + 8 * fq;
#pragma unroll
        for (int ai = 0; ai < 2; ++ai)
#pragma unroll
            for (int m = 0; m < 4; ++m) { bf16_t* rowp = O + (size_t)(row0 + ai * HALF + m * 16) * ldc + col0;
#pragma unroll
                for (int bj = 0; bj < 2; ++bj) { const f32x4 v0 = acc[ai][bj][m][0], v1 = acc[ai][bj][m][1];
                    u32x4 w; w.x = cvt_pk_bf16(v0[0], v0[1]); w.y = cvt_pk_bf16(v0[2], v0[3]); w.z = cvt_pk_bf16(v1[0], v1[1]); w.w = cvt_pk_bf16(v1[2], v1[3]);
                    *(PG8_GAS u32x4*)(rowp + bj * HALF) = w; } }
        return 16;
    }
};
template <int NCOLT> struct EpiFp8 {
    static constexpr bool PERM = true;
    unsigned char* O; int ldc; const PG8_LAS int* valid; float scale;
    __device__ __forceinline__ int operator()(const f32x4 (&acc)[2][2][4][2], const Unit& u, int wr, int wc, int fr, int fq) const {
        const int rl0 = wr * 64 + fr, nv = valid[u.pm]; const int col0 = (u.pn & (NCOLT - 1)) * BM + wc * 32 + 8 * fq;
#pragma unroll
        for (int ai = 0; ai < 2; ++ai)
#pragma unroll
            for (int m = 0; m < 4; ++m) { const int rl = rl0 + ai * HALF + m * 16; if (rl < nv) { unsigned char* rowp = O + (size_t)(u.pm * BM + rl) * ldc + col0;
#pragma unroll
                for (int bj = 0; bj < 2; ++bj) { const f32x4 v0 = acc[ai][bj][m][0] * scale, v1 = acc[ai][bj][m][1] * scale;
                    int w0 = __builtin_amdgcn_cvt_pk_fp8_f32(v0[0], v0[1], 0, false); w0 = __builtin_amdgcn_cvt_pk_fp8_f32(v0[2], v0[3], w0, true);
                    int w1 = __builtin_amdgcn_cvt_pk_fp8_f32(v1[0], v1[1], 0, false); w1 = __builtin_amdgcn_cvt_pk_fp8_f32(v1[2], v1[3], w1, true);
                    u32x2 w; w.x = (unsigned)w0; w.y = (unsigned)w1; *(PG8_GAS u32x2*)(rowp + bj * HALF) = w; } } }
        return nv >= BM ? 16 : 0;
    }
};
struct EpiProj {
    static constexpr bool PERM = true;
    bf16_t* O; int ldc; float* DT; int sig0, ndat;
    __device__ __forceinline__ int operator()(const f32x4 (&acc)[2][2][4][2], const Unit& u, int wr, int wc, int fr, int fq) const {
        const int row0 = u.pm * BM + wr * 64 + fr;
        if (u.pn < ndat) {
            const int col0 = u.pn * BM + wc * 32 + 8 * fq; const bool sg = u.pn >= sig0;
#pragma unroll
            for (int ai = 0; ai < 2; ++ai)
#pragma unroll
                for (int m = 0; m < 4; ++m) { bf16_t* rowp = O + (size_t)(row0 + ai * HALF + m * 16) * ldc + col0;
#pragma unroll
                    for (int bj = 0; bj < 2; ++bj) { f32x4 v0 = acc[ai][bj][m][0], v1 = acc[ai][bj][m][1];
                        if (sg) {
#pragma unroll
                            for (int j = 0; j < 4; ++j) { v0[j] = sigmoidf_(v0[j]); v1[j] = sigmoidf_(v1[j]); } }
                        u32x4 w; w.x = cvt_pk_bf16(v0[0], v0[1]); w.y = cvt_pk_bf16(v0[2], v0[3]); w.z = cvt_pk_bf16(v1[0], v1[1]); w.w = cvt_pk_bf16(v1[2], v1[3]);
                        *(PG8_GAS u32x4*)(rowp + bj * HALF) = w; } }
        } else {
            const int c0 = wc * 32 + 8 * fq;
            if (c0 + 7 < 48) {
#pragma unroll
                for (int ai = 0; ai < 2; ++ai)
#pragma unroll
                    for (int m = 0; m < 4; ++m) { float* rowp = DT + (size_t)(row0 + ai * HALF + m * 16) * 64 + c0;
                        *(PG8_GAS f32x4*)(rowp) = acc[ai][0][m][0]; *(PG8_GAS f32x4*)(rowp + 4) = acc[ai][0][m][1]; }
            }
        }
        return u.pn < ndat ? 16 : 0;
    }
};
template <bool ADD> struct EpiGate {
    static constexpr bool PERM = true;
    bf16_t* O; int ldc; const bf16_t* G; int ldg; int gcol0;
    __device__ __forceinline__ int operator()(const f32x4 (&acc)[2][2][4][2], const Unit& u, int wr, int wc, int fr, int fq) const {
        const int row0 = u.pm * BM + wr * 64 + fr; const int col0 = u.pn * BM + wc * 32 + 8 * fq;
#pragma unroll
        for (int ai = 0; ai < 2; ++ai)
#pragma unroll
            for (int m = 0; m < 4; ++m) { const size_t r = (size_t)(row0 + ai * HALF + m * 16); bf16_t* rowp = O + r * ldc + col0; const bf16_t* gp = G + r * ldg + gcol0 + col0;
#pragma unroll
                for (int bj = 0; bj < 2; ++bj) { const f32x4 v0 = acc[ai][bj][m][0], v1 = acc[ai][bj][m][1];
                    const u32x4 gw = *(const PG8_GAS u32x4*)(gp + bj * HALF);
                    float o[8] = { v0[0] * bf_lo(gw.x), v0[1] * bf_hi(gw.x), v0[2] * bf_lo(gw.y), v0[3] * bf_hi(gw.y), v1[0] * bf_lo(gw.z), v1[1] * bf_hi(gw.z), v1[2] * bf_lo(gw.w), v1[3] * bf_hi(gw.w) };
                    if (ADD) { const u32x4 pw = *(const PG8_GAS u32x4*)(rowp + bj * HALF);
                        o[0] += bf_lo(pw.x); o[1] += bf_hi(pw.x); o[2] += bf_lo(pw.y); o[3] += bf_hi(pw.y); o[4] += bf_lo(pw.z); o[5] += bf_hi(pw.z); o[6] += bf_lo(pw.w); o[7] += bf_hi(pw.w); }
                    u32x4 w; w.x = cvt_pk_bf16(o[0], o[1]); w.y = cvt_pk_bf16(o[2], o[3]); w.z = cvt_pk_bf16(o[4], o[5]); w.w = cvt_pk_bf16(o[6], o[7]);
                    *(PG8_GAS u32x4*)(rowp + bj * HALF) = w; } }
        return 16;
    }
};
struct EpiSwiglu {
    static constexpr bool PERM = true;
    bf16_t* O; int ldc;
    __device__ __forceinline__ int operator()(const f32x4 (&acc)[2][2][4][2], const Unit& u, int wr, int wc, int fr, int fq) const {
        const int row0 = u.pm * BM + wr * 64 + fr; const int col0 = (u.pn & 1) * HALF + wc * 32 + 8 * fq;
#pragma unroll
        for (int ai = 0; ai < 2; ++ai)
#pragma unroll
            for (int m = 0; m < 4; ++m) { bf16_t* rowp = O + (size_t)(row0 + ai * HALF + m * 16) * ldc + col0;
                float o[8];
#pragma unroll
                for (int n = 0; n < 2; ++n)
#pragma unroll
                    for (int j = 0; j < 4; ++j) { const float a = acc[ai][0][m][n][j], gg = acc[ai][1][m][n][j]; o[4 * n + j] = a * sigmoidf_(a) * gg; }
                u32x4 w; w.x = cvt_pk_bf16(o[0], o[1]); w.y = cvt_pk_bf16(o[2], o[3]); w.z = cvt_pk_bf16(o[4], o[5]); w.w = cvt_pk_bf16(o[6], o[7]);
                *(PG8_GAS u32x4*)(rowp) = w; }
        return 8;
    }
};

template <class Epi, class Sched, bool ALIGN_EPI, bool GATHER>
__device__ __forceinline__ void gemm_phase(PG8_LAS unsigned char* lds, const Gemm g, const Sched& S, const Epi& E) {
    int tid_ = threadIdx.x; asm volatile("" : "+v"(tid_));
    const int tid = tid_, wid = __builtin_amdgcn_readfirstlane(tid >> 6), lane = tid & 63, wr = wid >> 2, wc = wid & 3, fr = lane & 15, fq = lane >> 4;
    const int K = g.K, nt = K / BK;
    unsigned voffA[2], voffB[2];
#pragma unroll
    for (int i = 0; i < 2; ++i) { int R, C; stage_rc(tid * 16 + i * 8192, R, C); const int Rb = Epi::PERM ? ((R & ~31) + perm32(R & 31)) : R;
        voffA[i] = (unsigned)(R * K + C) * 2u; voffB[i] = (unsigned)(Rb * K + C) * 2u; }
    const size_t kstep = (size_t)(BK * 2);
    const size_t hstep = (size_t)HALF * K * 2;
    const size_t tstep = 2 * hstep;
    const unsigned rowB = (unsigned)K * 2u;
    const unsigned ldsw = (unsigned)wid * 1024u;
    const int aoff = lds_byte(wr * 64 + fr, fq * 8), boff = lds_byte(wc * 32 + fr, fq * 8);
#define PG8_SA(b, h) (((b) * 2 + (h)) * HTB)
#define PG8_SB(b, h) ((4 + (b) * 2 + (h)) * HTB)
#define PG8_STAGE(bufoff, gbase, voff) do { _Pragma("unroll") for (int _i = 0; _i < 2; ++_i) \
        __builtin_amdgcn_global_load_lds((const unsigned*)((const char*)(gbase) + (voff)[_i]), (PG8_LAS unsigned*)(lds + (bufoff) + ldsw + _i * 8192), 16, 0, 0); } while (0)
#define PG8_STAGE_A(bufoff, ptr_ng, offs, h, kb) do { _Pragma("unroll") for (int _i = 0; _i < 2; ++_i) { const char* _src; \
        if constexpr (GATHER) _src = (const char*)g.A + (size_t)(offs)[h][_i] + (size_t)(kb); else _src = (const char*)(ptr_ng) + voffA[_i]; \
        __builtin_amdgcn_global_load_lds((const unsigned*)_src, (PG8_LAS unsigned*)(lds + (bufoff) + ldsw + _i * 8192), 16, 0, 0); } } while (0)
#define PG8_LDA(dst, b, h) do { _Pragma("unroll") for (int m = 0; m < 4; ++m) _Pragma("unroll") for (int k = 0; k < 2; ++k) dst[m][k] = *(const PG8_LAS bf16x8*)(lds + PG8_SA(b, h) + aoff + m * 2048 + k * 1024); } while (0)
#define PG8_LDB(dst, b, h) do { _Pragma("unroll") for (int n = 0; n < 2; ++n) _Pragma("unroll") for (int k = 0; k < 2; ++k) dst[n][k] = *(const PG8_LAS bf16x8*)(lds + PG8_SB(b, h) + boff + n * 2048 + k * 1024); } while (0)
#define PG8_MMA(ai, bj, At, Bt) do { __builtin_amdgcn_s_setprio(1); _Pragma("unroll") for (int m = 0; m < 4; ++m) _Pragma("unroll") for (int n = 0; n < 2; ++n) _Pragma("unroll") for (int k = 0; k < 2; ++k) \
        acc[ai][bj][m][n] = __builtin_amdgcn_mfma_f32_16x16x32_bf16(Bt[n][k], At[m][k], acc[ai][bj][m][n], 0, 0, 0); __builtin_amdgcn_s_setprio(0); } while (0)
#define PG8_WAIT_V(n) asm volatile("s_waitcnt vmcnt(" #n ")" ::: "memory")
#define PG8_WAIT_L(n) asm volatile("s_waitcnt lgkmcnt(" #n ")" ::: "memory")
#define PG8_BAR __builtin_amdgcn_s_barrier()
#define PG8_SCHED __builtin_amdgcn_sched_barrier(0)
#define PG8_GOFFS(dst, unit) do { _Pragma("unroll") for (int _i = 0; _i < 2; ++_i) { int _R, _C; stage_rc(tid * 16 + _i * 8192, _R, _C); _Pragma("unroll") for (int _h = 0; _h < 2; ++_h) \
        dst[_h][_i] = (unsigned)((const PG8_GAS int*)g.rowtok)[(unit).pm * BM + _h * HALF + _R] * rowB + (unsigned)_C * 2u; } } while (0)
    Unit cur, nxt; int ui = 0, nst = 0;
    if (!S.next(0, cur)) return;
    f32x4 acc[2][2][4][2];
#pragma unroll
    for (int a = 0; a < 2; ++a)
#pragma unroll
        for (int b = 0; b < 2; ++b)
#pragma unroll
            for (int m = 0; m < 4; ++m)
#pragma unroll
                for (int n = 0; n < 2; ++n) acc[a][b][m][n] = (f32x4){0.f, 0.f, 0.f, 0.f};
    bf16x8 At[4][2], B0[2][2], B1[2][2];
    unsigned co[2][2] = {{0u, 0u}, {0u, 0u}}, no[2][2] = {{0u, 0u}, {0u, 0u}};
    const char* cA = (const char*)g.A + (GATHER ? (size_t)0 : (size_t)cur.pm * tstep); const char* cB = (const char*)g.Bt + (size_t)cur.pn * tstep;
    if constexpr (GATHER) { PG8_GOFFS(co, cur); }
    PG8_STAGE(PG8_SB(0, 0), cB, voffB); PG8_STAGE(PG8_SB(0, 1), cB + hstep, voffB); PG8_STAGE_A(PG8_SA(0, 0), cA, co, 0, 0); PG8_STAGE_A(PG8_SA(0, 1), cA + hstep, co, 1, 0);
    if (wr == 1) PG8_BAR;
    PG8_WAIT_V(2); PG8_BAR;
    PG8_STAGE(PG8_SB(1, 0), cB + kstep, voffB); PG8_STAGE_A(PG8_SA(1, 0), cA + kstep, co, 0, kstep); PG8_STAGE(PG8_SB(1, 1), cB + hstep + kstep, voffB);
    PG8_WAIT_V(6); PG8_BAR;
    for (;;) {
        const bool has_next = S.next(ui + 1, nxt);
        const char* nA = (has_next && !GATHER) ? (const char*)g.A + (size_t)nxt.pm * tstep : cA; const char* nB = has_next ? (const char*)g.Bt + (size_t)nxt.pn * tstep : cB;
        if constexpr (GATHER) { if (has_next) { PG8_GOFFS(no, nxt); } else {
#pragma unroll
            for (int _h = 0; _h < 2; ++_h)
#pragma unroll
                for (int _i = 0; _i < 2; ++_i) no[_h][_i] = co[_h][_i]; } }
#pragma unroll 1
        for (int t = 0; t < nt; t += 2) {
            const bool last = (t == nt - 2);
            const char* a1 = cA + (size_t)(t + 1) * kstep;
            const char* a2 = last ? nA : cA + (size_t)(t + 2) * kstep; const char* b2 = last ? nB : cB + (size_t)(t + 2) * kstep;
            const char* a3 = a2 + kstep; const char* b3 = b2 + kstep;
            unsigned so[2][2];
#pragma unroll
            for (int _h = 0; _h < 2; ++_h)
#pragma unroll
                for (int _i = 0; _i < 2; ++_i) so[_h][_i] = last ? no[_h][_i] : co[_h][_i];
            const size_t kb1 = (size_t)(t + 1) * kstep, kb2 = last ? (size_t)0 : (size_t)(t + 2) * kstep, kb3 = kb2 + kstep;
            const int rl = t == 0 ? nst : 0;
#define PG8_WAIT_VR() do { if (rl >= 16) PG8_WAIT_V(24); else if (rl >= 8) PG8_WAIT_V(16); else PG8_WAIT_V(8); } while (0)
            PG8_LDB(B0, 0, 0); PG8_LDB(B1, 0, 1); PG8_SCHED; PG8_LDA(At, 0, 0); PG8_STAGE_A(PG8_SA(1, 1), a1 + hstep, co, 1, kb1);
            PG8_WAIT_VR(); PG8_WAIT_L(0); PG8_BAR; PG8_MMA(0, 0, At, B0); PG8_MMA(0, 1, At, B1); PG8_BAR; PG8_SCHED;
            PG8_LDA(At, 0, 1); PG8_STAGE(PG8_SB(0, 0), b2, voffB); PG8_STAGE(PG8_SB(0, 1), b2 + hstep, voffB); PG8_STAGE_A(PG8_SA(0, 0), a2, so, 0, kb2);
            PG8_WAIT_VR(); PG8_WAIT_L(0); PG8_BAR; PG8_MMA(1, 0, At, B0); PG8_MMA(1, 1, At, B1); PG8_BAR; PG8_SCHED;
            PG8_LDB(B0, 1, 0); PG8_LDB(B1, 1, 1); PG8_SCHED; PG8_LDA(At, 1, 0); PG8_STAGE_A(PG8_SA(0, 1), a2 + hstep, so, 1, kb2);
            PG8_WAIT_VR(); PG8_WAIT_L(0); PG8_BAR; PG8_MMA(0, 0, At, B0); PG8_MMA(0, 1, At, B1); PG8_BAR; PG8_SCHED;
            PG8_LDA(At, 1, 1); PG8_STAGE(PG8_SB(1, 0), b3, voffB); PG8_STAGE(PG8_SB(1, 1), b3 + hstep, voffB); PG8_STAGE_A(PG8_SA(1, 0), a3, so, 0, kb3);
            PG8_WAIT_V(8); PG8_WAIT_L(0); PG8_BAR; PG8_MMA(1, 0, At, B0); PG8_MMA(1, 1, At, B1); PG8_BAR; PG8_SCHED;
        }
        if constexpr (ALIGN_EPI) { if (wr == 0) PG8_BAR; }
        PG8_SCHED; asm volatile("s_nop 15\n\ts_nop 15\n\ts_nop 15\n\ts_nop 15" ::: "memory"); PG8_SCHED;
        nst = __builtin_amdgcn_readfirstlane(E(acc, cur, wr, wc, fr, fq));
        if (!has_next) break;
#pragma unroll
        for (int a = 0; a < 2; ++a)
#pragma unroll
            for (int b = 0; b < 2; ++b)
#pragma unroll
                for (int m = 0; m < 4; ++m)
#pragma unroll
                    for (int n = 0; n < 2; ++n) acc[a][b][m][n] = (f32x4){0.f, 0.f, 0.f, 0.f};
        cur = nxt; cA = nA; cB = nB; ++ui;
#pragma unroll
        for (int _h = 0; _h < 2; ++_h)
#pragma unroll
            for (int _i = 0; _i < 2; ++_i) co[_h][_i] = no[_h][_i];
        if constexpr (ALIGN_EPI) { if (wr == 1) PG8_BAR; }
    }
    PG8_WAIT_V(0);
    if constexpr (!ALIGN_EPI) { if (wr == 0) PG8_BAR; }
    PG8_BAR;
#undef PG8_SA
#undef PG8_SB
#undef PG8_STAGE
#undef PG8_STAGE_A
#undef PG8_LDA
#undef PG8_LDB
#undef PG8_MMA
#undef PG8_WAIT_V
#undef PG8_WAIT_VR
#undef PG8_WAIT_L
#undef PG8_BAR
#undef PG8_SCHED
#undef PG8_GOFFS
}
}
constexpr int NWAVES = 8, NTHR = 512;
constexpr int NB = 4, SEQ = 8192, T = NB * SEQ, D = 1024;
constexpr int HEADS = 24, HD = 64, INNER = 1536, NG = 4, NS = 128, CHUNK = 128, NCHUNK = SEQ / CHUNK, HPG = HEADS / NG;
constexpr int INW = 6704;
constexpr int SRC_DT = 4096, SRC_F = 4144, SRC_G = 4656;
constexpr int NE = 256, TOPK = 8, EH = 256, NEX = NE + 1;
constexpr int PC_Z = 0, PC_X = 1536, PC_B = 3072, PC_C = 3584, PC_U = 4096, PC_GS = 4608, PC_GF = 5632, PW = 6656, NPROJ = 6912;
constexpr float RMS_EPS = 1e-6f;
constexpr int ROWS_R = T * TOPK + NE * 256;
constexpr int ROWS_ALL = ROWS_R + T;
constexpr int MAXTILES = ROWS_ALL / 256;

constexpr size_t MiB = 1u << 20;
constexpr size_t WS_CTL = 0, CTL_ZERO_BYTES = 1 * MiB;
constexpr size_t WS_MOD = 1 * MiB;
constexpr size_t WS_TW = WS_MOD + 128 * 1024;
constexpr size_t WS_WM1 = WS_TW + 64 * 1024;
constexpr size_t WS_WM2 = WS_WM1 + 32 * 1024;
constexpr size_t WS_CD = WS_WM2 + 64 * 1024;
constexpr size_t WS_DM = WS_CD + 64 * 1024;
constexpr size_t WS_BCNT = 2 * MiB;
constexpr size_t WS_TILEE = WS_BCNT + 256 * 1024;
constexpr size_t WS_TILEV = WS_TILEE + 8 * 1024;
constexpr float YB_SCALE = 8.f;
constexpr size_t WS_WINT = 4 * MiB;
constexpr size_t WS_WBST = 19 * MiB;
constexpr size_t WS_WBFT = 22 * MiB;
constexpr size_t WS_WOUTT = 23 * MiB;
constexpr size_t WS_WRT = 25 * MiB;
constexpr size_t WS_W13T = 26 * MiB;
constexpr size_t WS_W2T = 283 * MiB;
constexpr size_t WS_H = 412 * MiB;
constexpr size_t WS_PROJ = 476 * MiB;
constexpr size_t WS_DT = 924 * MiB;
constexpr size_t WS_ST = 932 * MiB;
constexpr size_t WS_STL = 1316 * MiB;
constexpr float STP_SCALE = 0.25f;
constexpr float STL_SCALE = 2.f;
constexpr size_t WS_YN = 1124 * MiB;
constexpr size_t WS_GB = 1220 * MiB;
constexpr size_t WS_FO = 1284 * MiB;
constexpr size_t WS_MIX = 1316 * MiB;
constexpr size_t WS_MIXED = 1380 * MiB;
constexpr size_t WS_LOG = 1444 * MiB;
constexpr size_t WS_TOPI = 1476 * MiB, WS_TOPW = 1477 * MiB, WS_TOKPOS = 1478 * MiB, WS_ROWTOK = 1479 * MiB;
constexpr size_t WS_HB = 1481 * MiB;
constexpr size_t WS_YB = 476 * MiB;
constexpr size_t WS_END = 1657 * MiB;
static_assert(WS_YB + (size_t)ROWS_ALL * 1024 * 2 <= WS_YN + (size_t)T * 1536 * 2, "YB overlay must end inside PROJ..YN");
constexpr int CW_ERR = 16;
constexpr int CW_NTILES = 64, CW_BASESH = 65;
constexpr int CW_BAR = 4096;
#define XCD_BAR_WORDS 3456
static_assert((CW_BAR + XCD_BAR_WORDS) * 4 <= (int)CTL_ZERO_BYTES, "ctl");

constexpr int W2_ITEMS = NEX * 64;
constexpr int W2_MOVED_A = 8192, W2_MOVED_B = 8192, W2_MOVED = W2_MOVED_A + W2_MOVED_B;
constexpr int W13_RPT = 2, W13_ROUTE = 8192 * W13_RPT, W13_S1 = 16384, W13_MOVED = W13_ROUTE + W13_S1;
constexpr int LDS_BYTES = 160 * 1024;
constexpr int MISC_OFF = LDS_BYTES - 256;

#define GAS __attribute__((address_space(1)))
#define LAS __attribute__((address_space(3)))
typedef unsigned short bf16;
typedef unsigned v4u __attribute__((ext_vector_type(4)));
typedef unsigned v2u __attribute__((ext_vector_type(2)));
typedef float f32x4 __attribute__((ext_vector_type(4)));
typedef float f32x2 __attribute__((ext_vector_type(2)));
typedef short bf16x8 __attribute__((ext_vector_type(8)));
typedef GAS unsigned gu32;
#define RLX_AGENT __ATOMIC_RELAXED, __HIP_MEMORY_SCOPE_AGENT
#define LDS_WAIT() asm volatile("s_waitcnt lgkmcnt(0)" ::: "memory")
#define VM_WAIT() asm volatile("s_waitcnt vmcnt(0)" ::: "memory")
__device__ __forceinline__ unsigned f2bf(float f) { unsigned u = __builtin_bit_cast(unsigned, f); return (u + 0x7fffu + ((u >> 16) & 1u)) >> 16; }
__device__ __forceinline__ unsigned pk2(float lo, float hi) { unsigned r; asm volatile("v_cvt_pk_bf16_f32 %0, %1, %2" : "=v"(r) : "v"(lo), "v"(hi)); return r; }
__device__ __forceinline__ float bflo(unsigned w) { return __uint_as_float(w << 16); }
__device__ __forceinline__ float bfhi(unsigned w) { return __uint_as_float(w & 0xffff0000u); }
__device__ __forceinline__ float bf2f(bf16 b) { return __uint_as_float(((unsigned)b) << 16); }
__device__ __forceinline__ float siluf_(float x) { return x * __builtin_amdgcn_rcpf(1.f + __expf(-x)); }
__device__ __forceinline__ float softplusf_(float x) { return x > 20.f ? x : log1pf(expf(x)); }
__device__ __forceinline__ float wave_sum(float v) {
#pragma unroll
    for (int o = 1; o < 64; o <<= 1) v += __shfl_xor(v, o);
    return v;
}

#define XB_TMO      128
#define XB_XCNT(j)  (256  + 64 * (j))
#define XB_XSUB(j)  (1280 + 64 * (j))
#define XB_XGEN(j)  (2304 + 64 * (j))
#define XB_TOP      3328
#define XB_TOPGEN   3392
#define XB_SPIN_CAP (1u << 18)
__device__ __forceinline__ unsigned xb_ld(unsigned* p)              { return __hip_atomic_load(p, __ATOMIC_RELAXED, __HIP_MEMORY_SCOPE_AGENT); }
__device__ __forceinline__ unsigned xb_add(unsigned* p, unsigned v) { return __hip_atomic_fetch_add(p, v, __ATOMIC_RELAXED, __HIP_MEMORY_SCOPE_AGENT); }
__device__ __forceinline__ unsigned xb_xcc_id() { return (unsigned)__builtin_amdgcn_s_getreg((3 << 11) | 20) & 0xFu; }
#define XB_SPIN(cond, bar) do { unsigned _sp = 0; while (cond) { __builtin_amdgcn_s_sleep(1); \
    if ((++_sp & 255u) == 0u) { if (xb_ld(&(bar)[XB_TMO])) break; if (_sp > XB_SPIN_CAP) { atomicAdd(&(bar)[XB_TMO], 1u); break; } } } } while (0)
struct XcdBarrier { unsigned* bar; unsigned x; volatile LAS unsigned* st; };
__device__ __forceinline__ XcdBarrier xcd_barrier_post(unsigned* bar, volatile LAS unsigned* st) {
    XcdBarrier b; b.bar = bar; b.x = xb_xcc_id(); b.st = st;
    if (threadIdx.x == 0) (void)xb_add(&bar[XB_XCNT(b.x)], 1u);
    return b;
}
__device__ __forceinline__ void xcd_barrier_complete(unsigned* bar, unsigned x, unsigned& nloc, unsigned& nx) {
    const unsigned G = gridDim.x * gridDim.y * gridDim.z;
    unsigned sum, cnt, mine, sp = 0u;
    for (;;) {
        sum = 0u; cnt = 0u; mine = 0u;
#pragma unroll
        for (unsigned j = 0; j < 16; ++j) { const unsigned c = xb_ld(&bar[XB_XCNT(j)]); sum += c; cnt += (c > 0u) ? 1u : 0u; mine = (j == x) ? c : mine; }
        if (sum == G) break;
        __builtin_amdgcn_s_sleep(1);
        if ((++sp & 255u) == 0u) { if (xb_ld(&bar[XB_TMO])) break; if (sp > XB_SPIN_CAP) { atomicAdd(&bar[XB_TMO], 1u); break; } }
    }
    nloc = mine > 0u ? mine : 1u; nx = cnt > 0u ? cnt : 1u;
}
__device__ __forceinline__ void xcd_barrier(const XcdBarrier& b) {
    asm volatile("s_waitcnt vmcnt(0)" ::: "memory");
    __syncthreads();
    if (threadIdx.x == 0) {
        unsigned* bar = b.bar;
        __builtin_amdgcn_s_waitcnt(0);
        unsigned nloc = b.st[0], nx = b.st[1];
        if (nloc == 0u) { xcd_barrier_complete(bar, b.x, nloc, nx); b.st[0] = nloc; b.st[1] = nx; }
        const unsigned old = xb_add(&bar[XB_XSUB(b.x)], 1u);
        const unsigned gen = old / nloc;
        if (old + 1u == (gen + 1u) * nloc) {
            __builtin_amdgcn_fence(__ATOMIC_RELEASE, "agent");
            asm volatile("s_waitcnt vmcnt(0)" ::: "memory");
            const unsigned og = xb_add(&bar[XB_TOP], 1u);
            const unsigned tg = og / nx;
            if (og + 1u == (tg + 1u) * nx) xb_add(&bar[XB_TOPGEN], 1u);
            else XB_SPIN(xb_ld(&bar[XB_TOPGEN]) == tg, bar);
            __builtin_amdgcn_fence(__ATOMIC_ACQUIRE, "agent");
            xb_add(&bar[XB_XGEN(b.x)], 1u);
            asm volatile("s_waitcnt vmcnt(0)" ::: "memory");
        } else {
            XB_SPIN(xb_ld(&bar[XB_XGEN(b.x)]) == gen, bar);
            __builtin_amdgcn_fence(__ATOMIC_ACQUIRE, "agent");
            asm volatile("s_waitcnt vmcnt(0)" ::: "memory");
        }
    }
    __syncthreads();
}

struct Frame {
    LAS unsigned char* lds;
    gu32* ctl;
    GAS unsigned char* ws;
    int tid, lane, wave, G, bx;
    GAS float* out;
};
#define FIN(i) (((const float* const __attribute__((address_space(4)))*)__builtin_amdgcn_kernarg_segment_ptr())[i])
#define WSP(T_, off) ((T_*)(F.ws + (off)))

__device__ __forceinline__ bf16x8 ldfrag(const LAS unsigned char* base, int pitchB, int row, int kel) { return *(const LAS bf16x8*)(base + row * pitchB + kel * 2); }
struct TrItem { const float* W; int K, Nsrc, k0, scol0, nvalid; bf16* WT; size_t drow0; const float* kscale; };
__device__ __forceinline__ void tr_load(const TrItem& t, f32x4 (&v)[16], int lane) {
    const int n4 = (lane & 15) * 4, kr = lane >> 4; const int n4c = n4 < t.nvalid ? n4 : 0;
#pragma unroll
    for (int i = 0; i < 16; ++i) { const int kk = 4 * i + kr; v[i] = __builtin_nontemporal_load((const GAS f32x4*)(t.W + (size_t)(t.k0 + kk) * t.Nsrc + t.scol0 + n4c)); }
}
template <bool KS> __device__ __forceinline__ void tr_put(const TrItem& t, const f32x4 (&v)[16], LAS float* scr, int lane) {
    const int n4 = (lane & 15) * 4, kr = lane >> 4; const bool ok = n4 < t.nvalid;
#pragma unroll
    for (int i = 0; i < 16; ++i) { const int kk = 4 * i + kr; f32x4 x = ok ? v[i] : (f32x4){0.f, 0.f, 0.f, 0.f}; if (KS) x = x * t.kscale[t.k0 + kk]; LAS float* d = scr + kk * 65 + n4; d[0] = x.x; d[1] = x.y; d[2] = x.z; d[3] = x.w; }
    LDS_WAIT(); asm volatile("" ::: "memory");
}
__device__ __forceinline__ void tr_get(const TrItem& t, LAS float* scr, int lane) {
    const int c = lane & 7;
#pragma unroll
    for (int j = 0; j < 8; ++j) { const int n = (lane >> 3) + 8 * j; const LAS float* s = scr + (8 * c) * 65 + n;
        v4u o; o.x = pk2(s[0 * 65], s[1 * 65]); o.y = pk2(s[2 * 65], s[3 * 65]); o.z = pk2(s[4 * 65], s[5 * 65]); o.w = pk2(s[6 * 65], s[7 * 65]);
        *(GAS v4u*)(t.WT + (t.drow0 + n) * (size_t)t.K + t.k0 + 8 * c) = o; }
    LDS_WAIT(); asm volatile("" ::: "memory");
}

template <class IT> __device__ __forceinline__ void tr_stream(LAS float* scr, int lane, int n, IT item) {
    if (n <= 0) return;
    if (n == 1) { f32x4 v[16]; const TrItem t = item(0); tr_load(t, v, lane); tr_put<false>(t, v, scr, lane); tr_get(t, scr, lane); return; }
    f32x4 va[16], vb[16]; TrItem ta = item(0), tb = item(1); tr_load(ta, va, lane); tr_load(tb, vb, lane);
    int k = 0;
    for (; k + 3 < n; k += 2) {
        tr_put<false>(ta, va, scr, lane); const TrItem ta2 = item(k + 2); tr_load(ta2, va, lane); tr_get(ta, scr, lane); ta = ta2;
        tr_put<false>(tb, vb, scr, lane); const TrItem tb2 = item(k + 3); tr_load(tb2, vb, lane); tr_get(tb, scr, lane); tb = tb2;
    }
    if (n - k == 3) { tr_put<false>(ta, va, scr, lane); const TrItem ta2 = item(k + 2); tr_load(ta2, va, lane); tr_get(ta, scr, lane);
        tr_put<false>(tb, vb, scr, lane); tr_get(tb, scr, lane); tr_put<false>(ta2, va, scr, lane); tr_get(ta2, scr, lane); }
    else { tr_put<false>(ta, va, scr, lane); tr_get(ta, scr, lane); tr_put<false>(tb, vb, scr, lane); tr_get(tb, scr, lane); }
}
__device__ __forceinline__ TrItem w13_item(Frame& F, int r) {
    const int e = r >> 7, q = r & 127, kb = q >> 3, db = q & 7; const int rho0 = db * 64, pn = rho0 >> 8, bj = (rho0 >> 7) & 1, jj = rho0 & 127;
    const float* src = (e < NE) ? FIN(22) + (size_t)e * 1024 * 512 : FIN(24);
    return TrItem{src, 1024, 512, kb * 64, bj * 256 + pn * 128 + jj, 64, WSP(bf16, WS_W13T), (size_t)e * 512 + rho0, nullptr};
}
__device__ __forceinline__ void trq_load(const TrItem& t, int kq, f32x4 (&v)[4], int lane) {
    const int n4 = (lane & 15) * 4, kr = lane >> 4;
#pragma unroll
    for (int i = 0; i < 4; ++i) { const int kk = 16 * kq + 4 * i + kr; v[i] = __builtin_nontemporal_load((const GAS f32x4*)(t.W + (size_t)(t.k0 + kk) * t.Nsrc + t.scol0 + n4)); }
}
__device__ __forceinline__ void trq_store(const TrItem& t, int kq, const f32x4 (&v)[4], LAS float* scr, int lane) {
    const int n4 = (lane & 15) * 4, kr = lane >> 4;
#pragma unroll
    for (int i = 0; i < 4; ++i) { const int kk = 4 * i + kr; LAS float* d = scr + kk * 65 + n4; d[0] = v[i].x; d[1] = v[i].y; d[2] = v[i].z; d[3] = v[i].w; }
    LDS_WAIT(); asm volatile("" ::: "memory");
    const int c = lane & 1;
#pragma unroll
    for (int j = 0; j < 2; ++j) { const int n = (lane >> 1) + 32 * j; const LAS float* s_ = scr + (8 * c) * 65 + n;
        v4u o; o.x = pk2(s_[0 * 65], s_[1 * 65]); o.y = pk2(s_[2 * 65], s_[3 * 65]); o.z = pk2(s_[4 * 65], s_[5 * 65]); o.w = pk2(s_[6 * 65], s_[7 * 65]);
        *(GAS v4u*)(t.WT + (t.drow0 + n) * (size_t)t.K + t.k0 + 16 * kq + 8 * c) = o; }
    LDS_WAIT(); asm volatile("" ::: "memory");
}
__device__ __forceinline__ void convert_w2_slice(Frame& F, int lo, int hi, int b0, int nblk) {
    LAS float* scr = (LAS float*)(F.lds + F.wave * 16896);
    const int wv = ((int)F.bx - b0) * NWAVES + F.wave, NW = nblk * NWAVES;
    const int n = (hi - lo - wv + NW - 1) / NW;
    auto item = [&](int k) { const int r = lo + wv + k * NW; const int e = r >> 6, q = r & 63, kb = q >> 4, nb = q & 15;
        const float* src = (e < NE) ? FIN(23) + (size_t)e * 256 * 1024 : FIN(25);
        return TrItem{src, 256, 1024, kb * 64, nb * 64, 64, WSP(bf16, WS_W2T), (size_t)e * 1024 + nb * 64, nullptr}; };
    tr_stream(scr, F.lane, n, item);
}

__device__ __forceinline__ void phase_prologue(Frame& F) {
    const float* c_in = FIN(1); const float* w_ada = FIN(2); const float* b_ada = FIN(3);
    const float* w_in = FIN(8);
    for (int it = F.bx; it < 96; it += F.G) {
        __syncthreads();
        {
            LAS float* sc = (LAS float*)(F.lds);
            LAS float* red = (LAS float*)(F.lds + 16384);
            for (int i = F.tid; i < 4096; i += NTHR) sc[i] = siluf_(c_in[i]);
            __syncthreads();
            const int col = it * 64 + F.lane; float a0 = 0.f, a1 = 0.f, a2 = 0.f, a3 = 0.f;
            const int kb = F.wave * 128;
#pragma unroll 32
            for (int k = 0; k < 128; ++k) { const float w = w_ada[(size_t)(kb + k) * 6144 + col]; a0 += sc[kb + k] * w; a1 += sc[1024 + kb + k] * w; a2 += sc[2048 + kb + k] * w; a3 += sc[3072 + kb + k] * w; }
            red[(F.wave * 4 + 0) * 64 + F.lane] = a0; red[(F.wave * 4 + 1) * 64 + F.lane] = a1; red[(F.wave * 4 + 2) * 64 + F.lane] = a2; red[(F.wave * 4 + 3) * 64 + F.lane] = a3;
            __syncthreads();
            if (F.tid < 256) { const int b = F.tid >> 6, l = F.tid & 63; float s = b_ada[it * 64 + l];
#pragma unroll
                for (int w = 0; w < 8; ++w) s += red[(w * 4 + b) * 64 + l];
                WSP(float, WS_MOD)[b * 6144 + it * 64 + l] = s; }
        }
    }
    __syncthreads();
    const int gt = F.bx * NTHR + F.tid, NGT = F.G * NTHR;
    for (int i = gt; i < 8192; i += NGT) { float s_, c_; sincospif((float)i / 4096.f, &s_, &c_); WSP(f32x2, WS_TW)[i] = (f32x2){c_, s_}; }
    for (int i = gt; i < 128 * 128; i += NGT) { const int m = i >> 7, k = i & 127; const int k1 = m & 63, s1 = k & 63; float s_, c_; sincospif((float)((k1 * s1) & 63) / 32.f, &s_, &c_);
        float v; if (m < 64) v = (k < 64) ? c_ : s_; else v = (k < 64) ? -s_ : c_;
        WSP(bf16, WS_WM1)[i] = (bf16)f2bf(v * 0.125f); }
    for (int i = gt; i < 128 * 256; i += NGT) { const int k2 = i >> 8, k = i & 255; const int s2 = k & 127; float s_, c_; sincospif((float)((k2 * s2) & 127) / 64.f, &s_, &c_);
        WSP(bf16, WS_WM2)[i] = (bf16)f2bf(((k < 128) ? c_ : s_) * 0.08838834764831845f); }
    for (int i = gt; i < 256 * 128; i += NGT) { const int rho = i >> 7, c = i & 127, j = rho & 127; float s_, c_; sincospif((float)((c * j) & 127) / 64.f, &s_, &c_);
        WSP(bf16, WS_DM)[i] = (bf16)f2bf((rho < 128 ? c_ : -s_) * 0.08838834764831845f); }
    LAS float* scr = (LAS float*)(F.lds + F.wave * 16896);
    const int gw = F.bx * NWAVES + F.wave, NGW = F.G * NWAVES;
    constexpr int I_IN = (NPROJ / 64) * 16, I_BS = 24 * 16, I_BF = 8 * 16, I_OUT = 16 * 16, I_R = 16 * 4, I_13 = NEX * 128, I_2 = NEX * 64;
    constexpr int NITEMS = I_IN + I_BS + I_BF + I_OUT + I_R + I_13 + I_2;
    auto decode = [&](int it) -> TrItem {
        int r = it;
        if (r < I_IN) { const int kb = r / (NPROJ / 64), db = r % (NPROJ / 64); const int d0 = db * 64; int src, nv = 64;
            if (d0 < PC_U) src = d0; else if (d0 < PC_GS) src = SRC_F + (d0 - PC_U); else if (d0 < PW) src = SRC_G + (d0 - PC_GS); else { src = SRC_DT + (d0 - PW); nv = 48 - (d0 - PW); nv = nv < 0 ? 0 : (nv > 64 ? 64 : nv); }
            return TrItem{w_in, 1024, INW, kb * 64, src, nv, WSP(bf16, WS_WINT), (size_t)d0, nullptr}; } r -= I_IN;
        if (r < I_BS) { const int kb = r / 16, nb = r % 16; return TrItem{FIN(17), 1536, 1024, kb * 64, nb * 64, 64, WSP(bf16, WS_WBST), (size_t)nb * 64, FIN(16)}; } r -= I_BS;
        if (r < I_BF) { const int kb = r / 16, nb = r % 16; return TrItem{FIN(18), 512, 1024, kb * 64, nb * 64, 64, WSP(bf16, WS_WBFT), (size_t)nb * 64, nullptr}; } r -= I_BF;
        if (r < I_OUT) { const int kb = r / 16, nb = r % 16; return TrItem{FIN(19), 1024, 1024, kb * 64, nb * 64, 64, WSP(bf16, WS_WOUTT), (size_t)nb * 64, nullptr}; } r -= I_OUT;
        if (r < I_R) { const int kb = r / 4, nb = r % 4; return TrItem{FIN(20), 1024, 256, kb * 64, nb * 64, 64, WSP(bf16, WS_WRT), (size_t)nb * 64, nullptr}; } r -= I_R;
        if (r < I_13) { const int e = r >> 7, q = r & 127, kb = q >> 3, db = q & 7; const int rho0 = db * 64, pn = rho0 >> 8, bj = (rho0 >> 7) & 1, jj = rho0 & 127;
            const float* src = (e < NE) ? FIN(22) + (size_t)e * 1024 * 512 : FIN(24);
            return TrItem{src, 1024, 512, kb * 64, bj * 256 + pn * 128 + jj, 64, WSP(bf16, WS_W13T), (size_t)e * 512 + rho0, nullptr}; } r -= I_13;
        { const int e = r >> 6, q = r & 63, kb = q >> 4, nb = q & 15;
            const float* src = (e < NE) ? FIN(23) + (size_t)e * 256 * 1024 : FIN(25);
            return TrItem{src, 256, 1024, kb * 64, nb * 64, 64, WSP(bf16, WS_W2T), (size_t)e * 1024 + nb * 64, nullptr}; }
    };
    const bool psplit = F.G >= 192; const int pNA = psplit ? 96 * NWAVES : 0; const bool pisA = gw < pNA; const int pgb = gw - pNA, pNBW = NGW - pNA;
    if (!pisA) for (int it = I_IN + pgb; it < I_IN + I_BS; it += pNBW) { f32x4 v[16]; const TrItem t = decode(it); tr_load(t, v, F.lane); tr_put<true>(t, v, scr, F.lane); tr_get(t, scr, F.lane); }
    static_assert(I_2 == W2_ITEMS, "W2 item count");
    constexpr int NM = NITEMS - I_BS - W2_MOVED - W13_MOVED;
    constexpr int S13 = I_IN + I_BS + I_BF + I_OUT + I_R;
    if (!pisA) {   const int n = (NM - pgb + pNBW - 1) / pNBW;
        auto item = [&](int k) { const int m = pgb + k * pNBW; int it = m < I_IN ? m : m + I_BS; if (it >= S13) it += W13_MOVED; return decode(it); };
        tr_stream(scr, F.lane, n, item);
    }
}

__device__ __forceinline__ void phase_norm1(Frame& F) {
    LAS float* GS = (LAS float*)(F.lds); LAS float* SH = GS + 4096;
    const float* mod = WSP(float, WS_MOD); const float* g = FIN(4);
    for (int i = F.tid; i < 4096; i += NTHR) { const int b = i >> 10, col = i & 1023; GS[i] = g[col] * (1.f + mod[b * 6144 + 1024 + col]); SH[i] = mod[b * 6144 + col]; }
    __syncthreads();
    const int gw = F.bx * NWAVES + F.wave, NGW = F.G * NWAVES; const float* x = FIN(0); bf16* H = WSP(bf16, WS_H);
    f32x4 nx[4];
    if (gw < T) { const GAS f32x4* xr = (const GAS f32x4*)(x + (size_t)gw * D) + F.lane;
#pragma unroll
        for (int j = 0; j < 4; ++j) nx[j] = xr[64 * j]; }
    for (int m = gw; m < T; m += NGW) { const int b = m / SEQ;
        f32x4 v[4]; float ss = 0.f;
#pragma unroll
        for (int j = 0; j < 4; ++j) v[j] = nx[j];
        if (m + NGW < T) { const GAS f32x4* xr = (const GAS f32x4*)(x + (size_t)(m + NGW) * D) + F.lane;
#pragma unroll
            for (int j = 0; j < 4; ++j) nx[j] = xr[64 * j]; }
#pragma unroll
        for (int j = 0; j < 4; ++j) ss += (v[j].x * v[j].x + v[j].y * v[j].y) + (v[j].z * v[j].z + v[j].w * v[j].w);
        const float rstd = 1.f / sqrtf(wave_sum(ss) * (1.f / D) + RMS_EPS);
        GAS unsigned long long* o8 = (GAS unsigned long long*)(H + (size_t)m * D) + F.lane;
#pragma unroll
        for (int j = 0; j < 4; ++j) { const int col = 4 * F.lane + 256 * j; const LAS float* gs = GS + b * 1024 + col; const LAS float* sh = SH + b * 1024 + col;
            o8[64 * j] = (unsigned long long)pk2(v[j].x * rstd * gs[0] + sh[0], v[j].y * rstd * gs[1] + sh[1]) | ((unsigned long long)pk2(v[j].z * rstd * gs[2] + sh[2], v[j].w * rstd * gs[3] + sh[3]) << 32); }
    }
}

#define MFMA_BEGIN() do { asm volatile("s_waitcnt lgkmcnt(0)" ::: "memory"); __builtin_amdgcn_sched_barrier(0); } while (0)
#define MFMA_END() do { __builtin_amdgcn_sched_barrier(0); asm volatile("s_nop 15\n\ts_nop 15\n\ts_nop 15\n\ts_nop 15" ::: "memory"); __builtin_amdgcn_sched_barrier(0); } while (0)
#define MFMA_END2() do { __builtin_amdgcn_sched_barrier(0); asm volatile("s_nop 15\n\ts_nop 15" ::: "memory"); __builtin_amdgcn_sched_barrier(0); } while (0)
#define LDS_BARRIER() do { asm volatile("s_waitcnt lgkmcnt(0)" ::: "memory"); __builtin_amdgcn_s_barrier(); asm volatile("" ::: "memory"); } while (0)
constexpr int PT = 272;
__device__ __forceinline__ void wave_scan128(float a0, float a1, int lane, float& i0, float& i1, float& tot) {
    float p = a0 + a1;
#pragma unroll
    for (int o = 1; o < 64; o <<= 1) { const float t = __shfl_up(p, o); if (lane >= o) p += t; }
    i1 = p; i0 = p - a1; tot = __shfl(p, 63);
}
__device__ __forceinline__ void raw_load(unsigned (&r)[12], const bf16* P, int b, int c, int col, int tid) {
    const int pp = tid & 31, sr = tid >> 5; const int s0 = c * CHUNK + 8 * sr - 2;
    const GAS unsigned* base = (const GAS unsigned*)(P + (size_t)(b * SEQ) * PW + col + 2 * pp);
#pragma unroll
    for (int i = 0; i < 12; ++i) { int s_ = s0 + i; s_ = s_ < 0 ? 0 : (s_ >= SEQ ? SEQ - 1 : s_); r[i] = base[(size_t)s_ * (PW / 2)]; }
}
__device__ __forceinline__ void conv8(const unsigned (&r)[12], const LAS float* cw, int nch, int chl, float (&o0)[8], float (&o1)[8], bool zlo, bool zhi) {
    f32x2 w[5], x[12];
#pragma unroll
    for (int i = 0; i < 5; ++i) w[i] = *(const LAS f32x2*)(cw + i * nch + chl);
    const f32x2 bb = *(const LAS f32x2*)(cw + 5 * nch + chl);
#pragma unroll
    for (int i = 0; i < 12; ++i) { const unsigned v = ((i < 2 && zlo) || (i >= 10 && zhi)) ? 0u : r[i]; x[i] = (f32x2){bflo(v), bfhi(v)}; }
#pragma unroll
    for (int j = 0; j < 8; ++j) { f32x2 a = bb;
#pragma unroll
        for (int i = 0; i < 5; ++i) a = x[j + i] * w[i] + a;
        o0[j] = siluf_(a.x); o1[j] = siluf_(a.y); }
}
__device__ __forceinline__ void store_T(LAS unsigned char* dst, int ch, int s0, const float (&o0)[8], const float (&o1)[8], const LAS float* sc) {
    f32x2 p[8];
#pragma unroll
    for (int j = 0; j < 8; ++j) p[j] = (f32x2){o0[j], o1[j]};
    if (sc) { const f32x4 a = *(const LAS f32x4*)(sc + s0), d = *(const LAS f32x4*)(sc + s0 + 4); const float k[8] = { a.x, a.y, a.z, a.w, d.x, d.y, d.z, d.w };
#pragma unroll
        for (int j = 0; j < 8; ++j) p[j] = p[j] * (f32x2){k[j], k[j]}; }
    v4u w0, w1;
    w0.x = pk2(p[0].x, p[1].x); w0.y = pk2(p[2].x, p[3].x); w0.z = pk2(p[4].x, p[5].x); w0.w = pk2(p[6].x, p[7].x);
    w1.x = pk2(p[0].y, p[1].y); w1.y = pk2(p[2].y, p[3].y); w1.z = pk2(p[4].y, p[5].y); w1.w = pk2(p[6].y, p[7].y);
    *(LAS v4u*)(dst + ch * PT + s0 * 2) = w0; *(LAS v4u*)(dst + (ch + 1) * PT + s0 * 2) = w1;
}
__host__ __device__ __forceinline__ int st_off(int p, int n) { return ((((p >> 4) + 4 * (n >> 6)) * 64 + (p & 15) + 16 * ((n & 15) >> 2)) << 4) + 4 * ((n >> 4) & 3) + (n & 3); }
__device__ __forceinline__ int st_col(int pc, int g) { return pc < 2 ? PC_B + g * 128 + pc * 64 : PC_X + (g * HPG + pc - 2) * 64; }
__device__ __forceinline__ void phase_states(Frame& F) {
    LAS unsigned char* BT = F.lds;
    LAS unsigned char* XTB = F.lds + 34816;
    LAS float* CWA = (LAS float*)(F.lds + 104448);
    LAS float* WSF = (LAS float*)(F.lds + 116736);
    LAS float* WSB = WSF + 768;
    LAS float* HC = (LAS float*)(F.lds + 122880);
    float hb0 = 0.f, hb1 = 0.f, hA0 = 0.f, hA1 = 0.f;
    const bf16* P = WSP(bf16, WS_PROJ); unsigned char* STL = WSP(unsigned char, WS_STL); float* CD = WSP(float, WS_CD); const float* DTR = WSP(float, WS_DT);
    const int fr = F.lane & 15, fq = F.lane >> 4, pp = F.tid & 31, sr = F.tid >> 5;
    constexpr int NU = NB * NCHUNK * NG;
    LAS float* qscr = (LAS float*)(F.lds + 123392 + F.wave * 4160);
    const int qNGW = F.G * NWAVES; int qk = F.bx * NWAVES + F.wave;
    int gtab = -1;
    unsigned r[4][12]; float dr[4] = {0.f, 0.f, 0.f, 0.f};
    if ((int)F.bx < NU) { const int u = F.bx, g = u & 3, c = (u >> 2) & 63, b = u >> 8;
#pragma unroll
        for (int k = 0; k < 4; ++k) raw_load(r[k], P, b, c, st_col(k, g), F.tid);
        if (F.wave < HPG) { const size_t row = (size_t)(b * SEQ + c * CHUNK + 2 * F.lane); const int h = g * HPG + F.wave;
            dr[0] = DTR[row * 64 + h]; dr[1] = DTR[(row + 1) * 64 + h]; dr[2] = DTR[row * 64 + 24 + h]; dr[3] = DTR[(row + 1) * 64 + 24 + h]; } }
    for (int u = F.bx; u < NU; u += F.G) {
        const int g = u & 3, c = (u >> 2) & 63, b = u >> 8;
        const bool hn = u + F.G < NU; const int un = hn ? u + F.G : u; const int gn = un & 3, cn = (un >> 2) & 63, bn = un >> 8;
        const bool zlo = (c == 0 && sr == 0), zhi = (c == NCHUNK - 1 && sr == 15);
        LDS_BARRIER();
        if (g != gtab) { gtab = g;
            for (int i = F.tid; i < 6 * 512; i += NTHR) { const int t = i >> 9, ch = i & 511; const int xc = ch < 384 ? g * 384 + ch : 1536 + g * 128 + (ch - 384);
                CWA[i] = t < 5 ? FIN(9)[t * 2560 + xc] : FIN(10)[xc]; }
            if (F.wave < HPG) { const int h = g * HPG + F.wave; hb0 = FIN(11)[h]; hb1 = FIN(12)[h]; hA0 = -expf(FIN(13)[h]); hA1 = -expf(FIN(14)[h]);
                if (F.lane == 0) { HC[F.wave * 8 + 4] = STL_SCALE / softplusf_(hb0); HC[F.wave * 8 + 5] = STL_SCALE / softplusf_(hb1); } } }
        if (F.wave < HPG) { const int h = g * HPG + F.wave;
#pragma unroll
            for (int d = 0; d < 2; ++d) { const float bias = d ? hb1 : hb0; const float A = d ? hA1 : hA0;
                const float dt0 = softplusf_(dr[2 * d] + bias), dt1 = softplusf_(dr[2 * d + 1] + bias);
                const float a0 = A * dt0, a1 = A * dt1; float i0, i1, tot; wave_scan128(a0, a1, F.lane, i0, i1, tot);
                const float ex0 = i0 - a0, ex1 = i1 - a1;
                LAS float* W = (d ? WSB : WSF) + F.wave * 128 + 2 * F.lane;
                if (d == 0) { W[0] = dt0 * __expf(tot - i0); W[1] = dt1 * __expf(tot - i1); } else { W[0] = dt0 * __expf(ex0); W[1] = dt1 * __expf(ex1); }
                if (F.lane == 0) CD[((size_t)(b * NCHUNK + c) * HEADS + h) * 2 + d] = __expf(tot); }
            { const size_t row = (size_t)(bn * SEQ + cn * CHUNK + 2 * F.lane); const int h2 = gn * HPG + F.wave;
                dr[0] = DTR[row * 64 + h2]; dr[1] = DTR[(row + 1) * 64 + h2]; dr[2] = DTR[row * 64 + 24 + h2]; dr[3] = DTR[(row + 1) * 64 + 24 + h2]; } }
        LDS_BARRIER();
#pragma unroll
        for (int pc = 0; pc < 8; ++pc) { constexpr int dummy = 0; (void)dummy; const int k = pc & 3;
            const int qc = qk < 4 * W13_S1 ? qk : 4 * W13_S1 - 1; qk += qNGW;
            const TrItem qt = w13_item(F, W13_ROUTE + (qc >> 2)); f32x4 qv[4]; trq_load(qt, qc & 3, qv, F.lane);
            float o0[8], o1[8];
            if (pc < 2) { conv8(r[k], CWA, 512, 384 + pc * 64 + 2 * pp, o0, o1, zlo, zhi); store_T(BT + pc * 64 * PT, 2 * pp, 8 * sr, o0, o1, nullptr); }
            else { const int hh = pc - 2; conv8(r[k], CWA, 512, hh * 64 + 2 * pp, o0, o1, zlo, zhi);
                LAS unsigned char* xf = XTB + ((hh & 1) * 2) * 17408; store_T(xf, 2 * pp, 8 * sr, o0, o1, WSF + hh * 128); store_T(xf + 17408, 2 * pp, 8 * sr, o0, o1, WSB + hh * 128); }
            if (pc < 4) raw_load(r[k], P, b, c, st_col(pc + 4, g), F.tid);
            else raw_load(r[k], P, bn, cn, st_col(pc - 4, gn), F.tid);
            LDS_BARRIER();
            if (pc >= 2) { const int hh = pc - 2, h = g * HPG + hh; const LAS unsigned char* xf = XTB + ((hh & 1) * 2) * 17408;
                const int ptile = F.wave & 3, nt0 = 4 * (F.wave >> 2);
                f32x4 af[4], ab[4];
#pragma unroll
                for (int j = 0; j < 4; ++j) { af[j] = (f32x4){0.f, 0.f, 0.f, 0.f}; ab[j] = (f32x4){0.f, 0.f, 0.f, 0.f}; }
#pragma unroll
                for (int half = 0; half < 2; ++half) { bf16x8 qf[2], qb[2], pf[2][4];
#pragma unroll
                    for (int k2 = 0; k2 < 2; ++k2) { const int kk = 2 * half + k2; qf[k2] = ldfrag(xf, PT, 16 * ptile + fr, 32 * kk + 8 * fq); qb[k2] = ldfrag(xf + 17408, PT, 16 * ptile + fr, 32 * kk + 8 * fq);
#pragma unroll
                        for (int j = 0; j < 4; ++j) pf[k2][j] = ldfrag(BT, PT, 16 * (nt0 + j) + fr, 32 * kk + 8 * fq); }
                    MFMA_BEGIN();
#pragma unroll
                    for (int k2 = 0; k2 < 2; ++k2)
#pragma unroll
                        for (int j = 0; j < 4; ++j) { af[j] = __builtin_amdgcn_mfma_f32_16x16x32_bf16(pf[k2][j], qf[k2], af[j], 0, 0, 0); ab[j] = __builtin_amdgcn_mfma_f32_16x16x32_bf16(pf[k2][j], qb[k2], ab[j], 0, 0, 0); }
                    MFMA_END(); }
                unsigned char* so = STL + ((size_t)((b * NCHUNK + c) * HEADS + h) * 2) * 8192 + F.tid * 16;
                const float sf = HC[hh * 8 + 4], sb = HC[hh * 8 + 5];
                unsigned wf[4], wb[4];
#pragma unroll
                for (int j = 0; j < 4; ++j) { const f32x4 vf = af[j] * sf, vb = ab[j] * sb;
                    int w = __builtin_amdgcn_cvt_pk_fp8_f32(__builtin_amdgcn_fmed3f(vf[0], -440.f, 440.f), __builtin_amdgcn_fmed3f(vf[1], -440.f, 440.f), 0, false); w = __builtin_amdgcn_cvt_pk_fp8_f32(__builtin_amdgcn_fmed3f(vf[2], -440.f, 440.f), __builtin_amdgcn_fmed3f(vf[3], -440.f, 440.f), w, true);
                    wf[j] = (unsigned)w;
                    w = __builtin_amdgcn_cvt_pk_fp8_f32(__builtin_amdgcn_fmed3f(vb[0], -440.f, 440.f), __builtin_amdgcn_fmed3f(vb[1], -440.f, 440.f), 0, false); w = __builtin_amdgcn_cvt_pk_fp8_f32(__builtin_amdgcn_fmed3f(vb[2], -440.f, 440.f), __builtin_amdgcn_fmed3f(vb[3], -440.f, 440.f), w, true);
                    wb[j] = (unsigned)w; }
                *(GAS v4u*)so = (v4u){wf[0], wf[1], wf[2], wf[3]}; *(GAS v4u*)(so + 8192) = (v4u){wb[0], wb[1], wb[2], wb[3]};
            }
            trq_store(qt, qc & 3, qv, qscr, F.lane);
        }
    }
    for (; qk < 4 * W13_S1; qk += qNGW) { const TrItem qt = w13_item(F, W13_ROUTE + (qk >> 2)); f32x4 qv[4]; trq_load(qt, qk & 3, qv, F.lane); trq_store(qt, qk & 3, qv, qscr, F.lane); }
}

__device__ __forceinline__ void phase_scan(Frame& F) {
    unsigned char* ST = WSP(unsigned char, WS_ST); const unsigned char* STL = WSP(unsigned char, WS_STL); const float* CD = WSP(float, WS_CD);
    const int gt = F.bx * NTHR + F.tid, NGT = F.G * NTHR;
    for (int e = gt; e < NB * HEADS * 2 * 512; e += NGT) {
        const int q16 = e & 511, d = (e >> 9) & 1, bh = e >> 10, h = bh % HEADS, b = bh / HEADS;
        const float inv = STP_SCALE / STL_SCALE;
        float prev[16];
#pragma unroll
        for (int j = 0; j < 16; ++j) prev[j] = 0.f;
        for (int c0 = 0; c0 < NCHUNK; c0 += 8) {
            v4u st[8]; float dec[8];
#pragma unroll
            for (int i = 0; i < 8; ++i) { const int c = d ? (NCHUNK - 1 - (c0 + i)) : (c0 + i); const size_t si = ((size_t)((b * NCHUNK + c) * HEADS + h) * 2 + d);
                st[i] = *(const GAS v4u*)(STL + si * 8192 + q16 * 16); dec[i] = CD[si]; }
#pragma unroll
            for (int i = 0; i < 8; ++i) { const int c = d ? (NCHUNK - 1 - (c0 + i)) : (c0 + i); const size_t si = ((size_t)((b * NCHUNK + c) * HEADS + h) * 2 + d);
                const int wv[4] = { (int)st[i].x, (int)st[i].y, (int)st[i].z, (int)st[i].w }; v4u o;
                unsigned ow[4];
#pragma unroll
                for (int q = 0; q < 4; ++q) { int w = __builtin_amdgcn_cvt_pk_fp8_f32(__builtin_amdgcn_fmed3f(prev[4 * q], -440.f, 440.f), __builtin_amdgcn_fmed3f(prev[4 * q + 1], -440.f, 440.f), 0, false);
                    w = __builtin_amdgcn_cvt_pk_fp8_f32(__builtin_amdgcn_fmed3f(prev[4 * q + 2], -440.f, 440.f), __builtin_amdgcn_fmed3f(prev[4 * q + 3], -440.f, 440.f), w, true); ow[q] = (unsigned)w;
                    prev[4 * q] = prev[4 * q] * dec[i] + inv * __builtin_amdgcn_cvt_f32_fp8(wv[q], 0); prev[4 * q + 1] = prev[4 * q + 1] * dec[i] + inv * __builtin_amdgcn_cvt_f32_fp8(wv[q], 1);
                    prev[4 * q + 2] = prev[4 * q + 2] * dec[i] + inv * __builtin_amdgcn_cvt_f32_fp8(wv[q], 2); prev[4 * q + 3] = prev[4 * q + 3] * dec[i] + inv * __builtin_amdgcn_cvt_f32_fp8(wv[q], 3); }
                o.x = ow[0]; o.y = ow[1]; o.z = ow[2]; o.w = ow[3]; *(GAS v4u*)(ST + si * 8192 + q16 * 16) = o; }
        }
    }
}

__device__ __forceinline__ void phase_ssd_out(Frame& F) {
    LAS unsigned char* CS = F.lds;
    LAS unsigned char* BS = F.lds + 34816;
    LAS unsigned char* XT = F.lds + 69632;
    LAS unsigned char* PVB = F.lds + 87040;
    LAS float* CWX = (LAS float*)(F.lds + 121856);
    LAS float* DTF = (LAS float*)(F.lds + 131072);
    LAS float* DTB = DTF + 768; LAS float* ACF = DTB + 768; LAS float* ACB = ACF + 768; LAS float* CFF = ACB + 768; LAS float* CFB = CFF + 768;
    LAS float* CWBC = (LAS float*)PVB;
    const unsigned char* ST = WSP(unsigned char, WS_ST); const bf16* P = WSP(bf16, WS_PROJ); bf16* YN = WSP(bf16, WS_YN);
    const int fr = F.lane & 15, fq = F.lane >> 4, w = F.wave, pp = F.tid & 31, sr = F.tid >> 5;
    LAS unsigned char* LB = BS + w * 16 * PT;
    LAS unsigned char* XB = F.lds + 149504 + w * 1280;
    LAS float* HC = (LAS float*)(F.lds + 159744);
    float hb0 = 0.f, hb1 = 0.f, hA0 = 0.f, hA1 = 0.f;
    const float* DTR = WSP(float, WS_DT);
    int gtab = -1;
    for (int u = F.bx; u < NB * NCHUNK * NG; u += F.G) {
        const int g = u & 3, c = (u >> 2) & 63, b = u >> 8;
        const bool zlo = (c == 0 && sr == 0), zhi = (c == NCHUNK - 1 && sr == 15);
        unsigned rbc[4][12];
#pragma unroll
        for (int pc = 0; pc < 4; ++pc) raw_load(rbc[pc], P, b, c, ((pc >> 1) ? PC_C : PC_B) + g * 128 + (pc & 1) * 64, F.tid);
        float dr[4];
        { const size_t row = (size_t)(b * SEQ + c * CHUNK + 2 * F.lane); const int h = g * HPG + (w < HPG ? w : 0);
          dr[0] = DTR[row * 64 + h]; dr[1] = DTR[(row + 1) * 64 + h]; dr[2] = DTR[row * 64 + 24 + h]; dr[3] = DTR[(row + 1) * 64 + 24 + h]; }
        LDS_BARRIER();
        if (g != gtab) { gtab = g; for (int i = F.tid; i < 6 * 384; i += NTHR) { const int t = i / 384, ch = i % 384; CWX[i] = t < 5 ? FIN(9)[t * 2560 + g * 384 + ch] : FIN(10)[g * 384 + ch]; }
            if (w < HPG) { const int h = g * HPG + w; hb0 = FIN(11)[h]; hb1 = FIN(12)[h]; hA0 = -expf(FIN(13)[h]); hA1 = -expf(FIN(14)[h]);
                if (F.lane == 0) { HC[w * 8 + 4] = softplusf_(hb0) * (1.f / STP_SCALE); HC[w * 8 + 5] = softplusf_(hb1) * (1.f / STP_SCALE); HC[w * 8 + 6] = FIN(15)[h]; } } }
        { float cwr[3];
#pragma unroll
            for (int q = 0; q < 3; ++q) { const int i = F.tid + q * NTHR; const int t = i >> 8, ch = i & 255; const int xc = 1536 + (ch >> 7) * 512 + g * 128 + (ch & 127); cwr[q] = t < 5 ? FIN(9)[t * 2560 + xc] : FIN(10)[xc]; }
#pragma unroll
            for (int q = 0; q < 3; ++q) CWBC[F.tid + q * NTHR] = cwr[q]; }
        if (w < HPG) { const int h = g * HPG + w;
#pragma unroll
            for (int d = 0; d < 2; ++d) { float dt0, dt1, ac0, ac1, ex0, ex1, tot;
                { const float bias = d ? hb1 : hb0, A = d ? hA1 : hA0;
                  dt0 = softplusf_(dr[2 * d] + bias); dt1 = softplusf_(dr[2 * d + 1] + bias);
                  const float a0 = A * dt0, a1 = A * dt1; float i0, i1; wave_scan128(a0, a1, F.lane, i0, i1, tot);
                  ex0 = i0 - a0; ex1 = i1 - a1; if (d == 0) { ac0 = i0; ac1 = i1; } else { ac0 = tot - ex0; ac1 = tot - ex1; } }
                const float ref = d ? __shfl(ac0, F.lane & ~7) : __shfl(ac1, (F.lane & ~7) + 7);
                LAS float* D_ = (d ? DTB : DTF) + w * 128 + 2 * F.lane; LAS float* A_ = (d ? ACB : ACF) + w * 128 + 2 * F.lane; LAS float* C_ = (d ? CFB : CFF) + w * 128 + 2 * F.lane;
                D_[0] = dt0; D_[1] = dt1; A_[0] = ac0; A_[1] = ac1; C_[0] = dt0 * __expf(ref - ac0); C_[1] = dt1 * __expf(ref - ac1); } }
        LDS_BARRIER();
        {
#pragma unroll
            for (int pc = 0; pc < 4; ++pc) { const int isC = pc >> 1, half = pc & 1;
                float o0[8], o1[8]; conv8(rbc[pc], CWBC, 256, isC * 128 + half * 64 + 2 * pp, o0, o1, zlo, zhi);
                LAS unsigned char* dst = (isC ? CS : BS) + (half * 64 + 2 * pp) * 2;
#pragma unroll
                for (int j = 0; j < 8; ++j) *(LAS unsigned*)(dst + (8 * sr + j) * PT) = pk2(o0[j], o1[j]); } }
        unsigned rx[12];
        raw_load(rx, P, b, c, PC_X + (g * HPG) * 64, F.tid);
        LDS_BARRIER();
        f32x4 cb[8];
#pragma unroll
        for (int t = 0; t < 8; ++t) cb[t] = (f32x4){0.f, 0.f, 0.f, 0.f};
#pragma unroll
        for (int kk = 0; kk < 4; ++kk) { const bf16x8 q = ldfrag(CS, PT, 16 * w + fr, 32 * kk + 8 * fq); bf16x8 pf[8];
#pragma unroll
            for (int t = 0; t < 8; ++t) pf[t] = ldfrag(BS, PT, 16 * t + fr, 32 * kk + 8 * fq);
            MFMA_BEGIN();
#pragma unroll
            for (int t = 0; t < 8; ++t) cb[t] = __builtin_amdgcn_mfma_f32_16x16x32_bf16(pf[t], q, cb[t], 0, 0, 0);
            MFMA_END(); }
        LDS_BARRIER();
        const int l = 16 * w + fr;
        float ssq = 0.f;
        v4u pv0, pv1; { const unsigned char* src = ST + ((size_t)((b * NCHUNK + c) * HEADS + g * HPG) * 2) * 8192 + F.tid * 16; pv0 = *(const GAS v4u*)src; pv1 = *(const GAS v4u*)(src + 8192); }
#pragma unroll 1
        for (int hh = 0; hh < HPG; ++hh) { const int h = g * HPG + hh;
            { float o0[8], o1[8]; conv8(rx, CWX, 384, hh * 64 + 2 * pp, o0, o1, zlo, zhi); store_T(XT, 2 * pp, 8 * sr, o0, o1, nullptr); }
            raw_load(rx, P, b, c, PC_X + (g * HPG + (hh + 1 < HPG ? hh + 1 : hh)) * 64, F.tid);
            f32x4 Y[4];
#pragma unroll
            for (int pt = 0; pt < 4; ++pt) Y[pt] = (f32x4){0.f, 0.f, 0.f, 0.f};
            const float dsk = HC[hh * 8 + 6];
            v2u zw[4]; { const bf16* zrow = P + (size_t)(b * SEQ + c * CHUNK + l) * PW + PC_Z + h * 64;
#pragma unroll
                for (int pt = 0; pt < 4; ++pt) zw[pt] = *(const GAS v2u*)(zrow + 16 * pt + 4 * fq); }
            {
                const int kd = w >> 1;
#pragma unroll
                for (int d = 0; d < 2; ++d) {
                    const LAS float* AC = (d ? ACB : ACF) + hh * 128; const LAS float* DT_ = (d ? DTB : DTF) + hh * 128; const LAS float* CF = (d ? CFB : CFF) + hh * 128;
                    const float al = AC[l];
#pragma unroll
                    for (int t = 0; t < 8; ++t) {
                        if (d ? ((t >> 1) < kd) : ((t >> 1) > kd)) continue;
                        float o[4];
                        if (t == w) { const f32x4 as = *(const LAS f32x4*)(AC + 16 * t + 4 * fq), ds = *(const LAS f32x4*)(DT_ + 16 * t + 4 * fq);
#pragma unroll
                            for (int r = 0; r < 4; ++r) { const int s = 16 * t + 4 * fq + r; const bool keep = d ? (s >= l) : (s <= l);
                                float v = cb[t][r] * __expf(al - as[r]) * ds[r]; v = keep ? v : 0.f; if (d == 0 && s == l) v += dsk; o[r] = v; } }
                        else if (d ? (t > w) : (t < w)) { const float rr = __expf(al - AC[d ? 16 * t : 16 * t + 15]); const f32x4 cf = *(const LAS f32x4*)(CF + 16 * t + 4 * fq);
#pragma unroll
                            for (int r = 0; r < 4; ++r) o[r] = cb[t][r] * rr * cf[r]; }
                        else { o[0] = 0.f; o[1] = 0.f; o[2] = 0.f; o[3] = 0.f; }
                        v2u pw; pw.x = pk2(o[0], o[1]); pw.y = pk2(o[2], o[3]);
                        if (d && (t >> 1) == kd) *(LAS v2u*)(XB + fr * 80 + ((t & 1) * 16 + 4 * fq) * 2) = pw;
                        else *(LAS v2u*)(LB + fr * PT + (16 * t + 4 * fq) * 2) = pw; }
                    { LAS unsigned char* PV = PVB + d * 17408; const v4u pvx = d ? pv1 : pv0;
                      const int r0 = 16 * (w & 3) + fr, n0 = 64 * (w >> 2) + 4 * fq; const float ps = HC[hh * 8 + 4 + d];
                      const int wv[4] = { (int)pvx.x, (int)pvx.y, (int)pvx.z, (int)pvx.w };
#pragma unroll
                      for (int q = 0; q < 4; ++q) { v2u o; o.x = pk2(ps * __builtin_amdgcn_cvt_f32_fp8(wv[q], 0), ps * __builtin_amdgcn_cvt_f32_fp8(wv[q], 1)); o.y = pk2(ps * __builtin_amdgcn_cvt_f32_fp8(wv[q], 2), ps * __builtin_amdgcn_cvt_f32_fp8(wv[q], 3));
                          *(LAS v2u*)(PV + r0 * PT + (n0 + 16 * q) * 2) = o; } }
                }
                { const unsigned char* src = ST + ((size_t)((b * NCHUNK + c) * HEADS + (hh + 1 < HPG ? h + 1 : h)) * 2) * 8192 + F.tid * 16; pv0 = *(const GAS v4u*)src; pv1 = *(const GAS v4u*)(src + 8192); }
                LDS_BARRIER();
                f32x4 Zf[4], Zb[4];
#pragma unroll
                for (int pt = 0; pt < 4; ++pt) { Zf[pt] = (f32x4){0.f, 0.f, 0.f, 0.f}; Zb[pt] = (f32x4){0.f, 0.f, 0.f, 0.f}; }
#pragma unroll
                for (int kk = 0; kk < 4; ++kk) { const bool yf = kk <= kd, yb = kk >= kd;
                    bf16x8 xp[4], lf, lb2;
#pragma unroll
                    for (int pt = 0; pt < 4; ++pt) xp[pt] = ldfrag(XT, PT, 16 * pt + fr, 32 * kk + 8 * fq);
                    lf = ldfrag(LB, PT, fr, 32 * kk + 8 * fq);
                    lb2 = (kk == kd) ? *(const LAS bf16x8*)(XB + fr * 80 + 16 * fq) : lf;
                    MFMA_BEGIN();
                    if (yf || kk > kd) {
#pragma unroll
                        for (int pt = 0; pt < 4; ++pt) Y[pt] = __builtin_amdgcn_mfma_f32_16x16x32_bf16(xp[pt], lf, Y[pt], 0, 0, 0); }
                    if (yb && kk == kd) {
#pragma unroll
                        for (int pt = 0; pt < 4; ++pt) Y[pt] = __builtin_amdgcn_mfma_f32_16x16x32_bf16(xp[pt], lb2, Y[pt], 0, 0, 0); }
                    MFMA_END2(); }
#pragma unroll
                for (int kk = 0; kk < 4; ++kk) { const bf16x8 cq = ldfrag(CS, PT, 16 * w + fr, 32 * kk + 8 * fq); bf16x8 pf_[4], pb_[4];
#pragma unroll
                    for (int pt = 0; pt < 4; ++pt) { pf_[pt] = ldfrag(PVB, PT, 16 * pt + fr, 32 * kk + 8 * fq); pb_[pt] = ldfrag(PVB + 17408, PT, 16 * pt + fr, 32 * kk + 8 * fq); }
                    MFMA_BEGIN();
#pragma unroll
                    for (int pt = 0; pt < 4; ++pt) { Zf[pt] = __builtin_amdgcn_mfma_f32_16x16x32_bf16(pf_[pt], cq, Zf[pt], 0, 0, 0); Zb[pt] = __builtin_amdgcn_mfma_f32_16x16x32_bf16(pb_[pt], cq, Zb[pt], 0, 0, 0); }
                    MFMA_END(); }
                const float elf = __expf(ACF[hh * 128 + l]), elb = __expf(ACB[hh * 128 + l]);
#pragma unroll
                for (int pt = 0; pt < 4; ++pt) Y[pt] = Y[pt] + Zf[pt] * elf + Zb[pt] * elb;
            }
            bf16* yrow0 = YN + (size_t)(b * SEQ + c * CHUNK + l) * INNER + g * 384 + hh * 64;
#pragma unroll
            for (int pt = 0; pt < 4; ++pt) {
                const float v0 = Y[pt][0] * siluf_(bflo(zw[pt].x)), v1 = Y[pt][1] * siluf_(bfhi(zw[pt].x)), v2 = Y[pt][2] * siluf_(bflo(zw[pt].y)), v3 = Y[pt][3] * siluf_(bfhi(zw[pt].y));
                ssq += (v0 * v0 + v1 * v1) + (v2 * v2 + v3 * v3); v2u o; o.x = pk2(v0, v1); o.y = pk2(v2, v3); *(GAS v2u*)(yrow0 + 16 * pt + 4 * fq) = o; }
            LDS_BARRIER();
        }
        ssq += __shfl_xor(ssq, 16); ssq += __shfl_xor(ssq, 32);
        const float rstd = 1.f / sqrtf(ssq * (1.f / 384.f) + RMS_EPS);
        VM_WAIT();
        bf16* yrow = YN + (size_t)(b * SEQ + c * CHUNK + l) * INNER + g * 384;
        v2u yv[HPG][4];
#pragma unroll
        for (int hh = 0; hh < HPG; ++hh)
#pragma unroll
            for (int pt = 0; pt < 4; ++pt) yv[hh][pt] = *(const GAS v2u*)(yrow + hh * 64 + 16 * pt + 4 * fq);
#pragma unroll
        for (int hh = 0; hh < HPG; ++hh)
#pragma unroll
            for (int pt = 0; pt < 4; ++pt) { const v2u vv = yv[hh][pt]; v2u o; o.x = pk2(bflo(vv.x) * rstd, bfhi(vv.x) * rstd); o.y = pk2(bflo(vv.y) * rstd, bfhi(vv.y) * rstd);
                *(GAS v2u*)(yrow + hh * 64 + 16 * pt + 4 * fq) = o; }
    }
}

__device__ __forceinline__ void zt_put(LAS unsigned char* ZT, int pb, int ch0, int kidx, v4u v, bool odd) {
    const unsigned w[4] = { v.x, v.y, v.z, v.w };
#pragma unroll
    for (int m = 0; m < 4; ++m) { const unsigned send = odd ? (w[m] & 0xffffu) : (w[m] >> 16); const unsigned recv = (unsigned)__shfl_xor((int)send, 1);
        const unsigned val = odd ? (recv | (w[m] & 0xffff0000u)) : ((w[m] & 0xffffu) | (recv << 16));
        const int off = odd ? (ch0 + 2 * m + 1) * pb + (kidx - 1) * 2 : (ch0 + 2 * m) * pb + kidx * 2;
        *(LAS unsigned*)(ZT + off) = val; }
}
__device__ __forceinline__ void phase_dft1(Frame& F) {
    LAS unsigned char* WM = F.lds;
    LAS unsigned char* ZT = F.lds + 34816;
    LAS unsigned char* UT = F.lds + 104448;
    const bf16* P = WSP(bf16, WS_PROJ); bf16* GB = WSP(bf16, WS_GB); const f32x2* TW = WSP(f32x2, WS_TW);
    __syncthreads();
    for (int q = F.tid; q < 128 * 16; q += NTHR) { const int r = q >> 4, part = q & 15; *(LAS v4u*)(WM + r * PT + part * 16) = *(const GAS v4u*)(WSP(bf16, WS_WM1) + r * 128 + part * 8); }
    const int fr = F.lane & 15, fq = F.lane >> 4, w = F.wave;
    bf16x8 dfr[2][4];
#pragma unroll
    for (int i = 0; i < 2; ++i)
#pragma unroll
        for (int kk = 0; kk < 4; ++kk) dfr[i][kk] = *(const GAS bf16x8*)(WSP(bf16, WS_DM) + (size_t)(32 * w + 16 * i + fr) * 128 + 32 * kk + 8 * fq);
    constexpr int NU1 = NB * 128 * 2;
    v4u ul[4];
#define DFT1_LOAD(uu) do { const int jh_ = (uu) & 1, s2_ = ((uu) >> 1) & 127, b_ = (uu) >> 8; _Pragma("unroll") for (int i = 0; i < 4; ++i) { const int q = F.tid + 512 * i, gl = q >> 10, r = (q >> 4) & 63, part = q & 15; \
        ul[i] = *(const GAS v4u*)(P + (size_t)(b_ * SEQ + 128 * r + s2_) * PW + PC_U + (2 * jh_ + gl) * 128 + part * 8); } } while (0)
    if ((int)F.bx < NU1) DFT1_LOAD((int)F.bx);
    for (int u = F.bx; u < NU1; u += F.G) {
        const int jh = u & 1, s2 = (u >> 1) & 127, b = u >> 8;
        const int un = u + F.G < NU1 ? u + F.G : u;
        LDS_BARRIER();
#pragma unroll
        for (int i = 0; i < 4; ++i) { const int q = F.tid + 512 * i, gl = q >> 10, r = (q >> 4) & 63, part = q & 15; *(LAS v4u*)(UT + gl * 17408 + r * PT + part * 16) = ul[i]; }
        DFT1_LOAD(un);
        const f32x2 tw = TW[(s2 * (16 * (w & 3) + fr)) & 8191];
        LDS_BARRIER();
#pragma unroll
        for (int gl = 0; gl < 2; ++gl)
#pragma unroll
            for (int tt = 0; tt < 4; ++tt) { bf16x8 uf[4];
#pragma unroll
                for (int kk = 0; kk < 4; ++kk) uf[kk] = ldfrag(UT + gl * 17408, PT, 16 * tt + fr, 32 * kk + 8 * fq);
                f32x4 za[2] = { (f32x4){0.f, 0.f, 0.f, 0.f}, (f32x4){0.f, 0.f, 0.f, 0.f} };
                MFMA_BEGIN();
#pragma unroll
                for (int kk = 0; kk < 4; ++kk) { za[0] = __builtin_amdgcn_mfma_f32_16x16x32_bf16(uf[kk], dfr[0][kk], za[0], 0, 0, 0); za[1] = __builtin_amdgcn_mfma_f32_16x16x32_bf16(uf[kk], dfr[1][kk], za[1], 0, 0, 0); }
                MFMA_END2();
#pragma unroll
                for (int i = 0; i < 2; ++i) { const int rho = 32 * w + 16 * i + fr; v2u o; o.x = pk2(za[i][0], za[i][1]); o.y = pk2(za[i][2], za[i][3]);
                    *(LAS v2u*)(ZT + (gl * 128 + (rho & 127)) * PT + ((rho >> 7) * 64 + 16 * tt + 4 * fq) * 2) = o; } }
        LDS_BARRIER();
        const int mi = w & 3, jq = w >> 2;
        f32x4 acc[2][8];
#pragma unroll
        for (int a = 0; a < 2; ++a)
#pragma unroll
            for (int j = 0; j < 8; ++j) acc[a][j] = (f32x4){0.f, 0.f, 0.f, 0.f};
#pragma unroll
        for (int kk = 0; kk < 4; ++kk) { const bf16x8 q0 = ldfrag(WM, PT, 16 * mi + fr, 32 * kk + 8 * fq), q1 = ldfrag(WM, PT, 64 + 16 * mi + fr, 32 * kk + 8 * fq); bf16x8 pf[8];
#pragma unroll
            for (int j = 0; j < 8; ++j) pf[j] = ldfrag(ZT, PT, 128 * jq + 16 * j + fr, 32 * kk + 8 * fq);
            MFMA_BEGIN();
#pragma unroll
            for (int j = 0; j < 8; ++j) { acc[0][j] = __builtin_amdgcn_mfma_f32_16x16x32_bf16(pf[j], q0, acc[0][j], 0, 0, 0); acc[1][j] = __builtin_amdgcn_mfma_f32_16x16x32_bf16(pf[j], q1, acc[1][j], 0, 0, 0); }
            MFMA_END(); }
        const int k1 = 16 * mi + fr;
        bf16* orow = GB + ((size_t)(b * 128 + s2) * 64 + k1) * 1024 + jh * 256 + 128 * jq + 4 * fq;
#pragma unroll
        for (int j = 0; j < 8; ++j) { float gr[4], gi[4];
#pragma unroll
            for (int r = 0; r < 4; ++r) { const float a = acc[0][j][r], bq = acc[1][j][r]; gr[r] = a * tw.x + bq * tw.y; gi[r] = bq * tw.x - a * tw.y; }
            v2u o; o.x = pk2(gr[0], gr[1]); o.y = pk2(gr[2], gr[3]); *(GAS v2u*)(orow + 16 * j) = o;
            o.x = pk2(gi[0], gi[1]); o.y = pk2(gi[2], gi[3]); *(GAS v2u*)(orow + 512 + 16 * j) = o; }
    }
}
constexpr int PT2 = 528;
__device__ __forceinline__ void phase_dft2(Frame& F) {
    LAS unsigned char* WM = F.lds;
    LAS unsigned char* ZT = F.lds + 67584;
    const bf16* GB = WSP(bf16, WS_GB); bf16* FO = WSP(bf16, WS_FO);
    LDS_BARRIER();
    for (int q = F.tid; q < 128 * 32; q += NTHR) { const int r = q >> 5, part = q & 31; *(LAS v4u*)(WM + r * PT2 + part * 16) = *(const GAS v4u*)(WSP(bf16, WS_WM2) + r * 256 + part * 8); }
    const int fr = F.lane & 15, fq = F.lane >> 4, w = F.wave;
    constexpr int NU2 = NB * 64 * 4;
    v4u vv[8];
#define DFT2_LOAD(uu) do { const int jb_ = (uu) & 3, k1_ = ((uu) >> 2) & 63, b_ = (uu) >> 8; const int s2_ = 64 * (w & 1) + F.lane; const bf16* row = GB + ((size_t)(b_ * 128 + s2_) * 64 + k1_) * 1024; \
        _Pragma("unroll") for (int q = 0; q < 8; ++q) { const int cc = (w >> 1) + 4 * q; const int im = cc >= 16, chunk = cc & 15; vv[q] = *(const GAS v4u*)(row + im * 512 + jb_ * 128 + chunk * 8); } } while (0)
    if ((int)F.bx < NU2) DFT2_LOAD((int)F.bx);
    for (int u = F.bx; u < NU2; u += F.G) {
        const int jb = u & 3, k1 = (u >> 2) & 63, b = u >> 8;
        const int un = u + F.G < NU2 ? u + F.G : u;
        LDS_BARRIER();
        { const int s2 = 64 * (w & 1) + F.lane;
#pragma unroll
          for (int q = 0; q < 8; ++q) { const int cc = (w >> 1) + 4 * q; const int im = cc >= 16, chunk = cc & 15; zt_put(ZT, PT2, chunk * 8, im * 128 + s2, vv[q], s2 & 1); } }
        DFT2_LOAD(un);
        LDS_BARRIER();
        f32x4 acc[8];
#pragma unroll
        for (int j = 0; j < 8; ++j) acc[j] = (f32x4){0.f, 0.f, 0.f, 0.f};
#pragma unroll
        for (int kk = 0; kk < 8; ++kk) { const bf16x8 q = ldfrag(WM, PT2, 16 * w + fr, 32 * kk + 8 * fq); bf16x8 pf[8];
#pragma unroll
            for (int j = 0; j < 8; ++j) pf[j] = ldfrag(ZT, PT2, 16 * j + fr, 32 * kk + 8 * fq);
            MFMA_BEGIN();
#pragma unroll
            for (int j = 0; j < 8; ++j) acc[j] = __builtin_amdgcn_mfma_f32_16x16x32_bf16(pf[j], q, acc[j], 0, 0, 0);
            MFMA_END(); }
        const int k2 = 16 * w + fr; bf16* orow = FO + (size_t)(b * SEQ + k1 + 64 * k2) * 512 + jb * 128 + 4 * fq;
#pragma unroll
        for (int j = 0; j < 8; ++j) { v2u o; o.x = pk2(acc[j][0], acc[j][1]); o.y = pk2(acc[j][2], acc[j][3]); *(GAS v2u*)(orow + 16 * j) = o; }
    }
}

__device__ __forceinline__ void phase_norm2(Frame& F) {
    LAS float* GM = (LAS float*)(F.lds); LAS float* GS = GM + 4096; LAS float* SH = GS + 4096;
    const float* mod = WSP(float, WS_MOD);
    __syncthreads();
    for (int i = F.tid; i < 4096; i += NTHR) { const int b = i >> 10, col = i & 1023; GM[i] = mod[b * 6144 + 2048 + col] * FIN(5)[col]; GS[i] = FIN(6)[col] * (1.f + mod[b * 6144 + 4096 + col]); SH[i] = mod[b * 6144 + 3072 + col]; }
    __syncthreads();
    const int gw = F.bx * NWAVES + F.wave, NGW = F.G * NWAVES; const float* x = FIN(0); bf16* H = WSP(bf16, WS_H); const bf16* MX = WSP(bf16, WS_MIXED);
    v2u nmw[4]; f32x4 nxv[4];
    if (gw < T) { const GAS v2u* mr = (const GAS v2u*)(MX + (size_t)gw * D) + F.lane; const GAS f32x4* xr = (const GAS f32x4*)(x + (size_t)gw * D) + F.lane;
#pragma unroll
        for (int j = 0; j < 4; ++j) { nmw[j] = mr[64 * j]; nxv[j] = xr[64 * j]; } }
    for (int m = gw; m < T; m += NGW) { const int b = m / SEQ;
        f32x4 v[4], xv[4]; float ss = 0.f;
#pragma unroll
        for (int j = 0; j < 4; ++j) { const v2u mw = nmw[j]; xv[j] = nxv[j]; v[j] = (f32x4){bflo(mw.x), bfhi(mw.x), bflo(mw.y), bfhi(mw.y)}; }
        if (m + NGW < T) { const GAS v2u* mr = (const GAS v2u*)(MX + (size_t)(m + NGW) * D) + F.lane; const GAS f32x4* xr = (const GAS f32x4*)(x + (size_t)(m + NGW) * D) + F.lane;
#pragma unroll
            for (int j = 0; j < 4; ++j) { nmw[j] = mr[64 * j]; nxv[j] = xr[64 * j]; } }
#pragma unroll
        for (int j = 0; j < 4; ++j) ss += (v[j].x * v[j].x + v[j].y * v[j].y) + (v[j].z * v[j].z + v[j].w * v[j].w);
        const float rstd = 1.f / sqrtf(wave_sum(ss) * (1.f / D) + RMS_EPS); float s2 = 0.f;
        GAS v2u* x1o = (GAS v2u*)(WSP(bf16, WS_MIXED) + (size_t)m * D) + F.lane;
#pragma unroll
        for (int j = 0; j < 4; ++j) { const LAS float* gm = GM + b * 1024 + 4 * F.lane + 256 * j;
            v[j].x = xv[j].x + gm[0] * v[j].x * rstd; v[j].y = xv[j].y + gm[1] * v[j].y * rstd; v[j].z = xv[j].z + gm[2] * v[j].z * rstd; v[j].w = xv[j].w + gm[3] * v[j].w * rstd;
            { v2u o; o.x = pk2(v[j].x, v[j].y); o.y = pk2(v[j].z, v[j].w); x1o[64 * j] = o; } s2 += (v[j].x * v[j].x + v[j].y * v[j].y) + (v[j].z * v[j].z + v[j].w * v[j].w); }
        const float rstd2 = 1.f / sqrtf(wave_sum(s2) * (1.f / D) + RMS_EPS);
        GAS unsigned long long* o8 = (GAS unsigned long long*)(H + (size_t)m * D) + F.lane;
#pragma unroll
        for (int j = 0; j < 4; ++j) { const int col = 4 * F.lane + 256 * j; const LAS float* gs = GS + b * 1024 + col; const LAS float* sh = SH + b * 1024 + col;
            o8[64 * j] = (unsigned long long)pk2(v[j].x * rstd2 * gs[0] + sh[0], v[j].y * rstd2 * gs[1] + sh[1]) | ((unsigned long long)pk2(v[j].z * rstd2 * gs[2] + sh[2], v[j].w * rstd2 * gs[3] + sh[3]) << 32); }
    }
}

#define DPP_MAX_STEP(ctrl, rmask) do { const float ov = __builtin_bit_cast(float, __builtin_amdgcn_update_dpp(__builtin_bit_cast(int, bv), __builtin_bit_cast(int, bv), ctrl, rmask, 0xf, false)); \
        const int oi = __builtin_amdgcn_update_dpp(bi, bi, ctrl, rmask, 0xf, false); const bool tk = ov > bv || (ov == bv && oi < bi); bv = tk ? ov : bv; bi = tk ? oi : bi; } while (0)
__device__ __forceinline__ void wave_argmax(float& bv, int& bi) {
    DPP_MAX_STEP(0x111, 0xf); DPP_MAX_STEP(0x112, 0xf); DPP_MAX_STEP(0x114, 0xf); DPP_MAX_STEP(0x118, 0xf);
    DPP_MAX_STEP(0x142, 0xa); DPP_MAX_STEP(0x143, 0xc);
    bv = __builtin_bit_cast(float, __builtin_amdgcn_readlane(__builtin_bit_cast(int, bv), 63)); bi = __builtin_amdgcn_readlane(bi, 63);
}
__device__ __forceinline__ void phase_route(Frame& F) {
    LAS int* hist = (LAS int*)(F.lds);
    const float* LOG = WSP(float, WS_LOG); const float* rb = FIN(21); int* TOPI = WSP(int, WS_TOPI); float* TOPW = WSP(float, WS_TOPW); int* BCNT = WSP(int, WS_BCNT);
    const int lane = F.lane;
    LAS float* cscr = (LAS float*)(F.lds + 4096 + F.wave * 16896);
    const int cNGW = F.G * NWAVES; int r13 = F.bx * NWAVES + F.wave;
    for (int vb = F.bx; vb < 256; vb += F.G) {
        __syncthreads();
        if (F.tid < 256) hist[F.tid] = 0;
        __syncthreads();
        const f32x4 bb = *(const GAS f32x4*)(rb + 4 * lane);
        f32x4 nlg[4];
#pragma unroll
        for (int q = 0; q < 4; ++q) nlg[q] = *(const GAS f32x4*)(LOG + (size_t)(vb * 128 + F.wave * 4 + q) * 256 + 4 * lane);
        for (int ti = F.wave * 4; ti < 128; ti += NWAVES * 4) {
            TrItem ct[W13_RPT]; f32x4 cv[W13_RPT][16];
#pragma unroll
            for (int ci = 0; ci < W13_RPT; ++ci) { const int rr = r13 + ci * cNGW; ct[ci] = w13_item(F, rr < W13_ROUTE ? rr : W13_ROUTE - 1); tr_load(ct[ci], cv[ci], lane); }
            float sc[4][4], cand[4][4], wsum[4], mysc[4]; int myidx[4];
            f32x4 clg[4];
#pragma unroll
            for (int q = 0; q < 4; ++q) clg[q] = nlg[q];
            { const int tn = ti + NWAVES * 4 < 128 ? ti + NWAVES * 4 : ti;
#pragma unroll
              for (int q = 0; q < 4; ++q) nlg[q] = *(const GAS f32x4*)(LOG + (size_t)(vb * 128 + tn + q) * 256 + 4 * lane); }
#pragma unroll
            for (int q = 0; q < 4; ++q) { const int t = vb * 128 + ti + q;
                const f32x4 lg = clg[q];
                float bs[4];
#pragma unroll
                for (int j = 0; j < 4; ++j) { sc[q][j] = 1.f / (1.f + expf(-lg[j])); bs[j] = sc[q][j] + bb[j]; }
                float m1 = fmaxf(fmaxf(bs[0], bs[1]), fmaxf(bs[2], bs[3])), m2;
                { float a_ = fmaxf(bs[0], bs[1]), a2 = fminf(bs[0], bs[1]), c_ = fmaxf(bs[2], bs[3]), c2 = fminf(bs[2], bs[3]); m2 = fmaxf(fminf(a_, c_), fmaxf(a2, c2)); }
#define TOP2_STEP(ctrl) do { const float o1 = __builtin_bit_cast(float, __builtin_amdgcn_update_dpp(0, __builtin_bit_cast(int, m1), ctrl, 0xf, 0xf, false)), o2 = __builtin_bit_cast(float, __builtin_amdgcn_update_dpp(0, __builtin_bit_cast(int, m2), ctrl, 0xf, 0xf, false)); \
                    const float n1 = fmaxf(m1, o1), n2 = fmaxf(fminf(m1, o1), fmaxf(m2, o2)); m1 = n1; m2 = n2; } while (0)
                TOP2_STEP(0xb1); TOP2_STEP(0x4e); TOP2_STEP(0x141);
#undef TOP2_STEP
                const float gs = m1 + m2; const int mygrp = lane >> 3; int rank = 0;
#pragma unroll
                for (int j = 0; j < 8; ++j) { const float og = __builtin_bit_cast(float, __builtin_amdgcn_readlane(__builtin_bit_cast(int, gs), 8 * j)); rank += (og > gs || (og == gs && j < mygrp)) ? 1 : 0; }
                const bool gsel = rank < 4;
#pragma unroll
                for (int j = 0; j < 4; ++j) cand[q][j] = gsel ? bs[j] : -INFINITY;
                wsum[q] = 0.f; mysc[q] = 0.f; myidx[q] = 0; }
            for (int k = 0; k < TOPK; ++k) {
#pragma unroll
                for (int q = 0; q < 4; ++q) {
                    float bv = cand[q][0]; int bi = 4 * lane;
#pragma unroll
                    for (int j = 1; j < 4; ++j) if (cand[q][j] > bv) { bv = cand[q][j]; bi = 4 * lane + j; }
                    wave_argmax(bv, bi);
                    const int own = bi >> 2, sub = bi & 3;
                    const float s_own = sub == 0 ? sc[q][0] : (sub == 1 ? sc[q][1] : (sub == 2 ? sc[q][2] : sc[q][3]));
                    const float ssel = __builtin_bit_cast(float, __builtin_amdgcn_readlane(__builtin_bit_cast(int, s_own), own));
                    if (lane == own) {
#pragma unroll
                        for (int j = 0; j < 4; ++j) if (j == sub) cand[q][j] = -INFINITY; }
                    wsum[q] += ssel; if (lane == k) { myidx[q] = bi; mysc[q] = ssel; } }
            }
#pragma unroll
            for (int q = 0; q < 4; ++q) { const int t = vb * 128 + ti + q;
                if (lane < TOPK) { TOPI[t * TOPK + lane] = myidx[q]; TOPW[t * TOPK + lane] = mysc[q] / wsum[q] * 2.5f; atomicAdd((int*)&hist[myidx[q]], 1); } }
#pragma unroll
            for (int ci = 0; ci < W13_RPT; ++ci) if (r13 + ci * cNGW < W13_ROUTE) { tr_put<false>(ct[ci], cv[ci], cscr, lane); tr_get(ct[ci], cscr, lane); }
            r13 += W13_RPT * cNGW;
        }
        __syncthreads();
        if (F.tid < 256) BCNT[vb * 256 + F.tid] = hist[F.tid];
    }
    for (; r13 < W13_ROUTE; r13 += cNGW) { const TrItem ct = w13_item(F, r13); f32x4 cv[16]; tr_load(ct, cv, lane); tr_put<false>(ct, cv, cscr, lane); tr_get(ct, cscr, lane); }
}

__device__ __forceinline__ void phase_lists(Frame& F) {
    LAS int* tot = (LAS int*)(F.lds);
    LAS int* base = tot + 256;
    LAS int* pre = base + 260;
    LAS int* cur = pre + 256;
    LAS int* part = cur + 256;
    const int* BCNT = WSP(int, WS_BCNT); const int* TOPI = WSP(int, WS_TOPI); int* TOKPOS = WSP(int, WS_TOKPOS); int* ROWTOK = WSP(int, WS_ROWTOK); int* TILEE = WSP(int, WS_TILEE);
    typedef int i32x4 __attribute__((ext_vector_type(4)));
    const int e4 = (F.tid & 63) * 4, rg = F.tid >> 6;
    for (int vb = F.bx; vb < 256; vb += F.G) {
        __syncthreads();
        { i32x4 st = (i32x4){0, 0, 0, 0}, sp = (i32x4){0, 0, 0, 0};
#pragma unroll 8
          for (int i = 0; i < 32; ++i) { const int v = rg + 8 * i; const i32x4 c4 = *(const GAS i32x4*)(BCNT + v * 256 + e4); st += c4; if (v < vb) sp += c4; }
          *(LAS i32x4*)(part + rg * 256 + e4) = st; *(LAS i32x4*)(part + 2048 + rg * 256 + e4) = sp; }
        __syncthreads();
        if (F.tid < 256) { int s = 0, q = 0;
#pragma unroll
            for (int r = 0; r < 8; ++r) { s += part[r * 256 + F.tid]; q += part[2048 + r * 256 + F.tid]; }
            tot[F.tid] = s; pre[F.tid] = q; cur[F.tid] = 0; }
        __syncthreads();
        if (F.tid < 256) { const int pad = (tot[F.tid] + 255) & ~255; int v = pad;
#pragma unroll
            for (int o = 1; o < 64; o <<= 1) { const int t_ = __shfl_up(v, o); if (F.lane >= o) v += t_; }
            part[F.tid] = v - pad; if (F.lane == 63) part[256 + F.wave] = v; }
        __syncthreads();
        if (F.tid < 256) { int off = T; for (int w_ = 0; w_ < F.wave; ++w_) off += part[256 + w_]; base[F.tid] = off + part[F.tid]; if (F.tid == 255) base[256] = off + part[255] + ((tot[255] + 255) & ~255); }
        __syncthreads();
        if (vb == 0) {
            int* TILEV = WSP(int, WS_TILEV);
            if (F.tid < 256) { const int e = F.tid; int left = tot[e]; for (int t = base[e] >> 8; t < (base[e + 1] >> 8); ++t) { TILEE[t] = e; TILEV[t] = left < 256 ? left : 256; left -= 256; } }
            for (int t = F.tid; t < T / 256; t += NTHR) { TILEE[t] = NE; TILEV[t] = 256; }
            if (F.tid == 0) { F.ctl[CW_NTILES] = (unsigned)(base[256] >> 8); F.ctl[CW_BASESH] = 0u; }
        }
        for (int r = base[vb] + tot[vb] + F.tid; r < base[vb + 1]; r += NTHR) ROWTOK[r] = 0;
        for (int i = F.tid; i < 128 * TOPK; i += NTHR) { const int t = vb * 128 + (i >> 3); const int e = TOPI[t * TOPK + (i & 7)]; const int pos = base[e] + pre[e] + atomicAdd((int*)&cur[e], 1);
            ROWTOK[pos] = t; TOKPOS[t * TOPK + (i & 7)] = pos; }
    }
}

__device__ __forceinline__ void phase_final(Frame& F) {
    LAS float* GF = (LAS float*)(F.lds);
    const float* mod = WSP(float, WS_MOD);
    __syncthreads();
    for (int i = F.tid; i < 4096; i += NTHR) { const int b = i >> 10, col = i & 1023; GF[i] = mod[b * 6144 + 5120 + col] * FIN(7)[col]; }
    __syncthreads();
    const int gw = F.bx * NWAVES + F.wave, NGW = F.G * NWAVES; const unsigned char* YB = WSP(unsigned char, WS_YB); const int* TOKPOS = WSP(int, WS_TOKPOS); const float* TOPW = WSP(float, WS_TOPW);
    const int basesh = (int)__hip_atomic_load(F.ctl + CW_BASESH, RLX_AGENT);
    int npos[TOPK + 1]; float nwk[TOPK + 1]; v2u ny0[TOPK + 1], ny1[TOPK + 1];
#define FIN_LOAD_PW(mm) do { _Pragma("unroll") for (int k = 0; k < TOPK; ++k) { npos[k] = TOKPOS[(mm) * TOPK + k]; nwk[k] = TOPW[(mm) * TOPK + k] * (1.f / YB_SCALE); } npos[TOPK] = basesh + (mm); nwk[TOPK] = 1.f / YB_SCALE; } while (0)
#define FIN_LOAD_ROWS(pos_, y0_, y1_) do { _Pragma("unroll") for (int k = 0; k < TOPK + 1; ++k) { const GAS v2u* yr = (const GAS v2u*)(YB + (size_t)(pos_)[k] * 1024) + F.lane; (y0_)[k] = yr[0]; (y1_)[k] = yr[64]; } } while (0)
    float cwk[TOPK + 1];
    if (gw < T) { FIN_LOAD_PW(gw); FIN_LOAD_ROWS(npos, ny0, ny1);
#pragma unroll
        for (int k = 0; k < TOPK + 1; ++k) cwk[k] = nwk[k];
        if (gw + NGW < T) FIN_LOAD_PW(gw + NGW); }
    for (int m = gw; m < T; m += NGW) { const int b = m / SEQ;
        float a[16]; v2u y0[TOPK + 1], y1[TOPK + 1]; float wk_[TOPK + 1];
        GAS float* orow = F.out + (size_t)m * D; v4u xw[2];
#pragma unroll
        for (int hlf = 0; hlf < 2; ++hlf) xw[hlf] = *(const GAS v4u*)(WSP(bf16, WS_MIXED) + (size_t)m * D + hlf * 512 + 8 * F.lane);
#pragma unroll
        for (int k = 0; k < TOPK + 1; ++k) { y0[k] = ny0[k]; y1[k] = ny1[k]; wk_[k] = cwk[k]; }
        if (m + NGW < T) { FIN_LOAD_ROWS(npos, ny0, ny1);
#pragma unroll
            for (int k = 0; k < TOPK + 1; ++k) cwk[k] = nwk[k];
            if (m + 2 * NGW < T) FIN_LOAD_PW(m + 2 * NGW); }
#pragma unroll
        for (int j = 0; j < 16; ++j) a[j] = 0.f;
#pragma unroll
        for (int k = 0; k < TOPK + 1; ++k) { const float wk = wk_[k];
            a[0] += wk * __builtin_amdgcn_cvt_f32_fp8((int)y0[k].x, 0); a[1] += wk * __builtin_amdgcn_cvt_f32_fp8((int)y0[k].x, 1); a[2] += wk * __builtin_amdgcn_cvt_f32_fp8((int)y0[k].x, 2); a[3] += wk * __builtin_amdgcn_cvt_f32_fp8((int)y0[k].x, 3);
            a[4] += wk * __builtin_amdgcn_cvt_f32_fp8((int)y0[k].y, 0); a[5] += wk * __builtin_amdgcn_cvt_f32_fp8((int)y0[k].y, 1); a[6] += wk * __builtin_amdgcn_cvt_f32_fp8((int)y0[k].y, 2); a[7] += wk * __builtin_amdgcn_cvt_f32_fp8((int)y0[k].y, 3);
            a[8] += wk * __builtin_amdgcn_cvt_f32_fp8((int)y1[k].x, 0); a[9] += wk * __builtin_amdgcn_cvt_f32_fp8((int)y1[k].x, 1); a[10] += wk * __builtin_amdgcn_cvt_f32_fp8((int)y1[k].x, 2); a[11] += wk * __builtin_amdgcn_cvt_f32_fp8((int)y1[k].x, 3);
            a[12] += wk * __builtin_amdgcn_cvt_f32_fp8((int)y1[k].y, 0); a[13] += wk * __builtin_amdgcn_cvt_f32_fp8((int)y1[k].y, 1); a[14] += wk * __builtin_amdgcn_cvt_f32_fp8((int)y1[k].y, 2); a[15] += wk * __builtin_amdgcn_cvt_f32_fp8((int)y1[k].y, 3); }
        float ss = 0.f;
#pragma unroll
        for (int j = 0; j < 16; ++j) ss += a[j] * a[j];
        const float rstd = 1.f / sqrtf(wave_sum(ss) * (1.f / D) + RMS_EPS);
#pragma unroll
        for (int hlf = 0; hlf < 2; ++hlf) { const int col = hlf * 512 + 8 * F.lane; const LAS float* gf = GF + b * 1024 + col;
            const v4u mw = xw[hlf]; f32x4 x0 = (f32x4){bflo(mw.x), bfhi(mw.x), bflo(mw.y), bfhi(mw.y)}, x1 = (f32x4){bflo(mw.z), bfhi(mw.z), bflo(mw.w), bfhi(mw.w)};
            x0.x += gf[0] * a[8 * hlf + 0] * rstd; x0.y += gf[1] * a[8 * hlf + 1] * rstd; x0.z += gf[2] * a[8 * hlf + 2] * rstd; x0.w += gf[3] * a[8 * hlf + 3] * rstd;
            x1.x += gf[4] * a[8 * hlf + 4] * rstd; x1.y += gf[5] * a[8 * hlf + 5] * rstd; x1.z += gf[6] * a[8 * hlf + 6] * rstd; x1.w += gf[7] * a[8 * hlf + 7] * rstd;
            *(GAS f32x4*)(orow + col) = x0; *(GAS f32x4*)(orow + col + 4) = x1; }
    }
}
constexpr int NPH = 18;
struct Args { const float* in[26]; float* out; unsigned char* ws; };
template <int LO, int HI>
__global__ void __launch_bounds__(NTHR, 2) fwd(Args args) {
    extern __shared__ __attribute__((aligned(16))) unsigned char lds[];
    Frame F;
    F.lds = (LAS unsigned char*)lds; F.ws = (GAS unsigned char*)args.ws; F.ctl = (gu32*)(F.ws + WS_CTL);
    F.tid = threadIdx.x; F.lane = F.tid & 63; F.wave = __builtin_amdgcn_readfirstlane(F.tid >> 6); F.G = gridDim.x; F.bx = blockIdx.x;
    F.out = (GAS float*)args.out;
    volatile LAS unsigned* MISC = (volatile LAS unsigned*)(F.lds + MISC_OFF);
    if (F.tid < 64) MISC[F.tid] = 0u;
#if KSTART_INV
    if (F.tid == 0) { __builtin_amdgcn_fence(__ATOMIC_ACQUIRE, "agent"); asm volatile("s_waitcnt vmcnt(0)" ::: "memory"); }
#endif
    __syncthreads();
    XcdBarrier bar; bar.bar = (unsigned*)(F.ctl + CW_BAR); bar.x = 0; bar.st = nullptr;
    if constexpr (HI - LO > 1) bar = xcd_barrier_post((unsigned*)(F.ctl + CW_BAR), MISC + 8);
#define IN(k) (LO <= (k) && (k) < HI)
#define FRESH() do { int _t = threadIdx.x; asm volatile("" : "+v"(_t)); F.tid = _t; F.lane = _t & 63; F.wave = __builtin_amdgcn_readfirstlane(_t >> 6); \
        unsigned long long _w = (unsigned long long)args.ws; asm volatile("" : "+s"(_w)); F.ws = (GAS unsigned char*)_w; F.ctl = (gu32*)(F.ws + WS_CTL); \
        unsigned long long _o = (unsigned long long)args.out; asm volatile("" : "+s"(_o)); F.out = (GAS float*)_o; } while (0)
#if TIMING
#define TSTAMP(k) do { if (blockIdx.x == 0 && threadIdx.x == 0) ((unsigned long long*)(args.ws + WS_CTL))[256 + (k)] = __builtin_amdgcn_s_memrealtime(); } while (0)
#else
#define TSTAMP(k) do {} while (0)
#endif
#define SEAM(k) do { if constexpr (IN(k) && IN((k) + 1)) xcd_barrier(bar); TSTAMP(k); } while (0)
    TSTAMP(18);
    if constexpr (IN(0)) { FRESH(); phase_prologue(F); } SEAM(0);
    if constexpr (IN(1)) { FRESH(); phase_norm1(F); } SEAM(1);
    if constexpr (IN(2)) { FRESH();
        __syncthreads();
        pg8::Gemm g{WSP(bf16, WS_H), WSP(bf16, WS_WINT), T, NPROJ, D, nullptr}; pg8::StaticOrder S; S.init(T, NPROJ, F.G, F.bx);
        pg8::EpiProj E{WSP(bf16, WS_PROJ), PW, WSP(float, WS_DT), PC_GS / 256, PW / 256};
        pg8::gemm_phase<pg8::EpiProj, pg8::StaticOrder, true, false>(F.lds, g, S, E);
        { const int rem = S.nwg % F.G; const int b0 = rem ? rem : 0;
          if ((int)F.bx >= b0) convert_w2_slice(F, W2_ITEMS - W2_MOVED, W2_ITEMS - W2_MOVED_B, b0, F.G - b0); }
    } SEAM(2);
    if constexpr (IN(3)) { FRESH(); phase_states(F); } TSTAMP(3);
    if constexpr (IN(4)) { FRESH(); phase_dft1(F); } SEAM(4);
    if constexpr (IN(5)) { FRESH(); phase_scan(F); } TSTAMP(5);
    if constexpr (IN(6)) { FRESH(); phase_dft2(F); } SEAM(6);
    if constexpr (IN(7)) { FRESH(); phase_ssd_out(F); } SEAM(7);
    if constexpr (IN(8)) { FRESH();
        __syncthreads();
        pg8::Gemm g{WSP(bf16, WS_YN), WSP(bf16, WS_WBST), T, D, INNER, nullptr}; pg8::StaticOrder S; S.init(T, D, F.G, F.bx);
        pg8::EpiGate<false> E{WSP(bf16, WS_MIX), D, WSP(bf16, WS_PROJ), PW, PC_GS};
        pg8::gemm_phase<pg8::EpiGate<false>, pg8::StaticOrder, true, false>(F.lds, g, S, E);
    } TSTAMP(8);
    if constexpr (IN(9)) { FRESH();
        __syncthreads();
        pg8::Gemm g{WSP(bf16, WS_FO), WSP(bf16, WS_WBFT), T, D, 512, nullptr}; pg8::StaticOrder S; S.init(T, D, F.G, F.bx);
        pg8::EpiGate<true> E{WSP(bf16, WS_MIX), D, WSP(bf16, WS_PROJ), PW, PC_GF};
        pg8::gemm_phase<pg8::EpiGate<true>, pg8::StaticOrder, true, false>(F.lds, g, S, E);
    } SEAM(9);
    if constexpr (IN(10)) { FRESH();
        __syncthreads();
        pg8::Gemm g{WSP(bf16, WS_MIX), WSP(bf16, WS_WOUTT), T, D, D, nullptr}; pg8::StaticOrder S; S.init(T, D, F.G, F.bx);
        pg8::EpiBf16<4> E{WSP(bf16, WS_MIXED), D};
        pg8::gemm_phase<pg8::EpiBf16<4>, pg8::StaticOrder, true, false>(F.lds, g, S, E);
    } SEAM(10);
    if constexpr (IN(11)) { FRESH(); phase_norm2(F); } SEAM(11);
    if constexpr (IN(12)) { FRESH();
        __syncthreads();
        const int nrb = (T / 256 < F.G) ? T / 256 : F.G;
        if (F.bx < nrb || F.G - nrb < 8) {
            pg8::Gemm g{WSP(bf16, WS_H), WSP(bf16, WS_WRT), T, NE, D, nullptr}; pg8::StaticOrder S; S.init(T, NE, F.G, F.bx);
            pg8::EpiF32 E{WSP(float, WS_LOG), NE};
            pg8::gemm_phase<pg8::EpiF32, pg8::StaticOrder, true, false>(F.lds, g, S, E);
            { const bool all_ = F.G - nrb < 8; convert_w2_slice(F, W2_ITEMS - W2_MOVED_B, W2_ITEMS, 0, all_ ? F.G : nrb); }
        }
        if (F.bx >= nrb || F.G - nrb < 8) {
            const bool all = F.G - nrb < 8;
            pg8::Gemm g{WSP(bf16, WS_H), WSP(bf16, WS_W13T), T, NEX * 512, D, nullptr}; pg8::SharedOrder S{T / 256, NE, all ? 0 : nrb, all ? F.G : F.G - nrb, F.bx};
            pg8::EpiSwiglu E{WSP(bf16, WS_HB), EH};
            pg8::gemm_phase<pg8::EpiSwiglu, pg8::SharedOrder, true, false>(F.lds, g, S, E);
        }
    } SEAM(12);
    if constexpr (IN(13)) { FRESH(); phase_route(F); } SEAM(13);
    if constexpr (IN(14)) { FRESH(); phase_lists(F); } SEAM(14);
    if constexpr (IN(15)) { FRESH();
        __syncthreads();
        const int ntiles = (int)__hip_atomic_load(F.ctl + CW_NTILES, RLX_AGENT);
        LAS int* te = (LAS int*)(F.lds + 131072); for (int i = F.tid; i < MAXTILES; i += NTHR) te[i] = (i < ntiles) ? WSP(int, WS_TILEE)[i] : 0;
        __syncthreads();
        pg8::Gemm g{WSP(bf16, WS_H), WSP(bf16, WS_W13T), ROWS_ALL, NEX * 512, D, WSP(int, WS_ROWTOK)}; pg8::GroupedOrder<2> S{te, ntiles, F.G, F.bx, T / 256};
        pg8::EpiSwiglu E{WSP(bf16, WS_HB), EH};
        pg8::gemm_phase<pg8::EpiSwiglu, pg8::GroupedOrder<2>, true, true>(F.lds, g, S, E);
    } SEAM(15);
    if constexpr (IN(16)) { FRESH();
        __syncthreads();
        const int ntiles = (int)__hip_atomic_load(F.ctl + CW_NTILES, RLX_AGENT);
        LAS int* te = (LAS int*)(F.lds + 131072); LAS int* tv = te + MAXTILES;
        for (int i = F.tid; i < MAXTILES; i += NTHR) { te[i] = (i < ntiles) ? WSP(int, WS_TILEE)[i] : 0; tv[i] = (i < ntiles) ? WSP(int, WS_TILEV)[i] : 0; }
        __syncthreads();
        pg8::Gemm g{WSP(bf16, WS_HB), WSP(bf16, WS_W2T), ROWS_ALL, NEX * 1024, EH, nullptr}; pg8::GroupedOrder<4> S{te, ntiles, F.G, F.bx, 0};
        pg8::EpiFp8<4> E{WSP(unsigned char, WS_YB), D, tv, YB_SCALE};
        pg8::gemm_phase<pg8::EpiFp8<4>, pg8::GroupedOrder<4>, true, false>(F.lds, g, S, E);
    } SEAM(16);
    if constexpr (IN(17)) { FRESH(); phase_final(F); }
#if TIMING
    if constexpr (HI - LO > 1) { xcd_barrier(bar); TSTAMP(17);
        if (blockIdx.x == 0) { __syncthreads(); const unsigned long long* TS = (const unsigned long long*)(args.ws + WS_CTL) + 256;
            const float ta = (float)(TS[TA_HI] - (TA_LO > 0 ? TS[TA_LO - 1] : TS[18])) * 0.01f, tb = (float)(TS[TB_HI] - (TB_LO > 0 ? TS[TB_LO - 1] : TS[18])) * 0.01f;
            VM_WAIT(); __syncthreads();
            for (int i = threadIdx.x; i < (1 << 20); i += NTHR) args.out[(size_t)1024 * 1024 + i] += tb * 0.01f;
            if (threadIdx.x == 0) args.out[7] = ta; } }
#endif
#undef IN
#undef SEAM
}
#if DEV_CHECKS
struct CArgs { const float* in[26]; float* out; unsigned char* ws; };
#define CW(T_, off) ((T_*)(a.ws + (off)))
__device__ __forceinline__ unsigned hsh(unsigned x) { x ^= x >> 16; x *= 0x7feb352du; x ^= x >> 15; x *= 0x846ca68bu; x ^= x >> 16; return x; }
__device__ __forceinline__ void chk_acc(unsigned char* ws, int k, float num, float den) {
    num = wave_sum(num); den = wave_sum(den);
    if ((threadIdx.x & 63) == 0) { float* e = (float*)(ws + WS_CTL) + CW_ERR + 2 * k; atomicAdd(e, num); atomicAdd(e + 1, den); }
}
__device__ __forceinline__ float bfr(float f) { return __uint_as_float(f2bf(f) << 16); }
__device__ float c_convsilu(const CArgs& a, int b, int s, int ch) {
    const bf16* P = CW(bf16, WS_PROJ); float o = a.in[10][ch];
    for (int i = 0; i < 5; ++i) { const int ss = s + i - 2; if (ss >= 0 && ss < SEQ) o += a.in[9][i * 2560 + ch] * bf2f(P[(size_t)(b * SEQ + ss) * PW + PC_X + ch]); }
    return siluf_(o);
}
__device__ float c_prev(const CArgs& a, size_t si, int idx, int h, int d) {
    const size_t ei = si * 8192 + st_off(idx >> 7, idx & 127); const int wv = CW(int, WS_ST)[ei >> 2]; const int bs = ei & 3;
    return (bs == 0 ? __builtin_amdgcn_cvt_f32_fp8(wv, 0) : bs == 1 ? __builtin_amdgcn_cvt_f32_fp8(wv, 1) : bs == 2 ? __builtin_amdgcn_cvt_f32_fp8(wv, 2) : __builtin_amdgcn_cvt_f32_fp8(wv, 3)) * softplusf_(d ? a.in[12][h] : a.in[11][h]) * (1.f / STP_SCALE);
}
__device__ float c_dt(const CArgs& a, int b, int s, int h, int d) { return softplusf_(CW(float, WS_DT)[(size_t)(b * SEQ + s) * 64 + d * 24 + h] + (d ? a.in[12][h] : a.in[11][h])); }
__device__ float c_a(const CArgs& a, int b, int s, int h, int d) { return -expf(d ? a.in[14][h] : a.in[13][h]) * c_dt(a, b, s, h, d); }

__global__ void chk0(CArgs a) {
    const unsigned sid = blockIdx.x * blockDim.x + threadIdx.x; const unsigned r = hsh(sid * 3u + 1u), r2 = hsh(sid * 3u + 2u);
    float num = 0.f, den = 0.f;
    { const int b = r & 3, col = (r >> 2) % 6144; float s = a.in[3][col]; for (int k = 0; k < 1024; ++k) s += siluf_(a.in[1][b * 1024 + k]) * a.in[2][(size_t)k * 6144 + col];
      const float f = CW(float, WS_MOD)[b * 6144 + col]; num += (f - s) * (f - s); den += s * s; }
    { const int d = r2 % NPROJ, k = (r2 >> 13) & 1023; float e;
      if (d < PC_U) e = a.in[8][(size_t)k * INW + d];
      else if (d < PC_GS) e = a.in[8][(size_t)k * INW + SRC_F + d - PC_U];
      else if (d < PW) e = a.in[8][(size_t)k * INW + SRC_G + d - PC_GS];
      else e = (d - PW < 48) ? a.in[8][(size_t)k * INW + SRC_DT + d - PW] : 0.f;
      const float f = bf2f(CW(bf16, WS_WINT)[(size_t)d * 1024 + k]); num += (f - e) * (f - e); den += e * e + 1e-6f; }
    { const int n = r & 1023, k = (r >> 10) % 1536; const float e = a.in[17][(size_t)k * 1024 + n] * a.in[16][k], f = bf2f(CW(bf16, WS_WBST)[(size_t)n * 1536 + k]); num += (f - e) * (f - e); den += e * e; }
    { const int n = r2 & 1023, k = (r2 >> 10) & 511; const float e = a.in[18][(size_t)k * 1024 + n], f = bf2f(CW(bf16, WS_WBFT)[(size_t)n * 512 + k]); num += (f - e) * (f - e); den += e * e; }
    { const int n = r & 1023, k = (r >> 10) & 1023; const float e = a.in[19][(size_t)k * 1024 + n], f = bf2f(CW(bf16, WS_WOUTT)[(size_t)n * 1024 + k]); num += (f - e) * (f - e); den += e * e; }
    { const int n = r2 & 255, k = (r2 >> 8) & 1023; const float e = a.in[20][(size_t)k * 256 + n], f = bf2f(CW(bf16, WS_WRT)[(size_t)n * 1024 + k]); num += (f - e) * (f - e); den += e * e; }
    { const int e_ = hsh(sid + 77u) % NEX, rho = r & 511, k = (r >> 9) & 1023; const int pn = rho >> 8, bj = (rho >> 7) & 1, jj = rho & 127, sc = bj * 256 + pn * 128 + jj;
      const float e = (e_ < NE) ? a.in[22][((size_t)e_ * 1024 + k) * 512 + sc] : a.in[24][(size_t)k * 512 + sc]; const float f = bf2f(CW(bf16, WS_W13T)[((size_t)e_ * 512 + rho) * 1024 + k]); num += (f - e) * (f - e); den += e * e; }
    { const int e_ = hsh(sid + 99u) % NEX, n = r2 & 1023, k = (r2 >> 10) & 255;
      const float e = (e_ < NE) ? a.in[23][((size_t)e_ * 256 + k) * 1024 + n] : a.in[25][(size_t)k * 1024 + n]; const float f = bf2f(CW(bf16, WS_W2T)[((size_t)e_ * 1024 + n) * 256 + k]); num += (f - e) * (f - e); den += e * e; }
    chk_acc(a.ws, 0, num, den);
}
__global__ void chk1(CArgs a) {
    const unsigned sid = blockIdx.x * blockDim.x + threadIdx.x; if (sid >= 4096) return; const unsigned r = hsh(sid + 11u);
    const int m = r % T, b = m / SEQ; const float* x = a.in[0] + (size_t)m * D; float ss = 0.f; for (int k = 0; k < D; ++k) ss += x[k] * x[k];
    const float rstd = 1.f / sqrtf(ss / D + RMS_EPS); const float* mod = CW(float, WS_MOD) + b * 6144; float num = 0.f, den = 0.f;
    for (int q = 0; q < 8; ++q) { const int col = (r >> 15) * 8 % 1024 + q; const float e = x[col] * rstd * a.in[4][col] * (1.f + mod[1024 + col]) + mod[col]; const float f = bf2f(CW(bf16, WS_H)[(size_t)m * D + col]); num += (f - e) * (f - e); den += e * e; }
    chk_acc(a.ws, 1, num, den);
}
__device__ float c_dot_bf(const bf16* A, const bf16* B, int K) { float s = 0.f; for (int k = 0; k < K; ++k) s += bf2f(A[k]) * bf2f(B[k]); return s; }
__global__ void chk2(CArgs a) {
    const unsigned sid = blockIdx.x * blockDim.x + threadIdx.x; const unsigned r = hsh(sid + 21u);
    const int m = r % T; int col = (r >> 15) % (PW + 48); float num = 0.f, den = 0.f;
    const float e = c_dot_bf(CW(bf16, WS_H) + (size_t)m * D, CW(bf16, WS_WINT) + (size_t)col * D, D); float f, ee = e;
    if (col < PW) { if (col >= PC_GS) ee = 1.f / (1.f + expf(-e)); f = bf2f(CW(bf16, WS_PROJ)[(size_t)m * PW + col]); } else f = CW(float, WS_DT)[(size_t)m * 64 + col - PW];
    num = (f - ee) * (f - ee); den = ee * ee; chk_acc(a.ws, 2, num, den);
}
__global__ void chk3(CArgs a) {
    const unsigned sid = blockIdx.x * blockDim.x + threadIdx.x; if (sid >= 8192) return; const unsigned r = hsh(sid + 31u);
    const int b = r & 3, c = (r >> 2) & 63, h = (r >> 8) % 24, d = (r >> 13) & 1, p = (r >> 14) & 63, n = (r >> 20) & 127, g = h / HPG;
    float tot = 0.f; for (int s = 0; s < 128; ++s) tot += c_a(a, b, c * 128 + s, h, d);
    float st = 0.f, run = 0.f;
    if (d == 0) { for (int s = 0; s < 128; ++s) { run += c_a(a, b, c * 128 + s, h, 0); st += c_convsilu(a, b, c * 128 + s, h * 64 + p) * c_dt(a, b, c * 128 + s, h, 0) * expf(tot - run) * c_convsilu(a, b, c * 128 + s, 1536 + g * 128 + n); } }
    else { for (int s = 127; s >= 0; --s) { run += c_a(a, b, c * 128 + s, h, 1); st += c_convsilu(a, b, c * 128 + s, h * 64 + p) * c_dt(a, b, c * 128 + s, h, 1) * expf(tot - run) * c_convsilu(a, b, c * 128 + s, 1536 + g * 128 + n); } }
    const size_t si = ((size_t)((b * NCHUNK + c) * HEADS + h) * 2 + d); const size_t ei = si * 8192 + st_off(p, n); const int wv = CW(int, WS_STL)[ei >> 2]; const int bs = ei & 3;
    const float f = (bs == 0 ? __builtin_amdgcn_cvt_f32_fp8(wv, 0) : bs == 1 ? __builtin_amdgcn_cvt_f32_fp8(wv, 1) : bs == 2 ? __builtin_amdgcn_cvt_f32_fp8(wv, 2) : __builtin_amdgcn_cvt_f32_fp8(wv, 3)) * softplusf_(d ? a.in[12][h] : a.in[11][h]) * (1.f / STL_SCALE);
    float num = (f - st) * (f - st), den = st * st; const float cd = CW(float, WS_CD)[si], ce = expf(tot); num += (cd - ce) * (cd - ce); den += ce * ce;
    chk_acc(a.ws, 3, num, den);
}
__global__ void chk4(CArgs a) {
    const unsigned sid = blockIdx.x * blockDim.x + threadIdx.x; const unsigned r = hsh(sid + 41u);
    const int b = r & 3, s2 = (r >> 2) & 127, k1 = (r >> 9) & 63, j = (r >> 15) & 511; const bf16* P = CW(bf16, WS_PROJ);
    float gr = 0.f, gi = 0.f;
    const int g_ = j >> 7, jj = j & 127;
    for (int s1 = 0; s1 < 64; ++s1) { const size_t row = (size_t)(b * SEQ + 128 * s1 + s2) * PW; float zr = 0.f, zi = 0.f;
        for (int c_ = 0; c_ < 128; ++c_) { float sn_, cs_; sincospif((float)((c_ * jj) & 127) / 64.f, &sn_, &cs_); const float uv = bf2f(P[row + PC_U + g_ * 128 + c_]); zr += uv * cs_; zi -= uv * sn_; }
        zr = bfr(zr * 0.08838834764831845f); zi = bfr(zi * 0.08838834764831845f);
        float sn, cs; sincospif((float)((s1 * k1) & 63) / 32.f, &sn, &cs); gr += zr * cs + zi * sn; gi += zi * cs - zr * sn; }
    float sn, cs; sincospif((float)((s2 * k1) & 8191) / 4096.f, &sn, &cs); const float er = (gr * cs + gi * sn) * 0.125f, ei = (gi * cs - gr * sn) * 0.125f;
    const bf16* G = CW(bf16, WS_GB) + ((size_t)(b * 128 + s2) * 64 + k1) * 1024; const float fr_ = bf2f(G[j]), fi = bf2f(G[512 + j]);
    chk_acc(a.ws, 4, (fr_ - er) * (fr_ - er) + (fi - ei) * (fi - ei), er * er + ei * ei);
}
__global__ void chk5(CArgs a) {
    const unsigned sid = blockIdx.x * blockDim.x + threadIdx.x; if (sid >= 8192) return; const unsigned r = hsh(sid + 51u);
    const int b = r & 3, c = (r >> 2) & 63, h = (r >> 8) % 24, d = (r >> 13) & 1, p = (r >> 14) & 63, n = (r >> 20) & 127, g = h / HPG;
    const int cn = d ? c - 1 : c + 1; float num = 0.f, den = 0.f;
    const size_t si = ((size_t)((b * NCHUNK + c) * HEADS + h) * 2 + d);
    if ((d == 0 && c == 0) || (d == 1 && c == 63)) { const float f = c_prev(a, si, p * 128 + n, h, d); num += f * f; }
    if (cn >= 0 && cn < 64) {
        float tot = 0.f; for (int s = 0; s < 128; ++s) tot += c_a(a, b, c * 128 + s, h, d);
        float st = 0.f, run = 0.f;
        for (int q = 0; q < 128; ++q) { const int s = d ? 127 - q : q; run += c_a(a, b, c * 128 + s, h, d); st += c_convsilu(a, b, c * 128 + s, h * 64 + p) * c_dt(a, b, c * 128 + s, h, d) * expf(tot - run) * c_convsilu(a, b, c * 128 + s, 1536 + g * 128 + n); }
        const size_t sn_ = ((size_t)((b * NCHUNK + cn) * HEADS + h) * 2 + d);
        const float e = c_prev(a, si, p * 128 + n, h, d) * expf(tot) + st, f = c_prev(a, sn_, p * 128 + n, h, d); num += (f - e) * (f - e); den += e * e + st * st; }
    chk_acc(a.ws, 5, num, den);
}
__global__ void chk6(CArgs a) {
    const unsigned sid = blockIdx.x * blockDim.x + threadIdx.x; const unsigned r = hsh(sid + 61u);
    const int b = r & 3, k = (r >> 2) & 8191, j = (r >> 15) & 511, k1 = k & 63, k2 = k >> 6; float num = 0.f, den = 0.f;
    { float s = 0.f; for (int s2 = 0; s2 < 128; ++s2) { const bf16* G = CW(bf16, WS_GB) + ((size_t)(b * 128 + s2) * 64 + k1) * 1024; float sn, cs; sincospif((float)((s2 * k2) & 127) / 64.f, &sn, &cs); s += bf2f(G[j]) * cs + bf2f(G[512 + j]) * sn; }
      s *= 0.08838834764831845f; const float f = bf2f(CW(bf16, WS_FO)[(size_t)(b * SEQ + k) * 512 + j]); num += (f - s) * (f - s); den += s * s; }
    if (sid < 64) { const bf16* P = CW(bf16, WS_PROJ); const int g_ = j >> 7, jj = j & 127; double s = 0.0;
      for (int t = 0; t < SEQ; ++t) { const size_t row = (size_t)(b * SEQ + t) * PW; for (int c_ = 0; c_ < 128; ++c_) { const long ph = ((long)k * t * 128 + (long)jj * c_ * SEQ) % ((long)SEQ * 128);
          float sn, cs; sincospif((float)((double)ph / ((double)SEQ * 64.0)), &sn, &cs); s += bf2f(P[row + PC_U + g_ * 128 + c_]) * cs; } }
      const float e = (float)(s / 1024.0); const float f = bf2f(CW(bf16, WS_FO)[(size_t)(b * SEQ + k) * 512 + j]); num += 64.f * (f - e) * (f - e); den += 64.f * e * e; }
    chk_acc(a.ws, 6, num, den);
}
__global__ void chk7(CArgs a) {
    __shared__ float Cl[128], CBs[2][128], red[384]; __shared__ float acf[6][128], acb[6][128];
    const unsigned r = hsh(blockIdx.x + 71u); const int b = r & 3, c = (r >> 2) & 63, l = (r >> 8) & 127, g = (r >> 15) & 3, tid = threadIdx.x;
    if (tid < 128) Cl[tid] = c_convsilu(a, b, c * 128 + l, 2048 + g * 128 + tid);
    if (tid < 12) { const int d = tid / 6, hh = tid % 6, h = g * HPG + hh; float run = 0.f;
        if (!d) for (int s = 0; s < 128; ++s) { run += c_a(a, b, c * 128 + s, h, 0); acf[hh][s] = run; } else for (int s = 127; s >= 0; --s) { run += c_a(a, b, c * 128 + s, h, 1); acb[hh][s] = run; } }
    __syncthreads();
    if (tid < 128) { float s = 0.f; for (int n = 0; n < 128; ++n) s += Cl[n] * c_convsilu(a, b, c * 128 + tid, 1536 + g * 128 + n); CBs[0][tid] = s; }
    __syncthreads();
    const int hh = tid / 64, p = tid % 64, h = g * HPG + hh; float y = 0.f;
    for (int s = 0; s < 128; ++s) { const float x = c_convsilu(a, b, c * 128 + s, h * 64 + p); float wgt = 0.f;
        if (s <= l) wgt += expf(acf[hh][l] - acf[hh][s]) * c_dt(a, b, c * 128 + s, h, 0);
        if (s >= l) wgt += expf(acb[hh][l] - acb[hh][s]) * c_dt(a, b, c * 128 + s, h, 1);
        y += CBs[0][s] * wgt * x; if (s == l) y += a.in[15][h] * x; }
    for (int d = 0; d < 2; ++d) { const size_t si_ = ((size_t)((b * NCHUNK + c) * HEADS + h) * 2 + d); float s = 0.f; for (int n = 0; n < 128; ++n) s += Cl[n] * c_prev(a, si_, p * 128 + n, h, d);
        y += s * expf(d ? acb[hh][l] : acf[hh][l]); }
    const size_t trow = (size_t)(b * SEQ + c * 128 + l);
    const float v = y * siluf_(bf2f(CW(bf16, WS_PROJ)[trow * PW + PC_Z + h * 64 + p])); red[tid] = v * v; __syncthreads();
    if (tid == 0) { float s = 0.f; for (int i = 0; i < 384; ++i) s += red[i]; red[0] = s; } __syncthreads();
    const float e = v / sqrtf(red[0] / 384.f + RMS_EPS), f = bf2f(CW(bf16, WS_YN)[trow * INNER + g * 384 + tid]);
    float num = (f - e) * (f - e), den = e * e; num = wave_sum(num); den = wave_sum(den);
    if ((tid & 63) == 0) { float* ew = (float*)(a.ws + WS_CTL) + CW_ERR + 2 * 7; atomicAdd(ew, num); atomicAdd(ew + 1, den); }
}
__global__ void chk9(CArgs a) {
    const unsigned sid = blockIdx.x * blockDim.x + threadIdx.x; const unsigned r = hsh(sid + 91u); const int m = r % T, col = (r >> 15) & 1023;
    const float y1 = c_dot_bf(CW(bf16, WS_YN) + (size_t)m * INNER, CW(bf16, WS_WBST) + (size_t)col * INNER, INNER), y2 = c_dot_bf(CW(bf16, WS_FO) + (size_t)m * 512, CW(bf16, WS_WBFT) + (size_t)col * 512, 512);
    const bf16* P = CW(bf16, WS_PROJ) + (size_t)m * PW; const float e = bfr(bf2f(P[PC_GS + col]) * y1) + bf2f(P[PC_GF + col]) * y2, f = bf2f(CW(bf16, WS_MIX)[(size_t)m * D + col]);
    chk_acc(a.ws, 9, (f - e) * (f - e), e * e);
}
__global__ void chk10(CArgs a) {
    const unsigned sid = blockIdx.x * blockDim.x + threadIdx.x; const unsigned r = hsh(sid + 101u); const int m = r % T, col = (r >> 15) & 1023;
    const float e = c_dot_bf(CW(bf16, WS_MIX) + (size_t)m * D, CW(bf16, WS_WOUTT) + (size_t)col * D, D), f = bf2f(CW(bf16, WS_MIXED)[(size_t)m * D + col]);
    chk_acc(a.ws, 10, (f - e) * (f - e), e * e);
}
__global__ void chk11(CArgs a) {
    const unsigned sid = blockIdx.x * blockDim.x + threadIdx.x; if (sid >= 4096) return; const unsigned r = hsh(sid + 111u);
    const int m = r % T, b = m / SEQ; const bf16* mx = CW(bf16, WS_MIXED) + (size_t)m * D; const float* mod = CW(float, WS_MOD) + b * 6144; const float* x = a.in[0] + (size_t)m * D;
    float ss = 0.f; for (int k = 0; k < D; ++k) ss += bf2f(mx[k]) * bf2f(mx[k]); const float rstd = 1.f / sqrtf(ss / D + RMS_EPS);
    float s2 = 0.f; for (int k = 0; k < D; ++k) { const float v = x[k] + mod[2048 + k] * (bf2f(mx[k]) * rstd * a.in[5][k]); s2 += v * v; } const float rstd2 = 1.f / sqrtf(s2 / D + RMS_EPS);
    float num = 0.f, den = 0.f;
    for (int q = 0; q < 8; ++q) { const int col = ((r >> 15) * 8 + q) & 1023; const float x1 = x[col] + mod[2048 + col] * (bf2f(mx[col]) * rstd * a.in[5][col]);
        const float f1 = a.out[(size_t)m * D + col]; num += (f1 - x1) * (f1 - x1); den += x1 * x1;
        const float e2 = x1 * rstd2 * a.in[6][col] * (1.f + mod[4096 + col]) + mod[3072 + col], f2 = bf2f(CW(bf16, WS_H)[(size_t)m * D + col]); num += (f2 - e2) * (f2 - e2); den += e2 * e2; }
    chk_acc(a.ws, 11, num, den);
}
__global__ void chk12(CArgs a) {
    const unsigned sid = blockIdx.x * blockDim.x + threadIdx.x; const unsigned r = hsh(sid + 121u); const int m = r % T, col = (r >> 15) & 255;
    const float e = c_dot_bf(CW(bf16, WS_H) + (size_t)m * D, CW(bf16, WS_WRT) + (size_t)col * D, D), f = CW(float, WS_LOG)[(size_t)m * NE + col];
    chk_acc(a.ws, 12, (f - e) * (f - e), e * e);
}
__global__ void chk13(CArgs a) {
    const unsigned sid = blockIdx.x * blockDim.x + threadIdx.x; if (sid >= 8192) return; const int t = hsh(sid + 131u) % T; const float* lg = CW(float, WS_LOG) + (size_t)t * NE;
    float gsc[8]; for (int g = 0; g < 8; ++g) { float m1 = -INFINITY, m2 = -INFINITY; for (int j = 0; j < 32; ++j) { const float v = 1.f / (1.f + expf(-lg[g * 32 + j])) + a.in[21][g * 32 + j]; if (v > m1) { m2 = m1; m1 = v; } else if (v > m2) m2 = v; } gsc[g] = m1 + m2; }
    unsigned gm = 0; for (int g = 0; g < 8; ++g) { int rank = 0; for (int j = 0; j < 8; ++j) rank += (gsc[j] > gsc[g] || (gsc[j] == gsc[g] && j < g)); if (rank < 4) gm |= 1u << g; }
    int idx[8]; float sc[8]; unsigned long long taken[4] = {0, 0, 0, 0}; float wsum = 0.f;
    for (int k = 0; k < 8; ++k) { float bv = -INFINITY; int bi = -1; for (int e = 0; e < 256; ++e) { if (!((gm >> (e >> 5)) & 1u) || ((taken[e >> 6] >> (e & 63)) & 1ull)) continue; const float v = 1.f / (1.f + expf(-lg[e])) + a.in[21][e]; if (v > bv) { bv = v; bi = e; } }
        idx[k] = bi; sc[k] = 1.f / (1.f + expf(-lg[bi])); wsum += sc[k]; taken[bi >> 6] |= 1ull << (bi & 63); }
    float num = 0.f, den = 8.f;
    for (int k = 0; k < 8; ++k) { if (CW(int, WS_TOPI)[t * 8 + k] != idx[k]) num += 1.f; const float e = sc[k] / wsum * 2.5f, f = CW(float, WS_TOPW)[t * 8 + k]; if (fabsf(e - f) > 1e-4f) num += 1.f; }
    chk_acc(a.ws, 13, num, den);
}
__global__ void chk14(CArgs a) {
    const unsigned sid = blockIdx.x * blockDim.x + threadIdx.x; const unsigned* ctl = (const unsigned*)(a.ws + WS_CTL); const int ntiles = (int)ctl[CW_NTILES], basesh = (int)ctl[CW_BASESH];
    float num = 0.f, den = 1.f;
    { const int t = sid % T, k = (sid / T) & 7; const int pos = CW(int, WS_TOKPOS)[t * 8 + k]; if (pos < T || pos >= ntiles * 256) num += 1.f; else { if (CW(int, WS_ROWTOK)[pos] != t) num += 1.f; if (CW(int, WS_TILEE)[pos >> 8] != CW(int, WS_TOPI)[t * 8 + k]) num += 1.f; } }
    for (int r = T + sid; r < ntiles * 256; r += gridDim.x * blockDim.x) { const int tk = CW(int, WS_ROWTOK)[r]; if (tk < 0 || tk >= T) num += 1.f; }
    if (sid == 0) { if (ntiles > MAXTILES || ntiles < T / 256 + 1024 || basesh != 0) num += 100.f; for (int t = 0; t < T / 256; ++t) if (CW(int, WS_TILEE)[t] != NE) num += 1.f; }
    chk_acc(a.ws, 14, num, den);
}
__global__ void chk15(CArgs a) {
    const unsigned sid = blockIdx.x * blockDim.x + threadIdx.x; const unsigned r = hsh(sid + 151u); const unsigned* ctl = (const unsigned*)(a.ws + WS_CTL); const int ntiles = (int)ctl[CW_NTILES];
    const int row = r % (ntiles * 256), j = (r >> 20) & 255, e_ = CW(int, WS_TILEE)[row >> 8], tok = row < T ? row : CW(int, WS_ROWTOK)[row];
    const float* w = (e_ < NE) ? a.in[22] + (size_t)e_ * 1024 * 512 : a.in[24]; const bf16* h = CW(bf16, WS_H) + (size_t)tok * D; float s1 = 0.f, s2 = 0.f;
    for (int k = 0; k < D; ++k) { const float hv = bf2f(h[k]); s1 += hv * bfr(w[(size_t)k * 512 + j]); s2 += hv * bfr(w[(size_t)k * 512 + 256 + j]); }
    const float e = siluf_(s1) * s2, f = bf2f(CW(bf16, WS_HB)[(size_t)row * EH + j]); chk_acc(a.ws, 15, (f - e) * (f - e), e * e);
}
__global__ void chk16(CArgs a) {
    const unsigned sid = blockIdx.x * blockDim.x + threadIdx.x; const unsigned r = hsh(sid + 161u); const unsigned* ctl = (const unsigned*)(a.ws + WS_CTL); const int ntiles = (int)ctl[CW_NTILES];
    const int row = r % (ntiles * 256), col = (r >> 20) & 1023, e_ = CW(int, WS_TILEE)[row >> 8];
    const float* w = (e_ < NE) ? a.in[23] + (size_t)e_ * 256 * 1024 : a.in[25]; const bf16* h = CW(bf16, WS_HB) + (size_t)row * EH; float s = 0.f;
    for (int k = 0; k < EH; ++k) s += bf2f(h[k]) * bfr(w[(size_t)k * 1024 + col]);
    const int nv = CW(int, WS_TILEV)[row >> 8]; if ((row & 255) >= nv) { chk_acc(a.ws, 16, 0.f, 0.f); return; }
    const unsigned wv = CW(unsigned, WS_YB)[((size_t)row * D + col) >> 2]; const int bs = col & 3;
    const float f = (bs == 0 ? __builtin_amdgcn_cvt_f32_fp8((int)wv, 0) : bs == 1 ? __builtin_amdgcn_cvt_f32_fp8((int)wv, 1) : bs == 2 ? __builtin_amdgcn_cvt_f32_fp8((int)wv, 2) : __builtin_amdgcn_cvt_f32_fp8((int)wv, 3)) * (1.f / YB_SCALE);
    chk_acc(a.ws, 16, (f - s) * (f - s), s * s);
}
__global__ void chk_verdict(CArgs a) {
    const float* e = (const float*)(a.ws + WS_CTL) + CW_ERR; const unsigned* ctl = (const unsigned*)(a.ws + WS_CTL); int bad = -1;
    for (int k = 0; k < 17; ++k) { const float num = e[2 * k], den = e[2 * k + 1]; if (k == 8) continue; const float tol = (k == 16 || k == 3 || k == 5) ? 1e-2f : 2e-3f; if (!(num <= tol * den) || !(den > 0.f)) { bad = k; break; } }
    if (ctl[CW_BAR + XB_TMO]) bad = 27;
    if (bad < 0) return; const float al = 3.f + bad;
    for (size_t i = (size_t)blockIdx.x * blockDim.x + threadIdx.x; i < (size_t)T * D; i += (size_t)gridDim.x * blockDim.x) a.out[i] = al * a.in[0][i];
}
#endif
#if EMIT_AFTER >= 0
__global__ void emit_k(CArgs a, int k) {
    const unsigned* ctl = (const unsigned*)(a.ws + WS_CTL);
    for (size_t i = (size_t)blockIdx.x * blockDim.x + threadIdx.x; i < (size_t)T * D; i += (size_t)gridDim.x * blockDim.x) {
        const int t = (int)(i >> 10), c = (int)(i & 1023); float v = 0.f;
        if (k == 1) v = bf2f(CW(bf16, WS_H)[i]) + CW(float, WS_MOD)[(t & 3) * 6144 + c] + bf2f(CW(bf16, WS_WINT)[(size_t)(t % NPROJ) * 1024 + c]) + bf2f(CW(bf16, WS_W13T)[(size_t)t * 4009 * 1024 % ((size_t)NEX * 512 * 1024) + c]);
        if (k == 2) { for (int q = 0; q < 6; ++q) v += bf2f(CW(bf16, WS_PROJ)[(size_t)t * PW + q * 1024 + c]); if ((c & 63) < 48) v += CW(float, WS_DT)[(size_t)t * 64 + (c & 63)]; }
        if (k == 20) v = bf2f(CW(bf16, WS_PROJ)[(size_t)t * PW + PC_U + (c & 511)]);
        if (k == 21) v = bf2f(CW(bf16, WS_WINT)[(size_t)(PC_U + (t & 511)) * 1024 + c]) + bf2f(CW(bf16, WS_WM1)[(i & 16383)]) + CW(f32x2, WS_TW)[i & 8191].x + CW(f32x2, WS_TW)[i & 8191].y;
        if (k == 3) { v = bf2f(CW(bf16, WS_ST)[i]) + bf2f(CW(bf16, WS_ST)[i + (size_t)T * D]) + bf2f(CW(bf16, WS_ST)[i + 2 * (size_t)T * D]); }
        if (k == 5) { v = bf2f(CW(bf16, WS_ST)[i]) + bf2f(CW(bf16, WS_ST)[i + (size_t)T * D]) + bf2f(CW(bf16, WS_ST)[i + 2 * (size_t)T * D]); }
        if (k == 4) v = a.in[0][i] + 1000.f * (bf2f(CW(bf16, WS_GB)[i]) - bf2f(CW(bf16, WS_MIX)[i]));
        if (k == 6) v = bf2f(CW(bf16, WS_GB)[i]) + bf2f(CW(bf16, WS_FO)[(size_t)t * 512 + (c & 511)]);
        if (k == 7) v = bf2f(CW(bf16, WS_YN)[(size_t)t * INNER + c]) + bf2f(CW(bf16, WS_YN)[(size_t)t * INNER + 512 + c]);
        if (k == 9) v = bf2f(CW(bf16, WS_MIX)[i]);
        if (k == 10) v = bf2f(CW(bf16, WS_MIXED)[i]);
        if (k == 12) v = CW(float, WS_LOG)[(size_t)t * 256 + (c & 255)] + bf2f(CW(bf16, WS_H)[i]) + a.out[i];
        if (k == 13) v = (float)CW(int, WS_TOPI)[t * 8 + (c & 7)] + CW(float, WS_TOPW)[t * 8 + (c & 7)];
        if (k == 15) { for (int q = 0; q < 8; ++q) v += bf2f(CW(bf16, WS_HB)[(size_t)CW(int, WS_TOKPOS)[t * 8 + q] * EH + (c & 255)]); v += bf2f(CW(bf16, WS_HB)[(size_t)(ctl[CW_BASESH] + t) * EH + (c & 255)]); }
        if (k == 16) { for (int q = 0; q < 8; ++q) v += CW(float, WS_TOPW)[t * 8 + q] * bf2f(CW(bf16, WS_YB)[(size_t)CW(int, WS_TOKPOS)[t * 8 + q] * D + c]); v += bf2f(CW(bf16, WS_YB)[(size_t)(ctl[CW_BASESH] + t) * D + c]); }
        a.out[i] = v;
    }
}
#endif
template <int K> static void launch_phase(const Args& a, int grid, hipStream_t stream) {
    static bool attr = false;
    if (!attr) { (void)hipFuncSetAttribute((const void*)fwd<K, K + 1>, hipFuncAttributeMaxDynamicSharedMemorySize, LDS_BYTES); attr = true; }
    hipLaunchKernelGGL((fwd<K, K + 1>), dim3(grid), dim3(NTHR), LDS_BYTES, stream, a);
}
extern "C" void kernel_launch(void* const* d_in, const int* in_sizes, int n_in, void* d_out, int out_size, void* d_ws, size_t ws_size, hipStream_t stream) {
    static int grid = 0;
    if (grid == 0) {
        if (n_in != 26 || out_size != T * D || ws_size < WS_END) { fprintf(stderr, "kernel_launch: unexpected shapes (n_in %d, out %d, ws %zu < %zu)\n", n_in, out_size, ws_size, (size_t)WS_END); grid = -1; return; }
        int dev = 0, cus = 0;
        if (hipGetDevice(&dev) != hipSuccess || hipDeviceGetAttribute(&cus, hipDeviceAttributeMultiprocessorCount, dev) != hipSuccess) { grid = -1; return; }
#if !MULTI_LAUNCH
        if (hipFuncSetAttribute((const void*)fwd<0, NPH>, hipFuncAttributeMaxDynamicSharedMemorySize, LDS_BYTES) != hipSuccess) { fprintf(stderr, "kernel_launch: hipFuncSetAttribute failed\n"); grid = -1; return; }
        int per_cu = 0; (void)hipOccupancyMaxActiveBlocksPerMultiprocessor(&per_cu, (const void*)fwd<0, NPH>, NTHR, LDS_BYTES); (void)hipGetLastError();
        if (per_cu < 1) fprintf(stderr, "kernel_launch: note: occupancy query reports %d\n", per_cu);
#endif
        grid = cus;
    }
    if (grid < 0) return;
    (void)hipMemsetAsync((char*)d_ws + WS_CTL, 0, CTL_ZERO_BYTES, stream);
    Args a{};
    for (int i = 0; i < 26; ++i) a.in[i] = (const float*)d_in[i];
    a.out = (float*)d_out; a.ws = (unsigned char*)d_ws;
#if MULTI_LAUNCH
#if DEV_CHECKS
    CArgs ca{}; for (int i = 0; i < 26; ++i) ca.in[i] = a.in[i]; ca.out = a.out; ca.ws = a.ws;
#define CHK(k, g, b) hipLaunchKernelGGL(chk##k, dim3(g), dim3(b), 0, stream, ca)
#else
#define CHK(k, g, b) do {} while (0)
#endif
#if PRE_K >= 0
    { launch_phase<0>(a, grid, stream);
      if (PRE_K >= 1) launch_phase<1>(a, grid, stream);
      if (PRE_K >= 2) launch_phase<2>(a, grid, stream);
      if (PRE_K >= 3) launch_phase<3>(a, grid, stream);
      if (PRE_K >= 4) launch_phase<4>(a, grid, stream);
      if (PRE_K >= 5) launch_phase<5>(a, grid, stream);
      if (PRE_K >= 6) launch_phase<6>(a, grid, stream);
      if (PRE_K >= 7) launch_phase<7>(a, grid, stream);
      if (PRE_K >= 8) launch_phase<8>(a, grid, stream);
      if (PRE_K >= 9) launch_phase<9>(a, grid, stream);
      if (PRE_K >= 10) launch_phase<10>(a, grid, stream);
      if (PRE_K >= 11) launch_phase<11>(a, grid, stream);
      if (PRE_K >= 12) launch_phase<12>(a, grid, stream);
      if (PRE_K >= 13) launch_phase<13>(a, grid, stream);
      if (PRE_K >= 14) launch_phase<14>(a, grid, stream);
      if (PRE_K >= 15) launch_phase<15>(a, grid, stream);
      if (PRE_K >= 16) launch_phase<16>(a, grid, stream); }
#endif
    launch_phase<0>(a, grid, stream); CHK(0, 256, 256);
#if (DUP_MASK >> 0) & 1
    launch_phase<0>(a, grid, stream);
#endif
#if EMIT_AFTER == 0
    { CArgs ce{}; for (int i = 0; i < 26; ++i) ce.in[i] = a.in[i]; ce.out = a.out; ce.ws = a.ws; hipLaunchKernelGGL(emit_k, dim3(2048), dim3(256), 0, stream, ce, 0); return; }
#endif
    launch_phase<1>(a, grid, stream); CHK(1, 16, 256);
#if (DUP_MASK >> 1) & 1
    launch_phase<1>(a, grid, stream);
#endif
#if EMIT_AFTER == 1
    { CArgs ce{}; for (int i = 0; i < 26; ++i) ce.in[i] = a.in[i]; ce.out = a.out; ce.ws = a.ws; hipLaunchKernelGGL(emit_k, dim3(2048), dim3(256), 0, stream, ce, 1); return; }
#endif
    launch_phase<2>(a, grid, stream); CHK(2, 256, 256);
#if (DUP_MASK >> 2) & 1
    launch_phase<2>(a, grid, stream);
#endif
#if EMIT_AFTER == 20 || EMIT_AFTER == 21
    { CArgs ce{}; for (int i = 0; i < 26; ++i) ce.in[i] = a.in[i]; ce.out = a.out; ce.ws = a.ws; hipLaunchKernelGGL(emit_k, dim3(2048), dim3(256), 0, stream, ce, EMIT_AFTER); return; }
#endif
#if EMIT_AFTER == 2
    { CArgs ce{}; for (int i = 0; i < 26; ++i) ce.in[i] = a.in[i]; ce.out = a.out; ce.ws = a.ws; hipLaunchKernelGGL(emit_k, dim3(2048), dim3(256), 0, stream, ce, 2); return; }
#endif
#if EMIT_AFTER != 4
    launch_phase<3>(a, grid, stream); CHK(3, 32, 256);
#if (DUP_MASK >> 3) & 1
    launch_phase<3>(a, grid, stream);
#endif
#endif
#if EMIT_AFTER == 3
    { CArgs ce{}; for (int i = 0; i < 26; ++i) ce.in[i] = a.in[i]; ce.out = a.out; ce.ws = a.ws; hipLaunchKernelGGL(emit_k, dim3(2048), dim3(256), 0, stream, ce, 3); return; }
#endif
    launch_phase<4>(a, grid, stream); CHK(4, 256, 256);
#if (DUP_MASK >> 4) & 1
    launch_phase<4>(a, grid, stream);
#endif
#if EMIT_AFTER == 4
    (void)hipMemcpyAsync((char*)d_ws + WS_MIX, (char*)d_ws + WS_GB, (size_t)T * D * 2, hipMemcpyDeviceToDevice, stream); launch_phase<4>(a, grid, stream);
    { CArgs ce{}; for (int i = 0; i < 26; ++i) ce.in[i] = a.in[i]; ce.out = a.out; ce.ws = a.ws; hipLaunchKernelGGL(emit_k, dim3(2048), dim3(256), 0, stream, ce, 4); return; }
#endif
    launch_phase<5>(a, grid, stream); CHK(5, 32, 256);
#if (DUP_MASK >> 5) & 1
    launch_phase<5>(a, grid, stream);
#endif
#if EMIT_AFTER == 5
    { CArgs ce{}; for (int i = 0; i < 26; ++i) ce.in[i] = a.in[i]; ce.out = a.out; ce.ws = a.ws; hipLaunchKernelGGL(emit_k, dim3(2048), dim3(256), 0, stream, ce, 5); return; }
#endif
    launch_phase<6>(a, grid, stream); CHK(6, 256, 256);
#if (DUP_MASK >> 6) & 1
    launch_phase<6>(a, grid, stream);
#endif
#if EMIT_AFTER == 6
    { CArgs ce{}; for (int i = 0; i < 26; ++i) ce.in[i] = a.in[i]; ce.out = a.out; ce.ws = a.ws; hipLaunchKernelGGL(emit_k, dim3(2048), dim3(256), 0, stream, ce, 6); return; }
#endif
    launch_phase<7>(a, grid, stream); CHK(7, 256, 384);
#if (DUP_MASK >> 7) & 1
    launch_phase<7>(a, grid, stream);
#endif
#if EMIT_AFTER == 7
    { CArgs ce{}; for (int i = 0; i < 26; ++i) ce.in[i] = a.in[i]; ce.out = a.out; ce.ws = a.ws; hipLaunchKernelGGL(emit_k, dim3(2048), dim3(256), 0, stream, ce, 7); return; }
#endif
    launch_phase<8>(a, grid, stream);
#if (DUP_MASK >> 8) & 1
    launch_phase<8>(a, grid, stream);
#endif
#if EMIT_AFTER == 8
    { CArgs ce{}; for (int i = 0; i < 26; ++i) ce.in[i] = a.in[i]; ce.out = a.out; ce.ws = a.ws; hipLaunchKernelGGL(emit_k, dim3(2048), dim3(256), 0, stream, ce, 8); return; }
#endif
    launch_phase<9>(a, grid, stream); CHK(9, 256, 256);
#if (DUP_MASK >> 9) & 1
    launch_phase<9>(a, grid, stream);
#endif
#if EMIT_AFTER == 9
    { CArgs ce{}; for (int i = 0; i < 26; ++i) ce.in[i] = a.in[i]; ce.out = a.out; ce.ws = a.ws; hipLaunchKernelGGL(emit_k, dim3(2048), dim3(256), 0, stream, ce, 9); return; }
#endif
    launch_phase<10>(a, grid, stream); CHK(10, 256, 256);
#if (DUP_MASK >> 10) & 1
    launch_phase<10>(a, grid, stream);
#endif
#if EMIT_AFTER == 10
    { CArgs ce{}; for (int i = 0; i < 26; ++i) ce.in[i] = a.in[i]; ce.out = a.out; ce.ws = a.ws; hipLaunchKernelGGL(emit_k, dim3(2048), dim3(256), 0, stream, ce, 10); return; }
#endif
    launch_phase<11>(a, grid, stream); CHK(11, 16, 256);
#if (DUP_MASK >> 11) & 1
    launch_phase<11>(a, grid, stream);
#endif
#if EMIT_AFTER == 11
    { CArgs ce{}; for (int i = 0; i < 26; ++i) ce.in[i] = a.in[i]; ce.out = a.out; ce.ws = a.ws; hipLaunchKernelGGL(emit_k, dim3(2048), dim3(256), 0, stream, ce, 11); return; }
#endif
    launch_phase<12>(a, grid, stream); CHK(12, 256, 256);
#if (DUP_MASK >> 12) & 1
    launch_phase<12>(a, grid, stream);
#endif
#if EMIT_AFTER == 12
    { CArgs ce{}; for (int i = 0; i < 26; ++i) ce.in[i] = a.in[i]; ce.out = a.out; ce.ws = a.ws; hipLaunchKernelGGL(emit_k, dim3(2048), dim3(256), 0, stream, ce, 12); return; }
#endif
    launch_phase<13>(a, grid, stream); CHK(13, 32, 256);
#if (DUP_MASK >> 13) & 1
    launch_phase<13>(a, grid, stream);
#endif
#if EMIT_AFTER == 13
    { CArgs ce{}; for (int i = 0; i < 26; ++i) ce.in[i] = a.in[i]; ce.out = a.out; ce.ws = a.ws; hipLaunchKernelGGL(emit_k, dim3(2048), dim3(256), 0, stream, ce, 13); return; }
#endif
    launch_phase<14>(a, grid, stream); CHK(14, 1024, 256);
#if (DUP_MASK >> 14) & 1
    launch_phase<14>(a, grid, stream);
#endif
#if EMIT_AFTER == 14
    { CArgs ce{}; for (int i = 0; i < 26; ++i) ce.in[i] = a.in[i]; ce.out = a.out; ce.ws = a.ws; hipLaunchKernelGGL(emit_k, dim3(2048), dim3(256), 0, stream, ce, 14); return; }
#endif
    launch_phase<15>(a, grid, stream); CHK(15, 256, 256);
#if (DUP_MASK >> 15) & 1
    launch_phase<15>(a, grid, stream);
#endif
#if EMIT_AFTER == 15
    { CArgs ce{}; for (int i = 0; i < 26; ++i) ce.in[i] = a.in[i]; ce.out = a.out; ce.ws = a.ws; hipLaunchKernelGGL(emit_k, dim3(2048), dim3(256), 0, stream, ce, 15); return; }
#endif
    launch_phase<16>(a, grid, stream); CHK(16, 256, 256);
#if (DUP_MASK >> 16) & 1
    launch_phase<16>(a, grid, stream);
#endif
#if EMIT_AFTER == 16
    { CArgs ce{}; for (int i = 0; i < 26; ++i) ce.in[i] = a.in[i]; ce.out = a.out; ce.ws = a.ws; hipLaunchKernelGGL(emit_k, dim3(2048), dim3(256), 0, stream, ce, 16); return; }
#endif
    launch_phase<17>(a, grid, stream);
#if (DUP_MASK >> 17) & 1
    launch_phase<17>(a, grid, stream);
#endif
#if EMIT_AFTER == 17
    { CArgs ce{}; for (int i = 0; i < 26; ++i) ce.in[i] = a.in[i]; ce.out = a.out; ce.ws = a.ws; hipLaunchKernelGGL(emit_k, dim3(2048), dim3(256), 0, stream, ce, 17); return; }
#endif
#if DEV_CHECKS
    hipLaunchKernelGGL(chk_verdict, dim3(1024), dim3(256), 0, stream, ca);
#endif
#else
    hipLaunchKernelGGL((fwd<0, NPH>), dim3(grid), dim3(NTHR), LDS_BYTES, stream, a);
#endif
}
```
